# Optimizing an MI355X kernel written in HIP

```python
import math
import jax
import jax.numpy as jnp
from jax import lax
import numpy as np

D_MODEL = 1024
BATCH = 8
SEQ = 2048
DEPTH = 2

GRID_W = 64
CTX_LEN = 256
HEAD_DIM = 64
N_MIXERS = 4
GROUP_WIDTH = D_MODEL // N_MIXERS
MIX_WIDTH = N_MIXERS * GROUP_WIDTH
NA_HEADS = GROUP_WIDTH // HEAD_DIM
NA_ROWS = 8
NA_COLS = 16
DIFF_HEADS = GROUP_WIDTH // HEAD_DIM
DIFF_QK_DIM = HEAD_DIM // 2
POOL_WINDOWS = (2, 4, 8, 16)
POOL_GROUP = GROUP_WIDTH // len(POOL_WINDOWS)
FFT_GROUPS = 4
FFT_GROUP = GROUP_WIDTH // FFT_GROUPS
OFF_NA_Q = 0 * GROUP_WIDTH
OFF_NA_K = 1 * GROUP_WIDTH
OFF_NA_V = 2 * GROUP_WIDTH
OFF_DF_Q = 3 * GROUP_WIDTH
OFF_DF_K = 4 * GROUP_WIDTH
OFF_DF_V = 5 * GROUP_WIDTH
OFF_POOL = 6 * GROUP_WIDTH
OFF_FFT = 7 * GROUP_WIDTH
IN_WIDTH = 8 * GROUP_WIDTH
N_EXPERTS = 32
TOP_K = 4
D_FF = D_MODEL
SWIGLU_ALPHA = 1.702
SWIGLU_LIMIT = 7.0
EXPERT_BLOCK = 256
Q_BLOCK = 128
ROPE_THETA = 10000.0
NORM_EPS = 1e-6
MASK_VALUE = -1e30

kernel_name = 'hybrid_prefix_dit_block'


def rms_norm(x, g):
    xf = x.astype(jnp.float32)
    y = xf * lax.rsqrt(jnp.mean(xf * xf, axis=-1, keepdims=True) + NORM_EPS)
    return (y * g.astype(jnp.float32)).astype(x.dtype)


def modulate(x, g, shift, scale):
    return rms_norm(x, g) * (1 + scale) + shift


def split_heads(t, n_heads):
    b, l, _ = t.shape
    return t.reshape(b, l, n_heads, -1).transpose(0, 2, 1, 3)


def merge_heads(t):
    b, h, l, d = t.shape
    return t.transpose(0, 2, 1, 3).reshape(b, l, h * d)


def diff_split(t):
    b, l, _ = t.shape
    return t.reshape(b, l, DIFF_HEADS, 2, DIFF_QK_DIM).transpose(0, 2, 3, 1, 4)


def axial_rope(t):
    l = t.shape[-2]
    pos = jnp.arange(l)
    half = DIFF_QK_DIM // 2
    inv = ROPE_THETA ** (-jnp.arange(0, half, 2, dtype=jnp.float32) / half)
    tf = t.astype(jnp.float32)
    outs = []
    for axis_pos, seg in ((pos // GRID_W, tf[..., :half]), (pos % GRID_W, tf[..., half:])):
        ang = axis_pos.astype(jnp.float32)[:, None] * inv
        cos, sin = jnp.cos(ang), jnp.sin(ang)
        s1, s2 = seg[..., :half // 2], seg[..., half // 2:]
        outs += [s1 * cos - s2 * sin, s2 * cos + s1 * sin]
    return jnp.concatenate(outs, axis=-1).astype(t.dtype)


def neighbourhood_attention(q, k, v, kc, vc, rpb):
    b, h, l, d = q.shape
    rows = l // GRID_W
    kr = min(NA_ROWS, rows)
    qg = q.reshape(b, h, rows, GRID_W, d)
    kg = k.reshape(b, h, rows, GRID_W, d)
    vg = v.reshape(b, h, rows, GRID_W, d)
    r = jnp.arange(rows)
    row_start = jnp.clip(r - NA_ROWS // 2, 0, rows - kr)
    row_idx = row_start[:, None] + jnp.arange(kr)
    k_rows = kg[:, :, row_idx]
    v_rows = vg[:, :, row_idx]
    col = jnp.arange(GRID_W)
    col_start = jnp.clip(col - NA_COLS // 2, 0, GRID_W - NA_COLS)
    in_win = (col[None, :] >= col_start[:, None]) & (col[None, :] < col_start[:, None] + NA_COLS)
    rel_r = row_idx - r[:, None] + NA_ROWS - 1
    rel_c = jnp.clip(col[None, :] - col[:, None], 1 - NA_COLS, NA_COLS - 1) + NA_COLS - 1
    bias = rpb.astype(jnp.float32)[:, rel_r[:, None, :, None], rel_c[None, :, None, :]]
    scale = d ** -0.5
    s_loc = jnp.einsum('bhrqd,bhrkcd->bhrqkc', qg, k_rows).astype(jnp.float32) * scale + bias
    s_loc = jnp.where(in_win[:, None, :], s_loc, MASK_VALUE)
    s_ctx = jnp.einsum('bhrqd,bhjd->bhrqj', qg, kc).astype(jnp.float32) * scale
    n_loc = kr * GRID_W
    s_all = jnp.concatenate([s_loc.reshape(b, h, rows, GRID_W, n_loc), s_ctx], axis=-1)
    p = jax.nn.softmax(s_all, axis=-1).astype(v.dtype)
    p_loc = p[..., :n_loc].reshape(b, h, rows, GRID_W, kr, GRID_W)
    out = (jnp.einsum('bhrqkc,bhrkcd->bhrqd', p_loc, v_rows)
           + jnp.einsum('bhrqj,bhjd->bhrqd', p[..., n_loc:], vc))
    return out.reshape(b, h, l, d)


def context_attention(q, k, v):
    s = jnp.einsum('bhqd,bhkd->bhqk', q, k).astype(jnp.float32) * q.shape[-1] ** -0.5
    return jnp.einsum('bhqk,bhkd->bhqd', jax.nn.softmax(s, axis=-1).astype(v.dtype), v)


def differential_attention(q, k, v, lam):
    s = jnp.einsum('bhiqd,bhikd->bhiqk', q, k).astype(jnp.float32) * q.shape[-1] ** -0.5
    p = jax.nn.softmax(s, axis=-1)
    a = p[:, :, 0] - lam * p[:, :, 1]
    return jnp.einsum('bhqk,bhkd->bhqd', a.astype(v.dtype), v)


def multiscale_pool(t, w, scale):
    b, l, _ = t.shape
    tf = t.astype(jnp.float32).reshape(b, l, len(POOL_WINDOWS), POOL_GROUP)
    cs = jnp.concatenate([jnp.zeros((b, 1, len(POOL_WINDOWS), POOL_GROUP), jnp.float32),
                          jnp.cumsum(tf, axis=1)], axis=1)
    pos = jnp.arange(l)
    outs = []
    for g, win in enumerate(POOL_WINDOWS):
        lo = jnp.clip(pos - win // 2, 0, l)
        hi = jnp.clip(pos - win // 2 + win, 0, l)
        csg = cs[:, :, g]
        mean = (csg[:, hi] - csg[:, lo]) / (hi - lo).astype(jnp.float32)[:, None]
        outs.append(mean - tf[:, :, g])
    m = jnp.stack(outs, axis=2)
    y = jnp.einsum('blgc,gce->blge', m, w.astype(jnp.float32)).reshape(b, l, GROUP_WIDTH)
    return (y * scale.astype(jnp.float32)).astype(t.dtype)


def fourier_mix(t, w):
    b, l, _ = t.shape
    tg = t.astype(jnp.float32).reshape(b, l, FFT_GROUPS, FFT_GROUP)
    f = jnp.fft.fft2(tg, axes=(1, 3), norm='ortho').real
    y = jnp.einsum('blgc,gce->blge', f, w.astype(jnp.float32)).reshape(b, l, GROUP_WIDTH)
    return y.astype(t.dtype)


def clamped_swiglu(u):
    glu = jnp.minimum(u[..., ::2], SWIGLU_LIMIT)
    lin = jnp.clip(u[..., 1::2], -SWIGLU_LIMIT, SWIGLU_LIMIT)
    return glu * jax.nn.sigmoid(SWIGLU_ALPHA * glu) * (lin + 1)


def expert_ffn(h, router_w, router_b, w1, b1, w2, b2):
    n, dm = h.shape
    logits = (h @ router_w).astype(jnp.float32) + router_b.astype(jnp.float32)
    top_val, top_idx = lax.top_k(logits, TOP_K)
    gate = jax.nn.softmax(top_val, axis=-1)
    n_assign = n * TOP_K
    flat_e = top_idx.reshape(n_assign)
    order = jnp.argsort(flat_e)
    sorted_e = flat_e[order]
    counts = jnp.bincount(flat_e, length=N_EXPERTS)
    padded = (counts + EXPERT_BLOCK - 1) // EXPERT_BLOCK * EXPERT_BLOCK
    group_start = jnp.cumsum(counts) - counts
    padded_end = jnp.cumsum(padded)
    padded_start = padded_end - padded
    dest = padded_start[sorted_e] + jnp.arange(n_assign) - group_start[sorted_e]
    n_blocks = -(-n_assign // EXPERT_BLOCK) + N_EXPERTS
    slots = n_blocks * EXPERT_BLOCK
    slot_tok = jnp.zeros((slots,), jnp.int32).at[dest].set((order // TOP_K).astype(jnp.int32))
    slot_w = jnp.zeros((slots,), jnp.float32).at[dest].set(gate.reshape(n_assign)[order])
    block_e = jnp.minimum(jnp.searchsorted(padded_end, jnp.arange(n_blocks) * EXPERT_BLOCK, side='right'),
                          N_EXPERTS - 1)

    def run_block(args):
        e, tok = args
        u = h[tok] @ w1[e] + b1[e]
        return clamped_swiglu(u) @ w2[e] + b2[e]

    y = lax.map(run_block, (block_e, slot_tok.reshape(n_blocks, EXPERT_BLOCK)))
    y = y.reshape(slots, dm) * slot_w[:, None].astype(h.dtype)
    return jnp.zeros_like(h).at[slot_tok].add(y)


def hybrid_layer(x, cx, c_act, cctx_act, p, layer_idx, ctx_out):
    b, l, dm = x.shape
    lc = cx.shape[1]
    gw = GROUP_WIDTH
    mod_x = (c_act @ p['w_ada'] + p['b_ada'])[:, None, :]
    mod_c = cctx_act @ p['w_ada'] + p['b_ada']
    sh1, sc1, g1, sh2, sc2, g2 = jnp.split(mod_x, 6, axis=-1)
    ch1, cs1, cg1, ch2, cs2, cg2 = jnp.split(mod_c, 6, axis=-1)
    w_in = p['w_in']

    hx = modulate(x, p['g1'], sh1, sc1)
    hc = modulate(cx, p['g1'], ch1, cs1)
    px = hx @ w_in
    if ctx_out:
        pc = hc @ w_in
        ccol = lambda off: pc[..., off:off + gw]
    else:
        ccol = lambda off: hc @ w_in[:, off:off + gw]
    xcol = lambda off: px[..., off:off + gw]

    qa = rms_norm(split_heads(xcol(OFF_NA_Q), NA_HEADS), p['na_qg'])
    ka = rms_norm(split_heads(xcol(OFF_NA_K), NA_HEADS), p['na_kg'])
    va = split_heads(xcol(OFF_NA_V), NA_HEADS)
    kca = rms_norm(split_heads(ccol(OFF_NA_K), NA_HEADS), p['na_kg'])
    vca = split_heads(ccol(OFF_NA_V), NA_HEADS)
    ya = merge_heads(neighbourhood_attention(qa, ka, va, kca, vca, p['na_rpb']))

    lam_init = 0.8 - 0.6 * math.exp(-0.3 * layer_idx)
    lam = (jnp.exp(jnp.sum(p['lq1'].astype(jnp.float32) * p['lk1'].astype(jnp.float32)))
           - jnp.exp(jnp.sum(p['lq2'].astype(jnp.float32) * p['lk2'].astype(jnp.float32))) + lam_init)
    qd = axial_rope(rms_norm(diff_split(xcol(OFF_DF_Q)), p['df_qg']))
    kd = axial_rope(rms_norm(diff_split(xcol(OFF_DF_K)), p['df_kg']))
    vd = split_heads(xcol(OFF_DF_V), DIFF_HEADS)
    kcd = rms_norm(diff_split(ccol(OFF_DF_K)), p['df_kg'])
    vcd = split_heads(ccol(OFF_DF_V), DIFF_HEADS)
    keys = jnp.concatenate([kcd, kd], axis=3)
    vals = jnp.concatenate([vcd, vd], axis=2)
    nb = l // Q_BLOCK
    q_blocks = jnp.moveaxis(qd.reshape(b, DIFF_HEADS, 2, nb, Q_BLOCK, DIFF_QK_DIM), 3, 0)
    yd = lax.map(lambda qb: differential_attention(qb, keys, vals, lam), q_blocks)
    yd = jnp.moveaxis(yd, 0, 2).reshape(b, DIFF_HEADS, l, HEAD_DIM)
    yd = merge_heads(rms_norm(yd, p['df_subln']) * (1 - lam_init))

    yb = multiscale_pool(xcol(OFF_POOL), p['pool_w'], p['pool_scale'])
    yf = fourier_mix(xcol(OFF_FFT), p['fft_w'])
    x = x + g1 * (jnp.concatenate([ya, yd, yb, yf], axis=-1) @ p['w_out'])

    if ctx_out:
        qca = rms_norm(split_heads(ccol(OFF_NA_Q), NA_HEADS), p['na_qg'])
        yca = merge_heads(context_attention(qca, kca, vca))
        qcd = rms_norm(diff_split(ccol(OFF_DF_Q)), p['df_qg'])
        ycd = merge_heads(rms_norm(differential_attention(qcd, kcd, vcd, lam), p['df_subln']) * (1 - lam_init))
        ycb = multiscale_pool(ccol(OFF_POOL), p['pool_w'], p['pool_scale'])
        ycf = fourier_mix(ccol(OFF_FFT), p['fft_w'])
        cx = cx + cg1 * (jnp.concatenate([yca, ycd, ycb, ycf], axis=-1) @ p['w_out'])

    hx2 = modulate(x, p['g2'], sh2, sc2).reshape(b * l, dm)
    moe_args = (p['router_w'], p['router_b'], p['w1'], p['b1'], p['w2'], p['b2'])
    if ctx_out:
        hc2 = modulate(cx, p['g2'], ch2, cs2).reshape(b * lc, dm)
        y = expert_ffn(jnp.concatenate([hx2, hc2], axis=0), *moe_args)
        x = x + g2 * y[:b * l].reshape(b, l, dm)
        cx = cx + cg2 * y[b * l:].reshape(b, lc, dm)
    else:
        x = x + g2 * expert_ffn(hx2, *moe_args).reshape(b, l, dm)
        cx = None
    return x, cx


def setup_inputs(seed: int = 0) -> dict:
    key = jax.random.key(seed)
    ks = jax.random.split(key, 32)
    f32 = jnp.float32
    nrm = lambda k, shape, s: jax.random.normal(k, shape, f32) * s
    L, D, E, F = DEPTH, D_MODEL, N_EXPERTS, D_FF
    return {
        'x': nrm(ks[0], (BATCH, SEQ, D), 1.0),
        'c': nrm(ks[1], (BATCH, D), 1.0),
        'ctx': nrm(ks[2], (BATCH, CTX_LEN, D), 1.0),
        'c_ctx': nrm(ks[3], (D,), 1.0),
        'w_ada': nrm(ks[4], (L, D, 6 * D), 0.5 * D ** -0.5),
        'b_ada': nrm(ks[5], (L, 6 * D), 0.02),
        'g_norm1': 1.0 + nrm(ks[6], (L, D), 0.05),
        'g_norm2': 1.0 + nrm(ks[7], (L, D), 0.05),
        'w_in': nrm(ks[8], (L, D, IN_WIDTH), D ** -0.5),
        'w_out': nrm(ks[9], (L, MIX_WIDTH, D), MIX_WIDTH ** -0.5),
        'na_q_gain': 1.0 + nrm(ks[10], (L, HEAD_DIM), 0.05),
        'na_k_gain': 1.0 + nrm(ks[11], (L, HEAD_DIM), 0.05),
        'na_rpb': nrm(ks[12], (L, NA_HEADS, 2 * NA_ROWS - 1, 2 * NA_COLS - 1), 0.5),
        'diff_q_gain': 1.0 + nrm(ks[13], (L, DIFF_QK_DIM), 0.05),
        'diff_k_gain': 1.0 + nrm(ks[14], (L, DIFF_QK_DIM), 0.05),
        'diff_lambda_q1': nrm(ks[15], (L, DIFF_QK_DIM), 0.1),
        'diff_lambda_k1': nrm(ks[16], (L, DIFF_QK_DIM), 0.1),
        'diff_lambda_q2': nrm(ks[17], (L, DIFF_QK_DIM), 0.1),
        'diff_lambda_k2': nrm(ks[18], (L, DIFF_QK_DIM), 0.1),
        'diff_subln': 1.0 + nrm(ks[19], (L, HEAD_DIM), 0.05),
        'pool_w': nrm(ks[20], (L, len(POOL_WINDOWS), POOL_GROUP, POOL_GROUP), POOL_GROUP ** -0.5),
        'pool_scale': 1.0 + nrm(ks[21], (L, GROUP_WIDTH), 0.1),
        'fft_w': nrm(ks[22], (L, FFT_GROUPS, FFT_GROUP, FFT_GROUP), FFT_GROUP ** -0.5),
        'router_w': nrm(ks[23], (L, D, E), D ** -0.5),
        'router_b': nrm(ks[24], (L, E), 0.01),
        'moe_w1': nrm(ks[25], (L, E, D, 2 * F), D ** -0.5),
        'moe_b1': nrm(ks[26], (L, E, 2 * F), 0.01),
        'moe_w2': nrm(ks[27], (L, E, F, D), F ** -0.5),
        'moe_b2': nrm(ks[28], (L, E, D), 0.01),
    }


def reference(x, c, ctx, c_ctx, w_ada, b_ada, g_norm1, g_norm2, w_in, w_out, na_q_gain, na_k_gain,
              na_rpb, diff_q_gain, diff_k_gain, diff_lambda_q1, diff_lambda_k1, diff_lambda_q2,
              diff_lambda_k2, diff_subln, pool_w, pool_scale, fft_w, router_w, router_b,
              moe_w1, moe_b1, moe_w2, moe_b2):
    c_act = jax.nn.silu(c)
    cctx_act = jax.nn.silu(c_ctx)
    cx = ctx
    for i in range(DEPTH):
        p = {
            'w_ada': w_ada[i], 'b_ada': b_ada[i], 'g1': g_norm1[i], 'g2': g_norm2[i],
            'w_in': w_in[i], 'w_out': w_out[i],
            'na_qg': na_q_gain[i], 'na_kg': na_k_gain[i], 'na_rpb': na_rpb[i],
            'df_qg': diff_q_gain[i], 'df_kg': diff_k_gain[i],
            'lq1': diff_lambda_q1[i], 'lk1': diff_lambda_k1[i],
            'lq2': diff_lambda_q2[i], 'lk2': diff_lambda_k2[i], 'df_subln': diff_subln[i],
            'pool_w': pool_w[i], 'pool_scale': pool_scale[i], 'fft_w': fft_w[i],
            'router_w': router_w[i], 'router_b': router_b[i],
            'w1': moe_w1[i], 'b1': moe_b1[i], 'w2': moe_w2[i], 'b2': moe_b2[i],
        }
        x, cx = hybrid_layer(x, cx, c_act, cctx_act, p, i, i < DEPTH - 1)
    return x
```

```cpp
#include <hip/hip_runtime.h>
#include <cstdio>
#include <cstdint>

#define REP_PRO0 1
#define REP_TILE 1
#define REP_EPI 1
#define REP_KL8 1
#define REP_KL16 1
#define REP_ROUTE 1
#define REP_BAR 1
#define REP_PRO1 1
#define REP_TR 1
#define REP_FOLD 1
#define REP_WIN 1
#define REP_PREP 1
#define REP_DF 1
#define REP_NA 1
#define REP_DFT 1
#define REP_WOUT 1
#define REP_MOE1 1
#define REP_MOE2 1
#define REP_COMB 1
#define REPEAT(n, stmt) do { _Pragma("unroll") for (int _r = 0; _r < (n); ++_r) { stmt; } } while (0)
typedef unsigned short bf16_t;
typedef short bf16x8 __attribute__((ext_vector_type(8)));
typedef float f32x4 __attribute__((ext_vector_type(4)));
typedef float f32x16 __attribute__((ext_vector_type(16)));
typedef float f32x2 __attribute__((ext_vector_type(2)));
typedef unsigned u32x4 __attribute__((ext_vector_type(4)));
typedef unsigned u32x2 __attribute__((ext_vector_type(2)));
typedef int i32x8 __attribute__((ext_vector_type(8)));
constexpr float SW8 = 64.f, SH8 = 16.f, SA8 = 4.f, SY8 = 16.f;

constexpr int NB = 8, SEQ = 2048, DM = 1024, LC = 256;
constexpr int NX = NB * SEQ, NC = NB * LC, NT = NX + NC;
constexpr int NIN = 2304;
constexpr int NE = 32, FF = 1024, KEYS = LC + SEQ;
constexpr int MAXSLOT = 81920;
constexpr float EPS = 1e-6f;

constexpr size_t al256(size_t x) { return (x + 255) & ~(size_t)255; }
constexpr size_t WS_CTL   = 0;
constexpr size_t CTL_BYTES = 65536;
constexpr size_t CTL_CNT  = 32768;
constexpr size_t CTL_PRO0 = 49152;
constexpr size_t WS_MOD   = WS_CTL + CTL_BYTES;
constexpr size_t WS_SCAL  = al256(WS_MOD + (size_t)2 * 9 * 6144 * 4);
constexpr size_t WS_ROPE  = al256(WS_SCAL + 2 * 16 * 4);
constexpr size_t WS_WIN   = al256(WS_ROPE + 64 * 8 * 2 * 4);
constexpr size_t WS_WOUT  = al256(WS_WIN + (size_t)2 * NIN * DM * 2);
constexpr size_t WS_W1    = al256(WS_WOUT + (size_t)2 * DM * DM * 2);
constexpr size_t WS_W2    = al256(WS_W1 + (size_t)2 * NE * 2048 * DM * 2);
constexpr size_t WS_DFTM  = al256(WS_W2 + (size_t)2 * NE * DM * FF * 2);
constexpr size_t WS_DFTC  = al256(WS_DFTM + (size_t)2048 * 2048 * 2);
constexpr size_t WS_H     = al256(WS_DFTC + (size_t)256 * 256 * 2);
constexpr size_t WS_PX    = al256(WS_H + (size_t)NT * DM * 2);
constexpr size_t QKV_ONE  = (size_t)NB * 4 * KEYS * 64 * 2;
constexpr size_t WS_QA    = al256(WS_PX + (size_t)NT * NIN * 2);
constexpr size_t WS_KA    = al256(WS_QA + QKV_ONE);
constexpr size_t WS_VTA   = al256(WS_KA + QKV_ONE);
constexpr size_t WS_QD    = al256(WS_VTA + QKV_ONE);
constexpr size_t WS_KD    = al256(WS_QD + QKV_ONE);
constexpr size_t WS_VTD   = al256(WS_KD + QKV_ONE);
constexpr size_t WS_XF    = al256(WS_VTD + QKV_ONE);
constexpr size_t WS_XFC   = al256(WS_XF + (size_t)2048 * 2048 * 2);
constexpr size_t WS_YCAT  = al256(WS_XFC + (size_t)2048 * 256 * 2);
constexpr size_t WS_X1    = al256(WS_YCAT + (size_t)NT * DM * 2);
constexpr size_t WS_X2    = al256(WS_X1 + (size_t)NT * DM * 4);
constexpr size_t WS_RTE   = al256(WS_X2 + (size_t)NT * DM * 4);
constexpr size_t WS_RTP   = al256(WS_RTE + (size_t)NT * 4 * 4);
constexpr size_t WS_RTG   = al256(WS_RTP + (size_t)NT * 4 * 4);
constexpr size_t WS_LIST  = al256(WS_RTG + (size_t)NT * 4 * 4);
constexpr size_t WS_ACT   = al256(WS_LIST + (size_t)NE * NT * 4);
constexpr size_t WS_Y2    = al256(WS_ACT + (size_t)MAXSLOT * FF * 2);
constexpr size_t WS_H8    = al256(WS_Y2 + (size_t)MAXSLOT * DM * 2);
constexpr size_t WS_RWT   = al256(WS_H8 + (size_t)NT * DM);
constexpr size_t WS_END   = al256(WS_RWT + (size_t)2 * NE * DM * 2);

struct Params {
    const float *x, *c, *ctx, *c_ctx, *w_ada, *b_ada, *g1w, *g2w, *w_in, *w_out, *na_qg, *na_kg, *na_rpb, *df_qg, *df_kg,
                *lq1, *lk1, *lq2, *lk2, *subln, *pool_w, *pool_scale, *fft_w, *router_w, *router_b, *w1, *b1, *w2, *b2;
    float* out;
    unsigned char* ws;
};
typedef __attribute__((address_space(1))) unsigned char g_u8;
__device__ __forceinline__ unsigned char* ws_base(unsigned char* w) { g_u8* g = (g_u8*)w; asm volatile("" : "+s"(g)); return (unsigned char*)g; }
#define WSP(T, off) ((T*)(ws_base(p.ws) + (off)))

__device__ __forceinline__ unsigned pk2(float lo, float hi) {
    typedef __bf16 bf2 __attribute__((ext_vector_type(2)));
    bf2 r = __builtin_convertvector((f32x2){lo, hi}, bf2);
    return *(unsigned*)&r;
}
__device__ __forceinline__ unsigned pk4_fp8(float a, float b, float c, float d) { int r = 0; r = __builtin_amdgcn_cvt_pk_fp8_f32(a, b, r, false); r = __builtin_amdgcn_cvt_pk_fp8_f32(c, d, r, true); return (unsigned)r; }
__device__ __forceinline__ bf16_t f2bf(float f) { return (bf16_t)(pk2(f, 0.f) & 0xffffu); }
__device__ __forceinline__ float bflo(unsigned u) { return __uint_as_float(u << 16); }
__device__ __forceinline__ float bfhi(unsigned u) { return __uint_as_float(u & 0xffff0000u); }
__device__ __forceinline__ float bf2f(bf16_t b) { return __uint_as_float(((unsigned)b) << 16); }
__device__ __forceinline__ float wave_sum(float v) {
#pragma unroll
    for (int o = 1; o < 64; o <<= 1) v += __shfl_xor(v, o);
    return v;
}
#define DPP_F(v, ctrl) __builtin_bit_cast(float, __builtin_amdgcn_update_dpp(0, __builtin_bit_cast(int, (v)), (ctrl), 0xf, 0xf, true))
__device__ __forceinline__ float sum8_dpp(float v)  { v += DPP_F(v, 0xB1); v += DPP_F(v, 0x4E); v += DPP_F(v, 0x141); return v; }
__device__ __forceinline__ float sum16_dpp(float v) { v += DPP_F(v, 0xB1); v += DPP_F(v, 0x4E); v += DPP_F(v, 0x141); v += DPP_F(v, 0x140); return v; }
__device__ __forceinline__ float wave_sum_fast(float v) {
    v += __builtin_bit_cast(float, __builtin_amdgcn_update_dpp(0, __builtin_bit_cast(int, v), 0xB1, 0xf, 0xf, true));
    v += __builtin_bit_cast(float, __builtin_amdgcn_update_dpp(0, __builtin_bit_cast(int, v), 0x4E, 0xf, 0xf, true));
    v += __builtin_bit_cast(float, __builtin_amdgcn_update_dpp(0, __builtin_bit_cast(int, v), 0x141, 0xf, 0xf, true));
    v += __builtin_bit_cast(float, __builtin_amdgcn_update_dpp(0, __builtin_bit_cast(int, v), 0x140, 0xf, 0xf, true));
    const float a = __builtin_bit_cast(float, __builtin_amdgcn_readlane(__builtin_bit_cast(int, v), 0)), b = __builtin_bit_cast(float, __builtin_amdgcn_readlane(__builtin_bit_cast(int, v), 16));
    const float c = __builtin_bit_cast(float, __builtin_amdgcn_readlane(__builtin_bit_cast(int, v), 32)), d = __builtin_bit_cast(float, __builtin_amdgcn_readlane(__builtin_bit_cast(int, v), 48));
    return (a + b) + (c + d);
}
__device__ __forceinline__ float wave_max(float v) {
#pragma unroll
    for (int o = 1; o < 64; o <<= 1) v = fmaxf(v, __shfl_xor(v, o));
    return v;
}
__device__ __forceinline__ int hid_tid() { int t = threadIdx.x; asm volatile("" : "+v"(t)); return t; }
__device__ __forceinline__ void unpack4(u32x2 r, float (&v)[4]) { v[0] = bflo(r.x); v[1] = bfhi(r.x); v[2] = bflo(r.y); v[3] = bfhi(r.y); }

__device__ __forceinline__ void mod_row(const float* xrow, const float* gw, const float* sh, const float* sc, bf16_t* orow, int lane, f32x4 (&hv)[4]) {
    f32x4 v[4]; float ss = 0.f;
#pragma unroll
    for (int j = 0; j < 4; ++j) { v[j] = ((const f32x4*)xrow)[lane + 64 * j]; ss += v[j].x * v[j].x + v[j].y * v[j].y + v[j].z * v[j].z + v[j].w * v[j].w; }
    ss = wave_sum_fast(ss);
    const float rs = rsqrtf(ss * (1.f / DM) + EPS);
#pragma unroll
    for (int j = 0; j < 4; ++j) {
        const int c = 4 * lane + 256 * j;
        const f32x4 g = *(const f32x4*)(gw + c), s1 = *(const f32x4*)(sc + c), s0 = *(const f32x4*)(sh + c);
        f32x4 o;
        o.x = v[j].x * rs * g.x * (1.f + s1.x) + s0.x; o.y = v[j].y * rs * g.y * (1.f + s1.y) + s0.y;
        o.z = v[j].z * rs * g.z * (1.f + s1.z) + s0.z; o.w = v[j].w * rs * g.w * (1.f + s1.w) + s0.w;
        hv[j] = o;
        u32x2 pk; pk.x = pk2(o.x, o.y); pk.y = pk2(o.z, o.w);
        *(u32x2*)(orow + c) = pk;
    }
}
__device__ __forceinline__ int mod_index(int r) { return r < NX ? (r >> 11) : 8; }

__device__ __forceinline__ void phase_pro0(const Params& p, unsigned char* smem) {
    float* act = (float*)smem;
    float* red = act + 9 * 1024;
    const int tid = hid_tid(), lane = tid & 63, wave = tid >> 6;
    for (int i = tid; i < 9 * 1024; i += 512) { const int r = i >> 10, k = i & 1023; const float v = (r < 8) ? p.c[r * 1024 + k] : p.c_ctx[k]; act[i] = v / (1.f + expf(-v)); }
    __syncthreads();
    float* MOD = WSP(float, WS_MOD);
    for (int item = blockIdx.x; item < 96; item += gridDim.x) {
        const int l = item / 48, ch = item % 48, hl = lane >> 5, cl = lane & 31;
        const float* w = p.w_ada + (size_t)l * 1024 * 6144 + ch * 128 + 4 * cl;
        f32x4 acc[9];
#pragma unroll
        for (int r = 0; r < 9; ++r) acc[r] = (f32x4){0.f, 0.f, 0.f, 0.f};
        const int k0 = wave * 128 + hl;
#pragma unroll 8
        for (int i = 0; i < 64; ++i) {
            const int k = k0 + 2 * i;
            const f32x4 wv = __builtin_nontemporal_load((const f32x4*)(w + (size_t)k * 6144));
#pragma unroll
            for (int r = 0; r < 9; ++r) { const float a = act[r * 1024 + k]; acc[r].x += a * wv.x; acc[r].y += a * wv.y; acc[r].z += a * wv.z; acc[r].w += a * wv.w; }
        }
#pragma unroll
        for (int r = 0; r < 9; ++r) {
            acc[r].x += __shfl_xor(acc[r].x, 32); acc[r].y += __shfl_xor(acc[r].y, 32); acc[r].z += __shfl_xor(acc[r].z, 32); acc[r].w += __shfl_xor(acc[r].w, 32);
            if (hl == 0) *(f32x4*)(red + (wave * 9 + r) * 128 + 4 * cl) = acc[r];
        }
        __syncthreads();
        for (int i = tid; i < 9 * 128; i += 512) {
            const int r = i >> 7, cc = i & 127; float s = 0.f;
#pragma unroll
            for (int w8 = 0; w8 < 8; ++w8) s += red[(w8 * 9 + r) * 128 + cc];
            MOD[(size_t)(l * 9 + r) * 6144 + ch * 128 + cc] = s + p.b_ada[l * 6144 + ch * 128 + cc];
        }
        __syncthreads();
    }
    if (blockIdx.x == gridDim.x - 2) {
        float* RT = WSP(float, WS_ROPE);
        const int pos = tid >> 3, f = tid & 7; const float ang = (float)pos * expf(-(float)f * 1.151292546497023f);
        RT[2 * tid] = cosf(ang); RT[2 * tid + 1] = sinf(ang);
    }
    if (blockIdx.x == gridDim.x - 1 && wave == 0) {
        float* SC = WSP(float, WS_SCAL);
        for (int l = 0; l < 2; ++l) {
            float s1 = lane < 32 ? p.lq1[l * 32 + lane] * p.lk1[l * 32 + lane] : 0.f;
            float s2 = lane < 32 ? p.lq2[l * 32 + lane] * p.lk2[l * 32 + lane] : 0.f;
            s1 = wave_sum(s1); s2 = wave_sum(s2);
            const float lam_init = 0.8f - 0.6f * expf(-0.3f * (float)l);
            const float lam = expf(s1) - expf(s2) + lam_init;
            const float mq = wave_max(lane < 32 ? fabsf(p.df_qg[l * 32 + lane]) : 0.f), mk = wave_max(lane < 32 ? fabsf(p.df_kg[l * 32 + lane]) : 0.f);
            const float aq = wave_max(fabsf(p.na_qg[l * 64 + lane])), ak = wave_max(fabsf(p.na_kg[l * 64 + lane]));
            if (lane == 0) { SC[l * 16 + 0] = lam; SC[l * 16 + 1] = lam_init; SC[l * 16 + 2] = 5.656854249f * 1.44269504f * mq * mk; }
            for (int h = 0; h < 4; ++h) {
                float mb = 0.f;
                for (int i = lane; i < 15 * 31; i += 64) mb = fmaxf(mb, p.na_rpb[((size_t)(l * 4 + h)) * 465 + i]);
                mb = wave_max(mb);
                if (lane == 0) SC[l * 16 + 4 + h] = (8.f * aq * ak + mb) * 1.44269504f;
            }
        }
    }
    asm volatile("s_waitcnt vmcnt(0)" ::: "memory");
    __syncthreads();
    if (tid == 0) {
        __builtin_amdgcn_fence(__ATOMIC_RELEASE, "agent");
        asm volatile("s_waitcnt vmcnt(0)" ::: "memory");
        __hip_atomic_fetch_add(WSP(unsigned, WS_CTL + CTL_PRO0), 1u, __ATOMIC_RELAXED, __HIP_MEMORY_SCOPE_AGENT);
    }
}

__device__ __forceinline__ void transpose_item(const float* W, int ldw, int K, bf16_t* WT, unsigned char* sm, int kb, int nb, int lane) {
    const int q = lane >> 4, c4 = lane & 15;
    const float* src = W + (size_t)(64 * kb + 16 * q) * ldw + 64 * nb + 4 * c4;
    f32x4 r[16];
#pragma unroll
    for (int j = 0; j < 16; ++j) r[j] = *(const f32x4*)(src + (size_t)j * ldw);
#pragma unroll
    for (int c = 0; c < 4; ++c) {
        u32x4 o0, o1;
        o0.x = pk2(r[0][c], r[1][c]); o0.y = pk2(r[2][c], r[3][c]); o0.z = pk2(r[4][c], r[5][c]); o0.w = pk2(r[6][c], r[7][c]);
        o1.x = pk2(r[8][c], r[9][c]); o1.y = pk2(r[10][c], r[11][c]); o1.z = pk2(r[12][c], r[13][c]); o1.w = pk2(r[14][c], r[15][c]);
        unsigned char* d = sm + (4 * c4 + c) * 144 + 32 * q;
        *(u32x4*)d = o0; *(u32x4*)(d + 16) = o1;
    }
    __builtin_amdgcn_s_waitcnt(0xc07f); asm volatile("" ::: "memory");
    bf16_t* dst = WT + (size_t)(64 * nb + (lane >> 3)) * K + 64 * kb + 8 * (lane & 7);
#pragma unroll
    for (int i = 0; i < 8; ++i) { const u32x4 o = *(const u32x4*)(sm + (8 * i + (lane >> 3)) * 144 + 16 * (lane & 7)); *(u32x4*)(dst + (size_t)(8 * i) * K) = o; }
    __builtin_amdgcn_s_waitcnt(0xc07f); asm volatile("" ::: "memory");
}

__device__ __forceinline__ void transpose_item8(const float* W, int ldw, int K, unsigned char* WT, unsigned char* sm, int kb, int nb, int lane) {
    const int q = lane >> 4, c4 = lane & 15;
    const float* src = W + (size_t)(64 * kb + 16 * q) * ldw + 64 * nb + 4 * c4;
    f32x4 r[16];
#pragma unroll
    for (int j = 0; j < 16; ++j) r[j] = *(const f32x4*)(src + (size_t)j * ldw) * SW8;
#pragma unroll
    for (int c = 0; c < 4; ++c) {
        u32x4 o; o.x = pk4_fp8(r[0][c], r[1][c], r[2][c], r[3][c]); o.y = pk4_fp8(r[4][c], r[5][c], r[6][c], r[7][c]);
        o.z = pk4_fp8(r[8][c], r[9][c], r[10][c], r[11][c]); o.w = pk4_fp8(r[12][c], r[13][c], r[14][c], r[15][c]);
        *(u32x4*)(sm + (4 * c4 + c) * 80 + 16 * q) = o;
    }
    __builtin_amdgcn_s_waitcnt(0xc07f); asm volatile("" ::: "memory");
    unsigned char* dst = WT + (size_t)(64 * nb + (lane >> 2)) * K + 64 * kb + 16 * (lane & 3);
#pragma unroll
    for (int i = 0; i < 4; ++i) { const u32x4 o = *(const u32x4*)(sm + (16 * i + (lane >> 2)) * 80 + 16 * (lane & 3)); *(u32x4*)(dst + (size_t)(16 * i) * K) = o; }
    __builtin_amdgcn_s_waitcnt(0xc07f); asm volatile("" ::: "memory");
}

__device__ __forceinline__ void phase_pro1(const Params& p, unsigned char* smem) {
    const int tid = hid_tid(), lane = tid & 63, wave = tid >> 6;
    const int gw = blockIdx.x * 8 + wave, ngw = gridDim.x * 8;
    bf16_t* WIN = WSP(bf16_t, WS_WIN);
    {
        float* Mf = (float*)smem;
        float* tile = Mf + 4096 + wave * (64 * 65);
        float* trig = Mf + 4096 + 8 * (64 * 65);
        if (tid < 128) { const int i = tid & 63; const float a = (float)i * (1.f / 32.f); trig[tid] = tid < 64 ? cospif(a) : sinpif(a); }
        __syncthreads();
        for (int rep_ = 0; rep_ < REP_FOLD; ++rep_)
        for (int it = blockIdx.x; it < 96; it += gridDim.x) {
            const int kq = it & 3, g = (it >> 2) & 3, kind = (it >> 4) % 3, l = it / 48;
            for (int i = tid; i < 4096; i += 512) {
                const int cch = i >> 6, e = i & 63; float v;
                if (kind == 0) v = p.pool_w[((size_t)(l * 4 + g) * 64 + cch) * 64 + e] * p.pool_scale[l * 256 + g * 64 + e];
                else {
                    const float* fw = p.fft_w + (size_t)(l * 4 + g) * 4096 + e; const float* tb = trig + (kind == 1 ? 0 : 64);
                    float s = 0.f;
#pragma unroll 8
                    for (int m = 0; m < 64; ++m) s += tb[(m * cch) & 63] * fw[m * 64];
                    v = s * 0.125f;
                }
                Mf[i] = v;
            }
            __syncthreads();
            const int srcb = (kind == 0 ? 1536 : 1792) + 64 * g, dstb = (kind == 0 ? 1536 : (kind == 1 ? 1792 : 2048)) + 64 * g;
            {
                const int kb = 4 * kq + (wave & 3), eh = wave >> 2;
                for (int i = 0; i < 64; ++i) tile[i * 65 + lane] = p.w_in[((size_t)l * 1024 + 64 * kb + i) * 2048 + srcb + lane];
                __builtin_amdgcn_s_waitcnt(0xc07f); asm volatile("" ::: "memory");
                float acc[32];
#pragma unroll
                for (int e = 0; e < 32; ++e) acc[e] = 0.f;
                for (int cch = 0; cch < 64; ++cch) {
                    const float a = tile[lane * 65 + cch];
#pragma unroll
                    for (int e = 0; e < 32; ++e) acc[e] += a * Mf[cch * 64 + eh * 32 + e];
                }
#pragma unroll
                for (int e = 0; e < 32; ++e) WIN[((size_t)l * NIN + dstb + eh * 32 + e) * 1024 + 64 * kb + lane] = f2bf(acc[e]);
                __builtin_amdgcn_s_waitcnt(0xc07f); asm volatile("" ::: "memory");
            }
            __syncthreads();
        }
    }
    {
        unsigned char* tsm = smem + wave * (64 * 144);
        __syncthreads();
        constexpr int I_IN = 16 * 24, I_OUT = 16 * 16;
        constexpr int T0 = 2 * I_IN, T1 = T0 + 2 * I_OUT;
        for (int rep_ = 0; rep_ < REP_TR; ++rep_)
        for (int it = gw; it < T1; it += ngw) {
            if (it < T0) { const int l = it / I_IN, r = it % I_IN; transpose_item(p.w_in + (size_t)l * 1024 * 2048, 2048, 1024, WIN + (size_t)l * NIN * 1024, tsm, r % 16, r / 16, lane); }
            else { const int q = it - T0, l = q / I_OUT, r = q % I_OUT; transpose_item(p.w_out + (size_t)l * 1024 * 1024, 1024, 1024, WSP(bf16_t, WS_WOUT) + (size_t)l * 1024 * 1024, tsm, r % 16, r / 16, lane); }
        }
    }
    {
        bf16_t* DM_ = WSP(bf16_t, WS_DFTM); bf16_t* DC_ = WSP(bf16_t, WS_DFTC);
        const int gt = blockIdx.x * 512 + tid, ngt = gridDim.x * 512;
        for (int i = gt; i < 2048 * 256; i += ngt) {
            const int k = i >> 8, j0 = (i & 255) * 8; unsigned o[4];
#pragma unroll
            for (int q = 0; q < 4; ++q) { float v[2];
#pragma unroll
                for (int e = 0; e < 2; ++e) { const int j = j0 + 2 * q + e;
                    if (j <= 1024) { const int ph = (k * j) & 2047; v[e] = cospif((float)ph * (1.f / 1024.f)) * 0.02209708691f; }
                    else { const int ph = (k * (j - 1024)) & 2047; v[e] = -sinpif((float)ph * (1.f / 1024.f)) * 0.02209708691f; } }
                o[q] = pk2(v[0], v[1]); }
            *(u32x4*)(DM_ + (size_t)k * 2048 + j0) = (u32x4){o[0], o[1], o[2], o[3]};
        }
        for (int i = gt; i < 256 * 32; i += ngt) {
            const int k = i >> 5, j0 = (i & 31) * 8; unsigned o[4];
#pragma unroll
            for (int q = 0; q < 4; ++q) { float v[2];
#pragma unroll
                for (int e = 0; e < 2; ++e) { const int j = j0 + 2 * q + e;
                    if (j <= 128) { const int ph = (k * j) & 255; v[e] = cospif((float)ph * (1.f / 128.f)) * 0.0625f; }
                    else { const int ph = (k * (j - 128)) & 255; v[e] = -sinpif((float)ph * (1.f / 128.f)) * 0.0625f; } }
                o[q] = pk2(v[0], v[1]); }
            *(u32x4*)(DC_ + (size_t)k * 256 + j0) = (u32x4){o[0], o[1], o[2], o[3]};
        }
    }
    {
        bf16_t* RWT = WSP(bf16_t, WS_RWT);
        const int gt = blockIdx.x * 512 + tid, ngt = gridDim.x * 512;
        for (int i = gt; i < 2 * 32 * 128; i += ngt) {
            const int l = i >> 12, e = (i >> 7) & 31, k0 = (i & 127) * 8;
            const float* s = p.router_w + ((size_t)l * 1024 + k0) * 32 + e;
            u32x4 o; o.x = pk2(s[0], s[32]); o.y = pk2(s[64], s[96]); o.z = pk2(s[128], s[160]); o.w = pk2(s[192], s[224]);
            *(u32x4*)(RWT + ((size_t)(l * 32 + e)) * 1024 + k0) = o;
        }
    }
    {
        if (tid == 0) {
            unsigned* cnt = WSP(unsigned, WS_CTL + CTL_PRO0); unsigned sp = 0;
            while (__hip_atomic_load(cnt, __ATOMIC_RELAXED, __HIP_MEMORY_SCOPE_AGENT) < gridDim.x) { __builtin_amdgcn_s_sleep(2); if (++sp > (1u << 22)) break; }
            __builtin_amdgcn_fence(__ATOMIC_ACQUIRE, "agent");
            asm volatile("s_waitcnt vmcnt(0)" ::: "memory");
        }
        __syncthreads();
    }
    {
        const float* MOD = WSP(float, WS_MOD); bf16_t* H = WSP(bf16_t, WS_H);
        for (int r = gw; r < NT; r += ngw) {
            const float* xr = r < NX ? p.x + (size_t)r * DM : p.ctx + (size_t)(r - NX) * DM;
            const float* m = MOD + (size_t)(0 * 9 + mod_index(r)) * 6144;
            f32x4 hv[4];
            mod_row(xr, p.g1w, m, m + 1024, H + (size_t)r * DM, lane, hv);
        }
    }
}

enum { G_WIN = 0, G_DFT = 1, G_DFTC = 2, G_WOUT = 3, G_MOE1 = 4, G_MOE2 = 5 };
__device__ __forceinline__ void moe_tinfo(const Params& p, int l, int* tinfo) {
    if (threadIdx.x == 0) {
        const int* cnt = WSP(int, WS_CTL + CTL_CNT) + l * 32; int s = 0;
        for (int e = 0; e < 32; ++e) { const int c = cnt[e]; tinfo[e] = s; tinfo[33 + e] = c; s += (c + 255) >> 8; }
        tinfo[32] = s;
    }
    __syncthreads();
}

#define LAS __attribute__((address_space(3)))
namespace g8 {
constexpr int BM = 256, BK = 64, HALF = 128, HTB = HALF * BK * 2, STAGE_BYTES = 8 * HTB, NXCD = 8, WGM = 8;
__host__ __device__ __forceinline__ int lds_xor(int r) { return (((r >> 1) & 1) * 3) | (r & 4); }
__host__ __device__ __forceinline__ int lds_byte(int r, int c) { return r * 128 + ((((c >> 3) ^ lds_xor(r)) & 7) << 4); }
__host__ __device__ __forceinline__ void stage_rc(int b, int& R, int& C) { const int r = b >> 7, cp = (b >> 4) & 7; R = r; C = ((cp ^ lds_xor(r)) & 7) * 8; }
}
struct UnitD { unsigned boff; const int* gather; int arow0, nvalid, orow0, ocol0, e; };
template <int KIND> __device__ __forceinline__ void phase_geom(int l, const int* tinfo, int& nM, int& nN, int& K) {
    if (KIND == G_WIN) { nM = 72; nN = 9; K = 1024; }
    else if (KIND == G_DFT) { nM = 8; nN = 8; K = 2048; }
    else if (KIND == G_DFTC) { nM = 1; nN = 8; K = 256; }
    else if (KIND == G_WOUT) { nM = (l == 0) ? 72 : 64; nN = 4; K = 1024; }
    else if (KIND == G_MOE1) { nM = __builtin_amdgcn_readfirstlane(tinfo[32]); nN = 8; K = 1024; }
    else { nM = __builtin_amdgcn_readfirstlane(tinfo[32]); nN = 4; K = 1024; }
}
template <int KIND> __device__ __forceinline__ const bf16_t* phase_A(const Params& p) {
    if (KIND == G_WIN) return WSP(bf16_t, WS_H);
    if (KIND == G_MOE1) return (const bf16_t*)WSP(unsigned char, WS_H8);
    if (KIND == G_DFT) return WSP(bf16_t, WS_DFTM);
    if (KIND == G_DFTC) return WSP(bf16_t, WS_DFTC);
    if (KIND == G_WOUT) return WSP(bf16_t, WS_YCAT);
    return WSP(bf16_t, WS_ACT);
}
template <int KIND> __device__ __forceinline__ const void* phase_B(const Params& p, int l) {
    if (KIND == G_WIN) return WSP(bf16_t, WS_WIN) + (size_t)l * NIN * 1024;
    if (KIND == G_DFT) return WSP(bf16_t, WS_XF);
    if (KIND == G_DFTC) return WSP(bf16_t, WS_XFC);
    if (KIND == G_WOUT) return WSP(bf16_t, WS_WOUT) + (size_t)l * 1024 * 1024;
    if (KIND == G_MOE1) return WSP(unsigned char, WS_W1) + (size_t)l * NE * 2048 * 1024;
    return WSP(unsigned char, WS_W2) + (size_t)l * NE * 1024 * 1024;
}
template <int KIND> __device__ __forceinline__ void get_unit(const Params& p, int l, int pm, int pn, const int* tinfo, UnitD& u) {
    u.gather = nullptr; u.nvalid = 256; u.e = 0; u.arow0 = pm * 256; u.orow0 = pm * 256; u.ocol0 = pn * 256;
    if (KIND == G_WIN) u.boff = (unsigned)pn * 256u * 1024u * 2u;
    else if (KIND == G_DFT) u.boff = (unsigned)pn * 256u * 2048u * 2u;
    else if (KIND == G_DFTC) u.boff = (unsigned)pn * 256u * 256u * 2u;
    else if (KIND == G_WOUT) u.boff = (unsigned)pn * 256u * 1024u * 2u;
    else {
        int e = 0; while (tinfo[e + 1] <= pm) ++e;
        e = __builtin_amdgcn_readfirstlane(e); u.e = e;
        if (KIND == G_MOE1) { u.gather = WSP(int, WS_LIST) + (size_t)e * NT; u.arow0 = __builtin_amdgcn_readfirstlane((pm - tinfo[e]) * 256); u.nvalid = __builtin_amdgcn_readfirstlane(tinfo[33 + e]) - u.arow0;
                              u.boff = (unsigned)(e * 2048 + pn * 256) * 1024u; }
        else u.boff = (unsigned)(e * 1024 + pn * 256) * 1024u;
    }
}
__device__ __forceinline__ bool static_order(int i, int G, int c, int nM, int nN, int& pm, int& pn) {
    const int nwg = nM * nN; const long L = (long)i * G + c; if (L >= nwg) return false;
    int wgid = (int)L; { const int q = nwg / g8::NXCD, r = nwg % g8::NXCD, xcd = wgid % g8::NXCD, off = wgid / g8::NXCD; wgid = (xcd < r ? xcd * (q + 1) : r * (q + 1) + (xcd - r) * q) + off; }
    const int nig = g8::WGM * nN, gid = wgid / nig, fm = gid * g8::WGM, gsz = (nM - fm) < g8::WGM ? (nM - fm) : g8::WGM;
    pm = fm + ((wgid % nig) % gsz); pn = (wgid % nig) / gsz; return true;
}
template <int KIND>
__device__ __forceinline__ void gemm_phase256(const Params& p, const int l, LAS unsigned char* lds, const int* tinfo) {
    using namespace g8;
    const int tid = hid_tid(), wid = __builtin_amdgcn_readfirstlane(tid >> 6), lane = tid & 63, wr = wid >> 2, wc = wid & 3, fr = lane & 15, fq = lane >> 4;
    int nM, nN, K; phase_geom<KIND>(l, tinfo, nM, nN, K);
    constexpr bool F8 = (KIND == G_MOE1 || KIND == G_MOE2);
    constexpr int ES = F8 ? 1 : 2;
    constexpr int KREP = F8 ? REP_KL8 : REP_KL16;
    const int nt1 = K * ES / 128, nt = nt1 * KREP, G = gridDim.x, cwg = blockIdx.x;
    const __amdgpu_buffer_rsrc_t rsA = __builtin_amdgcn_make_buffer_rsrc((void*)phase_A<KIND>(p), 0, 0x7ffffff0, 0x00020000);
    const __amdgpu_buffer_rsrc_t rsB = __builtin_amdgcn_make_buffer_rsrc((void*)phase_B<KIND>(p, l), 0, 0x7ffffff0, 0x00020000);
    unsigned voffB[2];
#pragma unroll
    for (int i = 0; i < 2; ++i) { int R_, C_; stage_rc(tid * 16 + i * 8192, R_, C_);
        const int rho = R_ & 31, Rb = (R_ & ~31) + 8 * ((rho & 15) >> 2) + 4 * (rho >> 4) + (rho & 3);
        voffB[i] = (unsigned)(Rb * K * ES + C_ * 2); }
    const unsigned kstep = 128u, hstepB = (unsigned)(HALF * K * ES);
    const unsigned ldsw = (unsigned)wid * 1024u;
    int aoffL[2], boffL[2];
    { const int ra = wr * 64 + fr, rb = wc * 32 + fr;
      if (F8) { aoffL[0] = lds_byte(ra, 16 * fq); aoffL[1] = lds_byte(ra, 16 * fq + 8); boffL[0] = lds_byte(rb, 16 * fq); boffL[1] = lds_byte(rb, 16 * fq + 8); }
      else { aoffL[0] = lds_byte(ra, fq * 8); aoffL[1] = lds_byte(ra, fq * 8 + 32); boffL[0] = lds_byte(rb, fq * 8); boffL[1] = lds_byte(rb, fq * 8 + 32); } }
#define G8_SA(b, h) (((b) * 2 + (h)) * HTB)
#define G8_SB(b, h) ((4 + (b) * 2 + (h)) * HTB)
#define G8_STAGE_A(bufoff, ktb, h) do { _Pragma("unroll") for (int _i = 0; _i < 2; ++_i) \
        __builtin_amdgcn_raw_ptr_buffer_load_lds(rsA, (LAS void*)(lds + (bufoff) + ldsw + _i * 8192), 16, aoff[h][_i], (int)(ktb), 0, 0); } while (0)
#define G8_STAGE_B(bufoff, soff) do { _Pragma("unroll") for (int _i = 0; _i < 2; ++_i) \
        __builtin_amdgcn_raw_ptr_buffer_load_lds(rsB, (LAS void*)(lds + (bufoff) + ldsw + _i * 8192), 16, voffB[_i], (int)(soff), 0, 0); } while (0)
#define G8_LDA(dst, b, h) do { _Pragma("unroll") for (int m = 0; m < 4; ++m) _Pragma("unroll") for (int k = 0; k < 2; ++k) { const u32x4 _v = *(const LAS u32x4*)(lds + G8_SA(b, h) + aoffL[k] + m * 2048); dst[m][4 * k] = (int)_v.x; dst[m][4 * k + 1] = (int)_v.y; dst[m][4 * k + 2] = (int)_v.z; dst[m][4 * k + 3] = (int)_v.w; } } while (0)
#define G8_LDB(dst, b, h) do { _Pragma("unroll") for (int n = 0; n < 2; ++n) _Pragma("unroll") for (int k = 0; k < 2; ++k) { const u32x4 _v = *(const LAS u32x4*)(lds + G8_SB(b, h) + boffL[k] + n * 2048); dst[n][4 * k] = (int)_v.x; dst[n][4 * k + 1] = (int)_v.y; dst[n][4 * k + 2] = (int)_v.z; dst[n][4 * k + 3] = (int)_v.w; } } while (0)
#define G8_MMA(ai, bj, At, Bt) do { __builtin_amdgcn_s_setprio(1); _Pragma("unroll") for (int m = 0; m < 4; ++m) _Pragma("unroll") for (int n = 0; n < 2; ++n) { \
        if (F8) acc[ai][bj][m][n] = __builtin_amdgcn_mfma_scale_f32_16x16x128_f8f6f4(Bt[n], At[m], acc[ai][bj][m][n], 0, 0, 0, 0, 0, 0); \
        else { typedef int i32x4_ __attribute__((ext_vector_type(4))); \
               const i32x4_ _a0 = __builtin_shufflevector(At[m], At[m], 0, 1, 2, 3), _a1 = __builtin_shufflevector(At[m], At[m], 4, 5, 6, 7); \
               const i32x4_ _b0 = __builtin_shufflevector(Bt[n], Bt[n], 0, 1, 2, 3), _b1 = __builtin_shufflevector(Bt[n], Bt[n], 4, 5, 6, 7); \
               acc[ai][bj][m][n] = __builtin_amdgcn_mfma_f32_16x16x32_bf16(*(const bf16x8*)&_b0, *(const bf16x8*)&_a0, acc[ai][bj][m][n], 0, 0, 0); \
               acc[ai][bj][m][n] = __builtin_amdgcn_mfma_f32_16x16x32_bf16(*(const bf16x8*)&_b1, *(const bf16x8*)&_a1, acc[ai][bj][m][n], 0, 0, 0); } } \
        __builtin_amdgcn_s_setprio(0); } while (0)
#define G8_WAIT_V(n) asm volatile("s_waitcnt vmcnt(" #n ")" ::: "memory")
#define G8_WAIT_L(n) asm volatile("s_waitcnt lgkmcnt(" #n ")" ::: "memory")
#define G8_BAR __builtin_amdgcn_s_barrier()
#define G8_SCHED __builtin_amdgcn_sched_barrier(0)
#define G8_AOFF(dst, u) do { _Pragma("unroll") for (int _h = 0; _h < 2; ++_h) _Pragma("unroll") for (int _i = 0; _i < 2; ++_i) { int _R, _C; stage_rc(tid * 16 + _i * 8192, _R, _C); const int _rt = _h * 128 + _R; int _ar; \
        if (KIND == G_MOE1) _ar = (u).gather[(u).arow0 + (_rt < (u).nvalid ? _rt : -(u).arow0)]; else _ar = (u).arow0 + _rt; \
        dst[_h][_i] = (unsigned)(_ar * K * ES + _C * 2); } } while (0)
    UnitD cur, nxt; int ui = 0, pm, pn;
    if (!static_order(0, G, cwg, nM, nN, pm, pn)) return;
    get_unit<KIND>(p, l, pm, pn, tinfo, cur);
    unsigned aoff[2][2]; G8_AOFF(aoff, cur);
    f32x4 acc[2][2][4][2];
#pragma unroll
    for (int a = 0; a < 2; ++a)
#pragma unroll
        for (int b = 0; b < 2; ++b)
#pragma unroll
            for (int m = 0; m < 4; ++m)
#pragma unroll
                for (int n = 0; n < 2; ++n) acc[a][b][m][n] = (f32x4){0.f, 0.f, 0.f, 0.f};
    i32x8 At[4], B0[2], B1[2];
    unsigned cB = cur.boff;
    G8_STAGE_B(G8_SB(0, 0), cB); G8_STAGE_A(G8_SA(0, 0), 0, 0); G8_STAGE_B(G8_SB(0, 1), cB + hstepB); G8_STAGE_A(G8_SA(0, 1), 0, 1);
    if (wr == 1) G8_BAR;
    G8_WAIT_V(4); G8_BAR;
    G8_STAGE_B(G8_SB(1, 0), cB + kstep); G8_STAGE_A(G8_SA(1, 0), kstep, 0); G8_STAGE_B(G8_SB(1, 1), cB + hstepB + kstep);
    G8_WAIT_V(6); G8_BAR;
    for (;;) {
        const bool has_next = static_order(ui + 1, G, cwg, nM, nN, pm, pn);
        if (has_next) get_unit<KIND>(p, l, pm, pn, tinfo, nxt);
        const unsigned nB = has_next ? nxt.boff : cB;
        if ((KIND == G_MOE1 || KIND == G_MOE2) && wid == 0) {
            const float* bsrc = ((KIND == G_MOE1) ? p.b1 + (size_t)(l * NE + cur.e) * 2048 : p.b2 + (size_t)(l * NE + cur.e) * 1024) + cur.ocol0 + 4 * lane;
            __builtin_amdgcn_global_load_lds((const unsigned*)bsrc, (LAS unsigned*)(lds + STAGE_BYTES + (ui & 1) * 1024), 16, 0, 0);
            if (KIND == G_MOE1 && has_next)
                __builtin_amdgcn_global_load_lds((const unsigned*)(nxt.gather + nxt.arow0 + 4 * lane), (LAS unsigned*)(lds + STAGE_BYTES + 2048 + ((ui + 1) & 1) * 1024), 16, 0, 0);
        }
#pragma unroll 1
        for (int t = 0; t < nt; t += 2) {
            const bool last = (t == nt - 2);
            if (KREP > 1 && t == nt - nt1) {
#pragma unroll
                for (int a = 0; a < 2; ++a)
#pragma unroll
                    for (int b = 0; b < 2; ++b)
#pragma unroll
                        for (int m = 0; m < 4; ++m)
#pragma unroll
                            for (int n = 0; n < 2; ++n) acc[a][b][m][n] = (f32x4){0.f, 0.f, 0.f, 0.f};
            }
            unsigned naoff1[2];
            if (KIND == G_MOE1 && last && has_next) {
                const LAS int* itab = (const LAS int*)(lds + STAGE_BYTES + 2048 + ((ui + 1) & 1) * 1024);
#pragma unroll
                for (int _i = 0; _i < 2; ++_i) { int _R, _C; stage_rc(tid * 16 + _i * 8192, _R, _C);
                    const int _r0 = _R, _r1 = 128 + _R;
                    const int a0 = itab[_r0 < nxt.nvalid ? _r0 : 0], a1 = itab[_r1 < nxt.nvalid ? _r1 : 0];
                    aoff[0][_i] = (unsigned)(a0 * K * ES + _C * 2); naoff1[_i] = (unsigned)(a1 * K * ES + _C * 2); }
            }
            G8_LDB(B0, 0, 0); G8_SCHED; G8_LDA(At, 0, 0); G8_STAGE_A(G8_SA(1, 1), (unsigned)((t + 1) & (nt1 - 1)) * kstep, 1);
            G8_WAIT_L(8); G8_BAR; G8_WAIT_L(0); G8_MMA(0, 0, At, B0); G8_BAR; G8_SCHED;
            unsigned kt2 = (unsigned)((t + 2) & (nt1 - 1)) * kstep; unsigned b2 = cB + kt2;
            if (last) { kt2 = 0; b2 = nB; if (has_next) { if (KIND == G_MOE1) { aoff[1][0] = naoff1[0]; aoff[1][1] = naoff1[1]; } else G8_AOFF(aoff, nxt); } }
            G8_LDB(B1, 0, 1); G8_STAGE_B(G8_SB(0, 0), b2);
            G8_BAR; G8_WAIT_L(0); G8_MMA(0, 1, At, B1); G8_BAR;
            G8_LDA(At, 0, 1); G8_STAGE_A(G8_SA(0, 0), kt2, 0);
            G8_BAR; G8_WAIT_L(0); G8_MMA(1, 0, At, B0); G8_BAR; G8_SCHED;
            G8_STAGE_B(G8_SB(0, 1), b2 + hstepB);
            G8_WAIT_V(6); G8_BAR; G8_MMA(1, 1, At, B1); G8_BAR;
            G8_LDB(B0, 1, 0); G8_SCHED; G8_LDA(At, 1, 0); G8_STAGE_A(G8_SA(0, 1), kt2, 1);
            G8_WAIT_L(8); G8_BAR; G8_WAIT_L(0); G8_MMA(0, 0, At, B0); G8_BAR; G8_SCHED;
            G8_LDB(B1, 1, 1); G8_STAGE_B(G8_SB(1, 0), b2 + kstep);
            G8_BAR; G8_WAIT_L(0); G8_MMA(0, 1, At, B1); G8_BAR;
            G8_LDA(At, 1, 1); G8_STAGE_A(G8_SA(1, 0), kt2 + kstep, 0);
            G8_BAR; G8_WAIT_L(0); G8_MMA(1, 0, At, B0); G8_BAR; G8_SCHED;
            G8_STAGE_B(G8_SB(1, 1), b2 + kstep + hstepB);
            G8_WAIT_V(6); G8_BAR; G8_MMA(1, 1, At, B1); G8_BAR;
        }
        {
            const int r0 = wr * 64 + fr, c0 = wc * 32 + 8 * fq;
            f32x4 cv[2][2];
            if (KIND == G_MOE1 || KIND == G_MOE2 || KIND == G_WOUT) {
                const float* cbase = WSP(float, WS_MOD) + (size_t)(l * 9 + mod_index(cur.orow0)) * 6144 + 2048;
#pragma unroll
                for (int bj = 0; bj < 2; ++bj)
#pragma unroll
                    for (int n = 0; n < 2; ++n) {
                        if (KIND == G_WOUT) cv[bj][n] = *(const f32x4*)(cbase + cur.ocol0 + bj * HALF + c0 + 4 * n);
                        else cv[bj][n] = *(const LAS f32x4*)(lds + STAGE_BYTES + (ui & 1) * 1024 + (bj * HALF + c0 + 4 * n) * 4);
                    }
            }
#pragma unroll
            for (int ai = 0; ai < 2; ++ai) {
                if (KIND == G_WOUT) {
                    f32x4 xv[4][2][2];
#pragma unroll
                    for (int m = 0; m < 4; ++m) {
                        const int row = cur.orow0 + ai * HALF + r0 + m * 16;
                        if (l == 0) {
                            const float* xin = row < NX ? p.x + (size_t)row * DM : p.ctx + (size_t)(row - NX) * DM;
#pragma unroll
                            for (int bj = 0; bj < 2; ++bj)
#pragma unroll
                                for (int n = 0; n < 2; ++n) xv[m][bj][n] = *(const f32x4*)(xin + cur.ocol0 + bj * HALF + c0 + 4 * n);
                        } else {
#pragma unroll
                            for (int bj = 0; bj < 2; ++bj) { const u32x4 w = *(const u32x4*)(WSP(bf16_t, WS_X2) + (size_t)row * DM + cur.ocol0 + bj * HALF + c0);
                                xv[m][bj][0] = (f32x4){bflo(w.x), bfhi(w.x), bflo(w.y), bfhi(w.y)}; xv[m][bj][1] = (f32x4){bflo(w.z), bfhi(w.z), bflo(w.w), bfhi(w.w)}; }
                        }
                    }
#pragma unroll
                    for (int m = 0; m < 4; ++m) {
                        const int row = cur.orow0 + ai * HALF + r0 + m * 16;
#pragma unroll
                        for (int bj = 0; bj < 2; ++bj) {
                            const f32x4 v0 = acc[ai][bj][m][0], v1 = acc[ai][bj][m][1], g0 = cv[bj][0], g1 = cv[bj][1], x0 = xv[m][bj][0], x1 = xv[m][bj][1];
                            u32x4 o; o.x = pk2(x0.x + g0.x * v0.x, x0.y + g0.y * v0.y); o.y = pk2(x0.z + g0.z * v0.z, x0.w + g0.w * v0.w);
                            o.z = pk2(x1.x + g1.x * v1.x, x1.y + g1.y * v1.y); o.w = pk2(x1.z + g1.z * v1.z, x1.w + g1.w * v1.w);
                            *(u32x4*)(WSP(bf16_t, WS_X1) + (size_t)row * DM + cur.ocol0 + bj * HALF + c0) = o;
                        }
                    }
                } else {
#pragma unroll
                    for (int m = 0; m < 4; ++m) {
                        const int row = cur.orow0 + ai * HALF + r0 + m * 16;
#pragma unroll
                        for (int bj = 0; bj < 2; ++bj) {
                            const f32x4 v0 = acc[ai][bj][m][0], v1 = acc[ai][bj][m][1]; const int col = cur.ocol0 + bj * HALF + c0;
                            if (KIND == G_MOE1) {
                                constexpr float dq = 1.f / (SW8 * SH8);
                                const f32x4 b0 = cv[bj][0], b1 = cv[bj][1];
                                const float u[8] = {v0.x * dq + b0.x, v0.y * dq + b0.y, v0.z * dq + b0.z, v0.w * dq + b0.w, v1.x * dq + b1.x, v1.y * dq + b1.y, v1.z * dq + b1.z, v1.w * dq + b1.w};
                                float o[4];
#pragma unroll
                                for (int q = 0; q < 4; ++q) { const float g = fminf(u[2 * q], 7.f), li = fminf(fmaxf(u[2 * q + 1], -7.f), 7.f);
                                    o[q] = g * __builtin_amdgcn_rcpf(1.f + __builtin_amdgcn_exp2f(-2.45546696f * g)) * (li + 1.f) * SA8; }
                                *(unsigned*)(WSP(unsigned char, WS_ACT) + (size_t)row * FF + (col >> 1)) = pk4_fp8(o[0], o[1], o[2], o[3]);
                            } else if (KIND == G_MOE2) {
                                constexpr float dq = SY8 / (SW8 * SA8);
                                const f32x4 b0 = cv[bj][0] * SY8, b1 = cv[bj][1] * SY8;
#define CL8(x) fminf(fmaxf((x), -448.f), 448.f)
                                u32x2 o; o.x = pk4_fp8(CL8(v0.x * dq + b0.x), CL8(v0.y * dq + b0.y), CL8(v0.z * dq + b0.z), CL8(v0.w * dq + b0.w));
                                o.y = pk4_fp8(CL8(v1.x * dq + b1.x), CL8(v1.y * dq + b1.y), CL8(v1.z * dq + b1.z), CL8(v1.w * dq + b1.w));
#undef CL8
                                *(u32x2*)(WSP(unsigned char, WS_Y2) + (size_t)row * DM + col) = o;
                            } else {
                                u32x4 o; o.x = pk2(v0.x, v0.y); o.y = pk2(v0.z, v0.w); o.z = pk2(v1.x, v1.y); o.w = pk2(v1.z, v1.w);
                                bf16_t* dst;
                                if (KIND == G_WIN) dst = WSP(bf16_t, WS_PX) + (size_t)row * NIN + col;
                                else if (KIND == G_DFT) dst = WSP(bf16_t, WS_YCAT) + (size_t)((col >> 8) * SEQ + row) * DM + 768 + (col & 255);
                                else dst = WSP(bf16_t, WS_YCAT) + (size_t)(NX + (col >> 8) * LC + row) * DM + 768 + (col & 255);
                                *(u32x4*)dst = o;
                            }
                        }
                    }
                }
            }
        }
        if (!has_next) break;
#pragma unroll
        for (int a = 0; a < 2; ++a)
#pragma unroll
            for (int b = 0; b < 2; ++b)
#pragma unroll
                for (int m = 0; m < 4; ++m)
#pragma unroll
                    for (int n = 0; n < 2; ++n) acc[a][b][m][n] = (f32x4){0.f, 0.f, 0.f, 0.f};
        cur = nxt; cB = nB; ++ui;
    }
    G8_WAIT_V(0);
    if (wr == 0) G8_BAR;
    G8_BAR;
#undef G8_SA
#undef G8_SB
#undef G8_STAGE_A
#undef G8_STAGE_B
#undef G8_LDA
#undef G8_LDB
#undef G8_MMA
#undef G8_WAIT_V
#undef G8_WAIT_L
#undef G8_BAR
#undef G8_SCHED
#undef G8_AOFF
}

__device__ __forceinline__ void wave_transpose_store(bf16_t* sm  , const u32x4 (&v)[8], bf16_t* dst, size_t dstride, int lane, int cpos) {
#pragma unroll
    for (int i = 0; i < 8; ++i) {
        const unsigned w[4] = {v[i].x, v[i].y, v[i].z, v[i].w};
#pragma unroll
        for (int q = 0; q < 4; ++q) { sm[(8 * i + 2 * q) * 72 + cpos] = (bf16_t)(w[q] & 0xffffu); sm[(8 * i + 2 * q + 1) * 72 + cpos] = (bf16_t)(w[q] >> 16); }
    }
    __builtin_amdgcn_s_waitcnt(0xc07f); asm volatile("" ::: "memory");
#pragma unroll
    for (int i = 0; i < 8; ++i) { const u32x4 o = *(const u32x4*)(sm + lane * 72 + 8 * i); *(u32x4*)(dst + (size_t)lane * dstride + 8 * i) = o; }
    __builtin_amdgcn_s_waitcnt(0xc07f); asm volatile("" ::: "memory");
}

__device__ __forceinline__ void phase_prep(const Params& p, const int l, unsigned char* smem) {
    const int tid = hid_tid(), lane = tid & 63, wave = tid >> 6;
    const int gw = blockIdx.x * 8 + wave, ngw = gridDim.x * 8;
    const bf16_t* PX = WSP(bf16_t, WS_PX); const float* ROPE = WSP(float, WS_ROPE);
    bf16_t *QA = WSP(bf16_t, WS_QA), *KA = WSP(bf16_t, WS_KA), *QD = WSP(bf16_t, WS_QD), *KD = WSP(bf16_t, WS_KD), *YC = WSP(bf16_t, WS_YCAT);
    struct RowRaw { u32x2 q[4]; u32x2 wv[16]; u32x2 cu; };
    auto row_load = [&](int r, RowRaw& R) {
        const bool isctx = r >= NX; const int t = isctx ? ((r - NX) & 255) : (r & 2047);
        const bf16_t* px = PX + (size_t)r * NIN;
        R.q[0] = *(const u32x2*)(px + 4 * lane); R.q[1] = *(const u32x2*)(px + 256 + 4 * lane); R.q[2] = *(const u32x2*)(px + 768 + 4 * lane); R.q[3] = *(const u32x2*)(px + 1024 + 4 * lane);
        if (!(l == 1 && isctx)) {
            const int g = lane >> 4, win = 2 << g, Ls = isctx ? LC : SEQ;
            int lo = t - win / 2, hi = lo + win; lo = lo < 0 ? 0 : lo; hi = hi > Ls ? Ls : hi;
            const bf16_t* base = PX + (size_t)(r - t) * NIN + 1536 + 4 * lane;
#pragma unroll
            for (int j = 0; j < 16; ++j) { const int tt = lo + j < hi ? lo + j : hi - 1; R.wv[j] = *(const u32x2*)(base + (size_t)tt * NIN); }
            R.cu = *(const u32x2*)(base + (size_t)t * NIN);
        }
    };
    RowRaw cur, nxt;
    if (gw < NT) row_load(gw, nxt);
    for (int r = gw; r < NT; r += ngw) {
        cur = nxt;
        if (r + ngw < NT) row_load(r + ngw, nxt);
        const bool isctx = r >= NX; int b, t, kidx;
        if (!isctx) { b = r >> 11; t = r & 2047; kidx = 256 + t; } else { const int rr = r - NX; b = rr >> 8; t = rr & 255; kidx = t; }
        const int h = lane >> 4, d4 = (4 * lane) & 63;
        const size_t obase = ((size_t)(b * 4 + h) * KEYS + kidx) * 64 + d4;
        float v[4];
        { unpack4(cur.q[0], v); float ss = v[0] * v[0] + v[1] * v[1] + v[2] * v[2] + v[3] * v[3];
          ss = sum16_dpp(ss);
          const float rs = rsqrtf(ss * (1.f / 64.f) + EPS) * 0.18033688f; const f32x4 g = *(const f32x4*)(p.na_qg + l * 64 + d4);
          u32x2 o; o.x = pk2(v[0] * rs * g.x, v[1] * rs * g.y); o.y = pk2(v[2] * rs * g.z, v[3] * rs * g.w); *(u32x2*)(QA + obase) = o; }
        { unpack4(cur.q[1], v); float ss = v[0] * v[0] + v[1] * v[1] + v[2] * v[2] + v[3] * v[3];
          ss = sum16_dpp(ss);
          const float rs = rsqrtf(ss * (1.f / 64.f) + EPS); const f32x4 g = *(const f32x4*)(p.na_kg + l * 64 + d4);
          u32x2 o; o.x = pk2(v[0] * rs * g.x, v[1] * rs * g.y); o.y = pk2(v[2] * rs * g.z, v[3] * rs * g.w); *(u32x2*)(KA + obase) = o; }
        const int li = lane & 7, d32 = 4 * li;
        float cs[4], sn[4];
        if (!isctx) {
            const int pos = (li & 4) ? (t & 63) : (t >> 6);
            const f32x4* rt = (const f32x4*)(ROPE + (pos * 8 + 4 * (li & 1)) * 2);
            const f32x4 r0 = rt[0], r1 = rt[1];
            cs[0] = r0.x; sn[0] = r0.y; cs[1] = r0.z; sn[1] = r0.w; cs[2] = r1.x; sn[2] = r1.y; cs[3] = r1.z; sn[3] = r1.w;
        }
#pragma unroll
        for (int which = 0; which < 2; ++which) {
            unpack4(cur.q[2 + which], v);
            float ss = v[0] * v[0] + v[1] * v[1] + v[2] * v[2] + v[3] * v[3];
            ss = sum8_dpp(ss);
            const float rs = rsqrtf(ss * (1.f / 32.f) + EPS);
            const f32x4 g = *(const f32x4*)((which ? p.df_kg : p.df_qg) + l * 32 + d32);
            float y[4] = {v[0] * rs * g.x, v[1] * rs * g.y, v[2] * rs * g.z, v[3] * rs * g.w};
            if (!isctx) {
#pragma unroll
                for (int e = 0; e < 4; ++e) { const float o = DPP_F(y[e], 0x4E); y[e] = (li & 2) ? (y[e] * cs[e] + o * sn[e]) : (y[e] * cs[e] - o * sn[e]); }
            }
            const float sc = which ? 1.f : 0.25503486f;
            u32x2 o; o.x = pk2(y[0] * sc, y[1] * sc); o.y = pk2(y[2] * sc, y[3] * sc);
            *(u32x2*)((which ? KD : QD) + obase) = o;
        }
        if (!(l == 1 && isctx)) {
            const int g = lane >> 4, win = 2 << g, Ls = isctx ? LC : SEQ;
            int lo = t - win / 2, hi = lo + win; lo = lo < 0 ? 0 : lo; hi = hi > Ls ? Ls : hi;
            float s[4] = {0.f, 0.f, 0.f, 0.f};
#pragma unroll
            for (int j = 0; j < 16; ++j) { float q[4]; unpack4(cur.wv[j], q); const float m = lo + j < hi ? 1.f : 0.f; s[0] += m * q[0]; s[1] += m * q[1]; s[2] += m * q[2]; s[3] += m * q[3]; }
            float u[4]; unpack4(cur.cu, u);
            const float inv = 1.f / (float)(hi - lo);
            u32x2 o; o.x = pk2(s[0] * inv - u[0], s[1] * inv - u[1]); o.y = pk2(s[2] * inv - u[2], s[3] * inv - u[3]);
            *(u32x2*)(YC + (size_t)r * DM + 512 + 4 * lane) = o;
        }
    }
    bf16_t* sm = (bf16_t*)smem + wave * (64 * 72);
    for (int it = gw; it < 2 * 8 * 4 * 36; it += ngw) {
        const int ch = it % 36, h = (it / 36) & 3, b = (it / 144) & 7, which = it / 1152;
        const int kidx = 64 * ch + lane; const int row = kidx < 256 ? NX + b * LC + kidx : b * SEQ + kidx - 256;
        const u32x4* src = (const u32x4*)(PX + (size_t)row * NIN + (which ? 1280 : 512) + 64 * h);
        u32x4 v[8];
#pragma unroll
        for (int i = 0; i < 8; ++i) v[i] = src[i];
        bf16_t* dst = (which ? WSP(bf16_t, WS_VTD) : WSP(bf16_t, WS_VTA)) + (size_t)(b * 4 + h) * 64 * KEYS + 64 * ch;
        wave_transpose_store(sm, v, dst, KEYS, lane, (lane & 48) | (((lane >> 2) & 1) << 3) | (((lane >> 3) & 1) << 2) | (lane & 3));
    }
    const int nC = 8 * 4 * 32 + (l == 0 ? 8 * 4 * 4 : 0);
    for (int it = gw; it < nC; it += ngw) {
        const bool cx = it >= 1024; const int q = cx ? it - 1024 : it;
        const int N = cx ? 256 : 2048, njc = N / 64;
        const int jc = q % njc, cc = (q / njc) & 3, b = q / (njc * 4);
        const int j = 64 * jc + lane; const int rowb = cx ? NX + b * LC : b * SEQ;
        int t1, t2, col; float sgn;
        if (j <= N / 2) { t1 = j; t2 = (j == 0 || j == N / 2) ? -1 : N - j; col = 1792 + 64 * cc; sgn = 1.f; }
        else { t1 = j - N / 2; t2 = N - t1; col = 2048 + 64 * cc; sgn = -1.f; }
        const u32x4* s1 = (const u32x4*)(PX + (size_t)(rowb + t1) * NIN + col);
        const u32x4* s2 = (const u32x4*)(PX + (size_t)(rowb + (t2 < 0 ? t1 : t2)) * NIN + col);
        const float w2 = t2 < 0 ? 0.f : sgn;
        u32x4 v[8];
#pragma unroll
        for (int i = 0; i < 8; ++i) {
            const u32x4 a = s1[i], bq = s2[i]; u32x4 o;
            o.x = pk2(bflo(a.x) + w2 * bflo(bq.x), bfhi(a.x) + w2 * bfhi(bq.x)); o.y = pk2(bflo(a.y) + w2 * bflo(bq.y), bfhi(a.y) + w2 * bfhi(bq.y));
            o.z = pk2(bflo(a.z) + w2 * bflo(bq.z), bfhi(a.z) + w2 * bfhi(bq.z)); o.w = pk2(bflo(a.w) + w2 * bflo(bq.w), bfhi(a.w) + w2 * bfhi(bq.w));
            v[i] = o;
        }
        bf16_t* dst = (cx ? WSP(bf16_t, WS_XFC) : WSP(bf16_t, WS_XF)) + (size_t)(b * 256 + 64 * cc) * N + 64 * jc;
        wave_transpose_store(sm, v, dst, N, lane, lane);
    }
}


__device__ __forceinline__ unsigned cvt_pk_bf16(float lo, float hi) { return pk2(lo, hi); }
__device__ __forceinline__ void phase_df_mfma(const Params& p, const int l, LAS unsigned char* lds) {
    const int tid = hid_tid(), wave = __builtin_amdgcn_readfirstlane(tid >> 6), lane = tid & 63, qn = lane & 31, hh = lane >> 5;
    const float* SC = WSP(float, WS_SCAL) + l * 16;
    const float lam = SC[0], lam_init = SC[1], negmb = -SC[2];
    const int nunits = 256 + (l == 0 ? 32 : 0);
    const int srow = tid >> 3, scq = (tid & 7) ^ ((srow >> 1) & 7);
    const unsigned ldsw = (unsigned)tid * 16u;
    f32x16 negm;
#pragma unroll
    for (int i = 0; i < 16; ++i) negm[i] = negmb;
    const int rsw = (qn >> 1) & 7;
    for (int it_ = 0;; ++it_) {
        int u;
        if (gridDim.x == 256) { if (it_ == 0) u = blockIdx.x; else { if (it_ > 1 || nunits <= 256 || blockIdx.x < 224) break; u = 256 + (255 - (int)blockIdx.x); } }
        else { u = blockIdx.x + it_ * (int)gridDim.x; if (u >= nunits) break; }
        const bool cx = u >= 256; const int qt = (u >> 3) & 7, bh = cx ? u - 256 : (u & 7) * 4 + (u >> 6), b = bh >> 2, h = bh & 3;
        const int q0 = cx ? 0 : 256 + 256 * qt, nkt = cx ? 4 : 36;
        const int orow = (cx ? NX + b * LC : b * SEQ + 256 * qt) + 32 * wave + qn;
        const char* Kg = (const char*)(WSP(bf16_t, WS_KD) + (size_t)bh * KEYS * 64) + srow * 128 + scq * 16;
        const char* Vg = (const char*)(WSP(bf16_t, WS_VTD) + (size_t)bh * 64 * KEYS) + (size_t)srow * KEYS * 2 + scq * 16;
        bf16x8 qf[2][2];
        { const bf16_t* Q = WSP(bf16_t, WS_QD) + ((size_t)bh * KEYS + q0 + 32 * wave + qn) * 64;
#pragma unroll
          for (int sub = 0; sub < 2; ++sub)
#pragma unroll
              for (int ks = 0; ks < 2; ++ks) qf[sub][ks] = *(const bf16x8*)(Q + 32 * sub + 16 * ks + 8 * hh); }
        f32x16 O1[2], O2[2]; float l1 = 0.f, l2 = 0.f;
        for (int trep_ = 0; trep_ < REP_TILE; ++trep_) {
#pragma unroll
        for (int db = 0; db < 2; ++db)
#pragma unroll
            for (int i = 0; i < 16; ++i) { O1[db][i] = 0.f; O2[db][i] = 0.f; }
        l1 = 0.f; l2 = 0.f;
        __syncthreads();
        __builtin_amdgcn_global_load_lds((const unsigned*)Kg, (LAS unsigned*)(lds + ldsw), 16, 0, 0);
        __builtin_amdgcn_global_load_lds((const unsigned*)Vg, (LAS unsigned*)(lds + 8192 + ldsw), 16, 0, 0);
        __builtin_amdgcn_global_load_lds((const unsigned*)(Kg + (size_t)64 * 128), (LAS unsigned*)(lds + 16384 + ldsw), 16, 0, 0);
        __builtin_amdgcn_global_load_lds((const unsigned*)(Vg + (size_t)64 * 2), (LAS unsigned*)(lds + 16384 + 8192 + ldsw), 16, 0, 0);
        asm volatile("s_waitcnt vmcnt(2)" ::: "memory"); __builtin_amdgcn_s_barrier();
        unsigned bo = 0u;
#pragma unroll 1
        for (int t = 0; t < nkt; ++t) {
            if (t + 2 < nkt) {
                const unsigned bn = bo == 0u ? 32768u : bo - 16384u;
                __builtin_amdgcn_global_load_lds((const unsigned*)(Kg + (size_t)(t + 2) * 64 * 128), (LAS unsigned*)(lds + bn + ldsw), 16, 0, 0);
                __builtin_amdgcn_global_load_lds((const unsigned*)(Vg + (size_t)(t + 2) * 64 * 2), (LAS unsigned*)(lds + bn + 8192 + ldsw), 16, 0, 0);
            }
#pragma unroll
            for (int kb = 0; kb < 2; ++kb) {
                const LAS unsigned char* kt = lds + bo + (32 * kb + qn) * 128;
                bf16x8 kf[2][2];
#pragma unroll
                for (int sub = 0; sub < 2; ++sub)
#pragma unroll
                    for (int ks = 0; ks < 2; ++ks) kf[sub][ks] = *(const LAS bf16x8*)(kt + (((4 * sub + 2 * ks + hh) ^ rsw) << 4));
                f32x16 S1 = __builtin_amdgcn_mfma_f32_32x32x16_bf16(kf[0][0], qf[0][0], negm, 0, 0, 0);
                S1 = __builtin_amdgcn_mfma_f32_32x32x16_bf16(kf[0][1], qf[0][1], S1, 0, 0, 0);
                f32x16 S2 = __builtin_amdgcn_mfma_f32_32x32x16_bf16(kf[1][0], qf[1][0], negm, 0, 0, 0);
                S2 = __builtin_amdgcn_mfma_f32_32x32x16_bf16(kf[1][1], qf[1][1], S2, 0, 0, 0);
                bf16x8 vf[2][2];
#pragma unroll
                for (int db = 0; db < 2; ++db)
#pragma unroll
                    for (int s = 0; s < 2; ++s) vf[db][s] = *(const LAS bf16x8*)(lds + bo + 8192 + (32 * db + qn) * 128 + (((4 * kb + 2 * s + hh) ^ rsw) << 4));
                unsigned pa[8], pb[8];
#pragma unroll
                for (int i = 0; i < 8; ++i) {
                    const float a0 = __builtin_amdgcn_exp2f(S1[2 * i]), a1 = __builtin_amdgcn_exp2f(S1[2 * i + 1]);
                    const float b0 = __builtin_amdgcn_exp2f(S2[2 * i]), b1 = __builtin_amdgcn_exp2f(S2[2 * i + 1]);
                    l1 += a0 + a1; l2 += b0 + b1;
                    pa[i] = cvt_pk_bf16(a0, a1); pb[i] = cvt_pk_bf16(b0, b1);
                }
                bf16x8 P1[2], P2[2];
#pragma unroll
                for (int s = 0; s < 2; ++s) {
                    const u32x4 wa = {pa[4 * s], pa[4 * s + 1], pa[4 * s + 2], pa[4 * s + 3]}, wb = {pb[4 * s], pb[4 * s + 1], pb[4 * s + 2], pb[4 * s + 3]};
                    P1[s] = *(const bf16x8*)&wa; P2[s] = *(const bf16x8*)&wb;
                }
#pragma unroll
                for (int db = 0; db < 2; ++db)
#pragma unroll
                    for (int s = 0; s < 2; ++s) {
                        O1[db] = __builtin_amdgcn_mfma_f32_32x32x16_bf16(vf[db][s], P1[s], O1[db], 0, 0, 0);
                        O2[db] = __builtin_amdgcn_mfma_f32_32x32x16_bf16(vf[db][s], P2[s], O2[db], 0, 0, 0);
                    }
            }
            if (t + 2 < nkt) asm volatile("s_waitcnt vmcnt(2)" ::: "memory"); else asm volatile("s_waitcnt vmcnt(0)" ::: "memory");
            __builtin_amdgcn_s_barrier();
            bo = bo >= 32768u ? 0u : bo + 16384u;
        }
        }
        l1 += __shfl_xor(l1, 32); l2 += __shfl_xor(l2, 32);
        const float i1 = 1.f / l1, i2 = lam / l2; float ss = 0.f;
#pragma unroll
        for (int db = 0; db < 2; ++db)
#pragma unroll
            for (int i = 0; i < 16; ++i) { const float o = O1[db][i] * i1 - O2[db][i] * i2; O1[db][i] = o; ss += o * o; }
        ss += __shfl_xor(ss, 32);
        const float rs = rsqrtf(ss * (1.f / 64.f) + EPS) * (1.f - lam_init);
        bf16_t* op = WSP(bf16_t, WS_YCAT) + (size_t)orow * DM + 256 + 64 * h + 4 * hh;
        const float* sl = p.subln + l * 64 + 4 * hh;
#pragma unroll
        for (int db = 0; db < 2; ++db)
#pragma unroll
            for (int i = 0; i < 4; ++i) {
                const int d = 32 * db + 8 * i; const f32x4 g = *(const f32x4*)(sl + d);
                u32x2 o; o.x = pk2(O1[db][4 * i] * rs * g.x, O1[db][4 * i + 1] * rs * g.y); o.y = pk2(O1[db][4 * i + 2] * rs * g.z, O1[db][4 * i + 3] * rs * g.w);
                *(u32x2*)(op + d) = o;
            }
    }
    __syncthreads();
}


__device__ __forceinline__ void phase_na_mfma(const Params& p, const int l, LAS unsigned char* lds) {
    const int tid = hid_tid(), wave = __builtin_amdgcn_readfirstlane(tid >> 6), lane = tid & 63, qn = lane & 31, hh = lane >> 5;
    const float* SC = WSP(float, WS_SCAL) + l * 16;
    const int nunits = 256 + (l == 0 ? 32 : 0);
    const int srow = tid >> 3, scq = (tid & 7) ^ ((srow >> 1) & 7);
    const unsigned ldsw = (unsigned)tid * 16u;
    const int rsw = (qn >> 1) & 7;
    LAS float* btab = (LAS float*)(lds + 49152);
    for (int it_ = 0;; ++it_) {
        int u;
        if (gridDim.x == 256) { if (it_ == 0) u = blockIdx.x; else { if (it_ > 1 || nunits <= 256 || blockIdx.x < 224) break; u = 256 + (255 - (int)blockIdx.x); } }
        else { u = blockIdx.x + it_ * (int)gridDim.x; if (u >= nunits) break; }
        const bool cx = u >= 256; const int bh = cx ? u - 256 : (u & 7) * 4 + (u >> 6), rg = (u >> 3) & 7, b = bh >> 2, h = bh & 3;
        __syncthreads();
        for (int i = tid; i < 15 * 32; i += 512) { const int rr = i >> 5, cc = i & 31; btab[i] = cc < 31 ? p.na_rpb[((size_t)(l * 4 + h) * 15 + rr) * 31 + cc] * 1.44269504f : -__builtin_inff(); }
        const int r = 4 * rg + (wave >> 1), qc = 32 * (wave & 1) + qn;
        const int qidx = cx ? 32 * wave + qn : 256 + 64 * r + qc;
        const int orow = cx ? NX + b * LC + 32 * wave + qn : b * SEQ + 64 * r + qc;
        bf16x8 qf[4];
        { const bf16_t* Q = WSP(bf16_t, WS_QA) + ((size_t)bh * KEYS + qidx) * 64;
#pragma unroll
          for (int ks = 0; ks < 4; ++ks) qf[ks] = *(const bf16x8*)(Q + 16 * ks + 8 * hh); }
        int cs = qc - 8; cs = cs < 0 ? 0 : (cs > 48 ? 48 : cs);
        int boff[2][16];
#pragma unroll
        for (int kb = 0; kb < 2; ++kb)
#pragma unroll
            for (int rg2 = 0; rg2 < 16; ++rg2) {
                const int kc = 32 * kb + (rg2 & 3) + 8 * (rg2 >> 2) + 4 * hh;
                int dk = kc - qc; dk = dk < -15 ? -15 : (dk > 15 ? 15 : dk);
                boff[kb][rg2] = ((unsigned)(kc - cs) < 16u) ? 4 * (dk + 15) : 4 * 31;
            }
        int rs = r - 4; rs = rs < 0 ? 0 : (rs > 24 ? 24 : rs);
        int krlo = 4 * rg - 4; krlo = krlo < 0 ? 0 : (krlo > 24 ? 24 : krlo);
        int krhi = 4 * rg - 1; krhi = (krhi < 0 ? 0 : (krhi > 24 ? 24 : krhi)) + 7;
        const int ntile = cx ? 4 : 4 + (krhi - krlo + 1);
        const float negmb = -SC[4 + h];
        f32x16 negm;
#pragma unroll
        for (int i = 0; i < 16; ++i) negm[i] = negmb;
        const char* Kg = (const char*)(WSP(bf16_t, WS_KA) + (size_t)bh * KEYS * 64) + srow * 128 + scq * 16;
        const char* Vg = (const char*)(WSP(bf16_t, WS_VTA) + (size_t)bh * 64 * KEYS) + (size_t)srow * KEYS * 2 + scq * 16;
        f32x16 O[2]; float ls = 0.f;
        for (int trep_ = 0; trep_ < REP_TILE; ++trep_) {
        if (trep_) __syncthreads();
#pragma unroll
        for (int db = 0; db < 2; ++db)
#pragma unroll
            for (int i = 0; i < 16; ++i) O[db][i] = 0.f;
        ls = 0.f;
        __builtin_amdgcn_global_load_lds((const unsigned*)Kg, (LAS unsigned*)(lds + ldsw), 16, 0, 0);
        __builtin_amdgcn_global_load_lds((const unsigned*)Vg, (LAS unsigned*)(lds + 8192 + ldsw), 16, 0, 0);
        __builtin_amdgcn_global_load_lds((const unsigned*)(Kg + (size_t)64 * 128), (LAS unsigned*)(lds + 16384 + ldsw), 16, 0, 0);
        __builtin_amdgcn_global_load_lds((const unsigned*)(Vg + (size_t)64 * 2), (LAS unsigned*)(lds + 16384 + 8192 + ldsw), 16, 0, 0);
        asm volatile("s_waitcnt vmcnt(2)" ::: "memory"); __builtin_amdgcn_s_barrier();
        unsigned bo = 0u;
#pragma unroll 1
        for (int i = 0; i < ntile; ++i) {
            if (i + 2 < ntile) {
                const int tn = (i + 2 < 4) ? i + 2 : 4 + krlo + (i + 2 - 4);
                const unsigned bn = bo == 0u ? 32768u : bo - 16384u;
                __builtin_amdgcn_global_load_lds((const unsigned*)(Kg + (size_t)tn * 64 * 128), (LAS unsigned*)(lds + bn + ldsw), 16, 0, 0);
                __builtin_amdgcn_global_load_lds((const unsigned*)(Vg + (size_t)tn * 64 * 2), (LAS unsigned*)(lds + bn + 8192 + ldsw), 16, 0, 0);
            }
            const int kr = krlo + i - 4;
            const bool local = i >= 4;
            if (!local || (kr >= rs && kr < rs + 8)) {
                const int brow = local ? (kr - r + 7) * 128 : 0;
#pragma unroll
                for (int kb = 0; kb < 2; ++kb) {
                    const LAS unsigned char* kt = lds + bo + (32 * kb + qn) * 128;
                    bf16x8 kf[4];
#pragma unroll
                    for (int ks = 0; ks < 4; ++ks) kf[ks] = *(const LAS bf16x8*)(kt + (((2 * ks + hh) ^ rsw) << 4));
                    f32x16 S = __builtin_amdgcn_mfma_f32_32x32x16_bf16(kf[0], qf[0], negm, 0, 0, 0);
#pragma unroll
                    for (int ks = 1; ks < 4; ++ks) S = __builtin_amdgcn_mfma_f32_32x32x16_bf16(kf[ks], qf[ks], S, 0, 0, 0);
                    bf16x8 vf[2][2];
#pragma unroll
                    for (int db = 0; db < 2; ++db)
#pragma unroll
                        for (int s = 0; s < 2; ++s) vf[db][s] = *(const LAS bf16x8*)(lds + bo + 8192 + (32 * db + qn) * 128 + (((4 * kb + 2 * s + hh) ^ rsw) << 4));
                    if (local) {
#pragma unroll
                        for (int rg2 = 0; rg2 < 16; ++rg2) S[rg2] += *(const LAS float*)((const LAS unsigned char*)btab + brow + boff[kb][rg2]);
                    }
                    unsigned pa[8];
#pragma unroll
                    for (int j = 0; j < 8; ++j) {
                        const float a0 = __builtin_amdgcn_exp2f(S[2 * j]), a1 = __builtin_amdgcn_exp2f(S[2 * j + 1]);
                        ls += a0 + a1; pa[j] = pk2(a0, a1);
                    }
                    bf16x8 P[2];
#pragma unroll
                    for (int s = 0; s < 2; ++s) { const u32x4 wa = {pa[4 * s], pa[4 * s + 1], pa[4 * s + 2], pa[4 * s + 3]}; P[s] = *(const bf16x8*)&wa; }
#pragma unroll
                    for (int db = 0; db < 2; ++db)
#pragma unroll
                        for (int s = 0; s < 2; ++s) O[db] = __builtin_amdgcn_mfma_f32_32x32x16_bf16(vf[db][s], P[s], O[db], 0, 0, 0);
                }
            }
            if (i + 2 < ntile) asm volatile("s_waitcnt vmcnt(2)" ::: "memory"); else asm volatile("s_waitcnt vmcnt(0)" ::: "memory");
            __builtin_amdgcn_s_barrier();
            bo = bo >= 32768u ? 0u : bo + 16384u;
        }
        }
        ls += __shfl_xor(ls, 32);
        const float il = 1.f / ls;
        bf16_t* op = WSP(bf16_t, WS_YCAT) + (size_t)orow * DM + 64 * h + 4 * hh;
#pragma unroll
        for (int db = 0; db < 2; ++db)
#pragma unroll
            for (int i = 0; i < 4; ++i) {
                u32x2 o; o.x = pk2(O[db][4 * i] * il, O[db][4 * i + 1] * il); o.y = pk2(O[db][4 * i + 2] * il, O[db][4 * i + 3] * il);
                *(u32x2*)(op + 32 * db + 8 * i) = o;
            }
    }
    __syncthreads();
}

constexpr int RB = 72;
constexpr int HSTR = 2064;
__device__ __forceinline__ void phase_route(const Params& p, const int l, unsigned char* smem, const int cnt_off) {
    unsigned char* HN = smem;
    float* LOGIT = (float*)(smem + RB * HSTR);
    int* hist = (int*)(smem + RB * HSTR + RB * 32 * 4); int* base = hist + 32; int* s_e = base + 32; int* s_lp = s_e + RB * 4; float* s_g = (float*)(s_lp + RB * 4);
    const int tid = hid_tid(), lane = tid & 63, wave = tid >> 6, fr = lane & 15, fq = lane >> 4;
    const int nrows = (l == 0) ? NT : NX;
    const float* MOD = WSP(float, WS_MOD); unsigned char* H8 = WSP(unsigned char, WS_H8); const bf16_t* X1 = WSP(bf16_t, WS_X1);
    const bf16_t* RWT = WSP(bf16_t, WS_RWT) + (size_t)l * 32 * 1024;
    int* cnt = WSP(int, WS_CTL + CTL_CNT + cnt_off) + l * 32;
    int *RTE = WSP(int, WS_RTE), *RTP = WSP(int, WS_RTP), *LIST = WSP(int, WS_LIST); float* RTG = WSP(float, WS_RTG);
    const float rb0 = p.router_b[l * 32 + fr], rb1 = p.router_b[l * 32 + 16 + fr];
    for (int r0 = blockIdx.x * RB; r0 < nrows; r0 += gridDim.x * RB) {
        __syncthreads();
        if (tid < 32) hist[tid] = 0;
        const int nr = (nrows - r0) < RB ? (nrows - r0) : RB;
        u32x2 vn[4];
        if (wave < nr) {
#pragma unroll
            for (int j = 0; j < 4; ++j) vn[j] = ((const u32x2*)(X1 + (size_t)(r0 + wave) * DM))[lane + 64 * j];
        }
        int cmi = -1; f32x4 mA[4], mB[4];
        for (int i = wave; i < nr; i += 8) {
            const int r = r0 + i;
            if (mod_index(r) != cmi) {
                cmi = mod_index(r);
                const float* m = MOD + (size_t)(l * 9 + cmi) * 6144; const float* gw = p.g2w + l * 1024;
#pragma unroll
                for (int j = 0; j < 4; ++j) { const int c = 4 * lane + 256 * j; const f32x4 g = *(const f32x4*)(gw + c), s1 = *(const f32x4*)(m + 4 * 1024 + c);
                    mA[j].x = g.x * (1.f + s1.x); mA[j].y = g.y * (1.f + s1.y); mA[j].z = g.z * (1.f + s1.z); mA[j].w = g.w * (1.f + s1.w); mB[j] = *(const f32x4*)(m + 3 * 1024 + c); }
            }
            f32x4 v[4]; float ss = 0.f;
#pragma unroll
            for (int j = 0; j < 4; ++j) { v[j] = (f32x4){bflo(vn[j].x), bfhi(vn[j].x), bflo(vn[j].y), bfhi(vn[j].y)}; ss += v[j].x * v[j].x + v[j].y * v[j].y + v[j].z * v[j].z + v[j].w * v[j].w; }
            if (i + 8 < nr) {
#pragma unroll
                for (int j = 0; j < 4; ++j) vn[j] = ((const u32x2*)(X1 + (size_t)(r + 8) * DM))[lane + 64 * j];
            }
            ss = wave_sum_fast(ss);
            const float rs = rsqrtf(ss * (1.f / DM) + EPS);
#pragma unroll
            for (int j = 0; j < 4; ++j) {
                const int c = 4 * lane + 256 * j;
                f32x4 o;
                o.x = v[j].x * rs * mA[j].x + mB[j].x; o.y = v[j].y * rs * mA[j].y + mB[j].y;
                o.z = v[j].z * rs * mA[j].z + mB[j].z; o.w = v[j].w * rs * mA[j].w + mB[j].w;
                *(unsigned*)(H8 + (size_t)r * DM + c) = pk4_fp8(fminf(fmaxf(o.x * SH8, -448.f), 448.f), fminf(fmaxf(o.y * SH8, -448.f), 448.f), fminf(fmaxf(o.z * SH8, -448.f), 448.f), fminf(fmaxf(o.w * SH8, -448.f), 448.f));
                u32x2 hb; hb.x = pk2(o.x, o.y); hb.y = pk2(o.z, o.w);
                *(u32x2*)(HN + i * HSTR + c * 2) = hb;
            }
        }
        __syncthreads();
        if (wave < 5 && 16 * wave < nr) {
            f32x4 a0 = {0.f, 0.f, 0.f, 0.f}, a1 = {0.f, 0.f, 0.f, 0.f};
            const unsigned char* arow = HN + (16 * wave + fr) * HSTR + fq * 16;
            const bf16_t* b0p = RWT + (size_t)fr * 1024 + fq * 8; const bf16_t* b1p = b0p + 16 * 1024;
#pragma unroll 8
            for (int ks = 0; ks < 32; ++ks) {
                const bf16x8 a = *(const bf16x8*)(arow + ks * 64);
                const bf16x8 b0 = *(const bf16x8*)(b0p + ks * 32), b1 = *(const bf16x8*)(b1p + ks * 32);
                a0 = __builtin_amdgcn_mfma_f32_16x16x32_bf16(a, b0, a0, 0, 0, 0);
                a1 = __builtin_amdgcn_mfma_f32_16x16x32_bf16(a, b1, a1, 0, 0, 0);
            }
#pragma unroll
            for (int q = 0; q < 4; ++q) { const int row = 16 * wave + 4 * fq + q; if (row < nr) { LOGIT[row * 32 + fr] = a0[q] + rb0; LOGIT[row * 32 + 16 + fr] = a1[q] + rb1; } }
        }
        __syncthreads();
        for (int i = wave; i < nr; i += 8) {
            const float logit = LOGIT[i * 32 + (lane & 31)];
            float tv[4]; int ti[4];
            {
                const int me = lane & 31; int rank = 0;
#pragma unroll
                for (int e = 0; e < 32; ++e) { const float ov = __builtin_bit_cast(float, __builtin_amdgcn_readlane(__builtin_bit_cast(int, logit), e)); rank += ((ov > logit) || (ov == logit && e < me)) ? 1 : 0; }
#pragma unroll
                for (int k = 0; k < 4; ++k) {
                    const unsigned long long mk = __ballot(rank == k);
                    const int srcl = __builtin_amdgcn_readfirstlane((int)__builtin_ctzll(mk));
                    ti[k] = srcl & 31; tv[k] = __builtin_bit_cast(float, __builtin_amdgcn_readlane(__builtin_bit_cast(int, logit), srcl));
                }
            }
            const float e1 = __expf(tv[1] - tv[0]), e2 = __expf(tv[2] - tv[0]), e3 = __expf(tv[3] - tv[0]); const float inv = 1.f / (1.f + e1 + e2 + e3);
            if (lane < 4) {
                const int te = lane == 0 ? ti[0] : lane == 1 ? ti[1] : lane == 2 ? ti[2] : ti[3];
                const float tg = (lane == 0 ? 1.f : lane == 1 ? e1 : lane == 2 ? e2 : e3) * inv;
                s_e[i * 4 + lane] = te; s_g[i * 4 + lane] = tg; s_lp[i * 4 + lane] = atomicAdd(&hist[te], 1);
            }
        }
        __syncthreads();
        if (tid < 32) base[tid] = hist[tid] ? atomicAdd(&cnt[tid], hist[tid]) : 0;
        __syncthreads();
        for (int i = tid; i < nr * 4; i += 512) {
            const int r = r0 + (i >> 2), e = s_e[i], pos = base[e] + s_lp[i];
            RTE[(size_t)r * 4 + (i & 3)] = e; RTP[(size_t)r * 4 + (i & 3)] = pos; RTG[(size_t)r * 4 + (i & 3)] = s_g[i];
            LIST[(size_t)e * NT + pos] = r;
        }
    }
    __syncthreads();
}

__device__ __forceinline__ void phase_combine(const Params& p, const int l, const int* tinfo) {
    const int tid = hid_tid(), lane = tid & 63, wave = tid >> 6;
    const int gw = blockIdx.x * 8 + wave, ngw = gridDim.x * 8;
    const int nrows = (l == 0) ? NT : NX;
    const float* MOD = WSP(float, WS_MOD); const bf16_t* X1 = WSP(bf16_t, WS_X1); const unsigned char* Y2 = WSP(unsigned char, WS_Y2);
    const int *RTE = WSP(int, WS_RTE), *RTP = WSP(int, WS_RTP); const float* RTG = WSP(float, WS_RTG);
    int ne[4], np_[4]; float ng[4];
    if (gw < nrows) {
#pragma unroll
        for (int k = 0; k < 4; ++k) { ne[k] = RTE[(size_t)gw * 4 + k]; np_[k] = RTP[(size_t)gw * 4 + k]; ng[k] = RTG[(size_t)gw * 4 + k]; }
    }
    int cmi = -1; f32x4 g2v[4], nA[4], nB[4];
    for (int r = gw; r < nrows; r += ngw) {
        if (mod_index(r) != cmi) {
            cmi = mod_index(r);
            const float* g2 = MOD + (size_t)(l * 9 + cmi) * 6144 + 5 * 1024; const float* m = MOD + (size_t)(1 * 9 + cmi) * 6144;
#pragma unroll
            for (int j = 0; j < 4; ++j) { const int c = 4 * lane + 256 * j; g2v[j] = *(const f32x4*)(g2 + c);
                if (l == 0) { const f32x4 g = *(const f32x4*)(p.g1w + 1024 + c), s1 = *(const f32x4*)(m + 1024 + c);
                    nA[j].x = g.x * (1.f + s1.x); nA[j].y = g.y * (1.f + s1.y); nA[j].z = g.z * (1.f + s1.z); nA[j].w = g.w * (1.f + s1.w); nB[j] = *(const f32x4*)(m + c); } }
        }
        const unsigned char* yr[4]; float gk[4];
#pragma unroll
        for (int k = 0; k < 4; ++k) { yr[k] = Y2 + ((size_t)tinfo[ne[k]] * 256 + np_[k]) * DM; gk[k] = ng[k] * (1.f / SY8); }
        unsigned yv[4][4]; u32x2 x1v[4]; f32x4 gv[4];
#pragma unroll
        for (int j = 0; j < 4; ++j) {
            const int c = 4 * lane + 256 * j;
#pragma unroll
            for (int k = 0; k < 4; ++k) yv[j][k] = *(const unsigned*)(yr[k] + c);
            x1v[j] = *(const u32x2*)(X1 + (size_t)r * DM + c); gv[j] = g2v[j];
        }
        if (r + ngw < nrows) {
#pragma unroll
            for (int k = 0; k < 4; ++k) { ne[k] = RTE[(size_t)(r + ngw) * 4 + k]; np_[k] = RTP[(size_t)(r + ngw) * 4 + k]; ng[k] = RTG[(size_t)(r + ngw) * 4 + k]; }
        }
        f32x4 xv[4];
#pragma unroll
        for (int j = 0; j < 4; ++j) {
            const int c = 4 * lane + 256 * j;
            float s[4] = {0.f, 0.f, 0.f, 0.f};
#pragma unroll
            for (int k = 0; k < 4; ++k) { const f32x2 ya = __builtin_amdgcn_cvt_pk_f32_fp8((int)yv[j][k], false), yb = __builtin_amdgcn_cvt_pk_f32_fp8((int)yv[j][k], true); s[0] += gk[k] * ya.x; s[1] += gk[k] * ya.y; s[2] += gk[k] * yb.x; s[3] += gk[k] * yb.y; }
            const f32x4 x1 = {bflo(x1v[j].x), bfhi(x1v[j].x), bflo(x1v[j].y), bfhi(x1v[j].y)}, g = gv[j];
            f32x4 o; o.x = x1.x + g.x * s[0]; o.y = x1.y + g.y * s[1]; o.z = x1.z + g.z * s[2]; o.w = x1.w + g.w * s[3];
            if (l == 0) { u32x2 ob; ob.x = pk2(o.x, o.y); ob.y = pk2(o.z, o.w); *(u32x2*)(WSP(bf16_t, WS_X2) + (size_t)r * DM + c) = ob; }
            else *(f32x4*)(p.out + (size_t)r * DM + c) = o;
            xv[j] = o;
        }
        if (l == 0) {
            float ss = 0.f;
#pragma unroll
            for (int j = 0; j < 4; ++j) ss += xv[j].x * xv[j].x + xv[j].y * xv[j].y + xv[j].z * xv[j].z + xv[j].w * xv[j].w;
            ss = wave_sum_fast(ss); const float rs = rsqrtf(ss * (1.f / DM) + EPS);
            bf16_t* hrow = WSP(bf16_t, WS_H) + (size_t)r * DM;
#pragma unroll
            for (int j = 0; j < 4; ++j) {
                const int c = 4 * lane + 256 * j;
                u32x2 pk; pk.x = pk2(xv[j].x * rs * nA[j].x + nB[j].x, xv[j].y * rs * nA[j].y + nB[j].y);
                pk.y = pk2(xv[j].z * rs * nA[j].z + nB[j].z, xv[j].w * rs * nA[j].w + nB[j].w);
                *(u32x2*)(hrow + c) = pk;
            }
        }
    }
}

#define XB_TMO      128
#define XB_XCNT(j)  (256  + 64 * (j))
#define XB_XSUB(j)  (1280 + 64 * (j))
#define XB_XGEN(j)  (2304 + 64 * (j))
#define XB_TOP      3328
#define XB_TOPGEN   3392
#define XCD_BAR_WORDS 3456
#define XB_SPIN_CAP (1u << 18)
__device__ __forceinline__ unsigned xb_ld(unsigned* p)              { return __hip_atomic_load(p, __ATOMIC_RELAXED, __HIP_MEMORY_SCOPE_AGENT); }
__device__ __forceinline__ unsigned xb_add(unsigned* p, unsigned v) { return __hip_atomic_fetch_add(p, v, __ATOMIC_RELAXED, __HIP_MEMORY_SCOPE_AGENT); }
__device__ __forceinline__ unsigned xb_xcc_id() { return (unsigned)__builtin_amdgcn_s_getreg((3 << 11) | 20) & 0xFu; }
#define XB_SPIN(cond, bar) do { unsigned _sp = 0; while (cond) { __builtin_amdgcn_s_sleep(1); \
    if ((++_sp & 255u) == 0u) { if (xb_ld(&(bar)[XB_TMO])) break; if (_sp > XB_SPIN_CAP) { atomicAdd(&(bar)[XB_TMO], 1u); break; } } } } while (0)
struct XcdBarrier { unsigned* bar; unsigned x; volatile LAS unsigned* st; };
__device__ __forceinline__ XcdBarrier xcd_barrier_post(unsigned* bar, volatile LAS unsigned* st) {
    XcdBarrier b; b.bar = bar; b.x = xb_xcc_id(); b.st = st;
    if (threadIdx.x == 0) (void)xb_add(&bar[XB_XCNT(b.x)], 1u);
    return b;
}
__device__ __forceinline__ void xcd_barrier_complete(unsigned* bar, unsigned x, unsigned& nloc, unsigned& nx) {
    const unsigned G = gridDim.x * gridDim.y * gridDim.z;
    unsigned sum, cnt, mine, sp = 0u;
    for (;;) {
        sum = 0u; cnt = 0u; mine = 0u;
#pragma unroll
        for (unsigned j = 0; j < 16; ++j) { const unsigned c = xb_ld(&bar[XB_XCNT(j)]); sum += c; cnt += (c > 0u) ? 1u : 0u; mine = (j == x) ? c : mine; }
        if (sum == G) break;
        __builtin_amdgcn_s_sleep(1);
        if ((++sp & 255u) == 0u) { if (xb_ld(&bar[XB_TMO])) break; if (sp > XB_SPIN_CAP) { atomicAdd(&bar[XB_TMO], 1u); break; } }
    }
    nloc = mine > 0u ? mine : 1u; nx = cnt > 0u ? cnt : 1u;
}
__device__ __forceinline__ void xcd_barrier(const XcdBarrier& b) {
    asm volatile("s_waitcnt vmcnt(0)" ::: "memory");
    __syncthreads();
    if (threadIdx.x == 0) {
        unsigned* bar = b.bar;
        __builtin_amdgcn_s_waitcnt(0);
        unsigned nloc = b.st[0], nx = b.st[1];
        if (nloc == 0u) { xcd_barrier_complete(bar, b.x, nloc, nx); b.st[0] = nloc; b.st[1] = nx; }
        const unsigned old = xb_add(&bar[XB_XSUB(b.x)], 1u);
        const unsigned gen = old / nloc;
        if (old + 1u == (gen + 1u) * nloc) {
            __builtin_amdgcn_fence(__ATOMIC_RELEASE, "agent");
            asm volatile("s_waitcnt vmcnt(0)" ::: "memory");
            const unsigned og = xb_add(&bar[XB_TOP], 1u);
            const unsigned tg = og / nx;
            if (og + 1u == (tg + 1u) * nx) xb_add(&bar[XB_TOPGEN], 1u);
            else XB_SPIN(xb_ld(&bar[XB_TOPGEN]) == tg, bar);
            __builtin_amdgcn_fence(__ATOMIC_ACQUIRE, "agent");
            xb_add(&bar[XB_XGEN(b.x)], 1u);
            asm volatile("s_waitcnt vmcnt(0)" ::: "memory");
        } else {
            XB_SPIN(xb_ld(&bar[XB_XGEN(b.x)]) == gen, bar);
            __builtin_amdgcn_fence(__ATOMIC_ACQUIRE, "agent");
            asm volatile("s_waitcnt vmcnt(0)" ::: "memory");
        }
    }
    __syncthreads();
}

constexpr int LDS_BYTES = 163840;
constexpr int MISC_OFF = LDS_BYTES - 2048;
constexpr int NCH_L = 3072;
constexpr size_t CTL_CHUNK = 40960, CTL_DONE = 41472;
__device__ __forceinline__ void conv_item(const Params& p, unsigned char* smem, int l, int q, int wave, int lane) {
    unsigned char* tsm = smem + wave * (64 * 144);
    if (q < 16384) { const int m = l * 32 + (q >> 9), r = q & 511; transpose_item8(p.w1 + (size_t)m * 1024 * 2048, 2048, 1024, WSP(unsigned char, WS_W1) + (size_t)m * 2048 * 1024, tsm, r & 15, r >> 4, lane); }
    else { const int q2 = q - 16384, m = l * 32 + (q2 >> 8), r = q2 & 255; transpose_item8(p.w2 + (size_t)m * 1024 * 1024, 1024, 1024, WSP(unsigned char, WS_W2) + (size_t)m * 1024 * 1024, tsm, r & 15, r >> 4, lane); }
}
__device__ __forceinline__ void idle_fill(const Params& p, unsigned char* smem, const int phase, const int l) {
    const int tid = hid_tid(), lane = tid & 63, wave = tid >> 6;
    volatile int* cslot = (volatile int*)(smem + MISC_OFF + 512);
    unsigned* chunk = WSP(unsigned, WS_CTL + CTL_CHUNK + 256 * l); unsigned* done = WSP(unsigned, WS_CTL + CTL_DONE + 256 * phase);
    __syncthreads();
    if (tid == 0) {
        __hip_atomic_fetch_add(done, 1u, __ATOMIC_RELAXED, __HIP_MEMORY_SCOPE_AGENT);
        int c = -1;
        if (__hip_atomic_load(done, __ATOMIC_RELAXED, __HIP_MEMORY_SCOPE_AGENT) < gridDim.x) { const unsigned g = __hip_atomic_fetch_add(chunk, 1u, __ATOMIC_RELAXED, __HIP_MEMORY_SCOPE_AGENT); if (g < (unsigned)NCH_L) c = (int)g; }
        cslot[0] = c;
    }
    __syncthreads();
    int c = cslot[0];
    while (c >= 0) {
        __syncthreads();
        unsigned gnext = 0xffffffffu; bool more = false;
        if (tid == 0) { more = __hip_atomic_load(done, __ATOMIC_RELAXED, __HIP_MEMORY_SCOPE_AGENT) < gridDim.x; if (more) gnext = __hip_atomic_fetch_add(chunk, 1u, __ATOMIC_RELAXED, __HIP_MEMORY_SCOPE_AGENT); }
        conv_item(p, smem, l, c * 8 + wave, wave, lane);
        if (tid == 0) cslot[0] = (more && gnext < (unsigned)NCH_L) ? (int)gnext : -1;
        __syncthreads();
        c = cslot[0];
    }
}
__device__ __forceinline__ void conv_drain(const Params& p, unsigned char* smem, const int l) {
    const int tid = hid_tid(), lane = tid & 63, wave = tid >> 6;
    const int gw = blockIdx.x * 8 + wave, ngw = gridDim.x * 8;
    unsigned cst = __hip_atomic_load(WSP(unsigned, WS_CTL + CTL_CHUNK + 256 * l), __ATOMIC_RELAXED, __HIP_MEMORY_SCOPE_AGENT);
    cst = cst > (unsigned)NCH_L ? (unsigned)NCH_L : cst;
    __syncthreads();
    for (int q = (int)cst * 8 + gw; q < NCH_L * 8; q += ngw) conv_item(p, smem, l, q, wave, lane);
    __syncthreads();
}

__global__ void __launch_bounds__(512, 2) k_fwd(Params p) {
    extern __shared__ __attribute__((aligned(16))) unsigned char smem[];
    int* tinfo = (int*)(smem + MISC_OFF + 64);
    if (threadIdx.x < 4) ((unsigned*)(smem + MISC_OFF))[threadIdx.x] = 0u;
    __syncthreads();
    XcdBarrier bar = xcd_barrier_post(WSP(unsigned, WS_CTL), (volatile LAS unsigned*)(smem + MISC_OFF));
    phase_pro0(p, smem);
    __syncthreads();
    REPEAT(REP_PRO1, phase_pro1(p, smem); __syncthreads());
    xcd_barrier(bar);
#define LAYER(l) do { \
        REPEAT(REP_WIN, gemm_phase256<G_WIN>(p, l, (LAS unsigned char*)smem, tinfo)); \
        REPEAT(REP_BAR, xcd_barrier(bar)); \
        REPEAT(REP_PREP, phase_prep(p, l, smem); __syncthreads()); \
        REPEAT(REP_BAR, xcd_barrier(bar)); \
          \
        REPEAT(REP_DFT, gemm_phase256<G_DFT>(p, l, (LAS unsigned char*)smem, tinfo)); \
        if (l == 0) gemm_phase256<G_DFTC>(p, l, (LAS unsigned char*)smem, tinfo); \
        __syncthreads(); \
        REPEAT(REP_DF, phase_df_mfma(p, l, (LAS unsigned char*)smem)); \
        REPEAT(REP_NA, phase_na_mfma(p, l, (LAS unsigned char*)smem)); \
        idle_fill(p, smem, 3 + 8 * l, l); \
        REPEAT(REP_BAR, xcd_barrier(bar)); \
        REPEAT(REP_WOUT, gemm_phase256<G_WOUT>(p, l, (LAS unsigned char*)smem, tinfo)); \
        if (l == 0) idle_fill(p, smem, 4 + 8 * l, l); \
        REPEAT(REP_BAR, xcd_barrier(bar)); \
        if (REP_ROUTE > 1) { phase_route(p, l, smem, 1024); __syncthreads(); } \
        phase_route(p, l, smem, 0); \
        conv_drain(p, smem, l); \
        REPEAT(REP_BAR, xcd_barrier(bar)); \
        moe_tinfo(p, l, tinfo); \
        REPEAT(REP_MOE1, gemm_phase256<G_MOE1>(p, l, (LAS unsigned char*)smem, tinfo)); \
        REPEAT(REP_BAR, xcd_barrier(bar)); \
        REPEAT(REP_MOE2, gemm_phase256<G_MOE2>(p, l, (LAS unsigned char*)smem, tinfo)); \
        REPEAT(REP_BAR, xcd_barrier(bar)); \
        REPEAT(REP_COMB, phase_combine(p, l, tinfo)); \
        if (l == 0) xcd_barrier(bar); \
    } while (0)
    LAYER(0);
    LAYER(1);
#undef LAYER
}

extern "C" void kernel_launch(void* const* d_in, const int* in_sizes, int n_in, void* d_out, int out_size, void* d_ws, size_t ws_size, hipStream_t stream) {
    static int grid = 0;
    if (n_in != 29 || ws_size < WS_END) { fprintf(stderr, "kernel_launch: need 29 inputs and %zu bytes of workspace (got %d, %zu)\n", (size_t)WS_END, n_in, ws_size); return; }
    if (!grid) {
        int dev = 0, cus = 0, per_cu = 0;
        (void)hipGetDevice(&dev);
        (void)hipDeviceGetAttribute(&cus, hipDeviceAttributeMultiprocessorCount, dev);
        (void)hipFuncSetAttribute((const void*)k_fwd, hipFuncAttributeMaxDynamicSharedMemorySize, LDS_BYTES);
        (void)hipOccupancyMaxActiveBlocksPerMultiprocessor(&per_cu, (const void*)k_fwd, 512, LDS_BYTES);
        if (per_cu < 1) fprintf(stderr, "kernel_launch: occupancy query reports %d workgroups per CU\n", per_cu);
        grid = cus > 0 ? cus : 256;
    }
    Params p;
    const float** pp = (const float**)&p;
    for (int i = 0; i < 29; ++i) pp[i] = (const float*)d_in[i];
    p.out = (float*)d_out; p.ws = (unsigned char*)d_ws;
    (void)hipMemsetAsync((char*)d_ws + WS_CTL, 0, CTL_BYTES, stream);
    hipLaunchKernelGGL(k_fwd, dim3(grid), dim3(512), LDS_BYTES, stream, p);
}
```

```cpp
#include <hip/hip_runtime.h>
#include <cstdio>
#include <cstdint>

#define REP_PRO0 1
#define REP_TILE 1
#define REP_EPI 1
#define REP_KL8 1
#define REP_KL16 1
#define REP_ROUTE 1
#define REP_BAR 1
#define REP_PRO1 1
#define REP_TR 1
#define REP_FOLD 1
#define REP_WIN 1
#define REP_PREP 1
#define REP_DF 1
#define REP_NA 1
#define REP_DFT 1
#define REP_WOUT 1
#define REP_MOE1 1
#define REP_MOE2 1
#define REP_COMB 1
#define REPEAT(n, stmt) do { _Pragma("unroll") for (int _r = 0; _r < (n); ++_r) { stmt; } } while (0)
typedef unsigned short bf16_t;
typedef short bf16x8 __attribute__((ext_vector_type(8)));
typedef float f32x4 __attribute__((ext_vector_type(4)));
typedef float f32x16 __attribute__((ext_vector_type(16)));
typedef float f32x2 __attribute__((ext_vector_type(2)));
typedef unsigned u32x4 __attribute__((ext_vector_type(4)));
typedef unsigned u32x2 __attribute__((ext_vector_type(2)));
typedef int i32x8 __attribute__((ext_vector_type(8)));
constexpr float SW8 = 64.f, SH8 = 16.f, SA8 = 4.f, SY8 = 16.f;

constexpr int NB = 8, SEQ = 2048, DM = 1024, LC = 256;
constexpr int NX = NB * SEQ, NC = NB * LC, NT = NX + NC;
constexpr int NIN = 2304;
constexpr int NE = 32, FF = 1024, KEYS = LC + SEQ;
constexpr int MAXSLOT = 81920;
constexpr float EPS = 1e-6f;

constexpr size_t al256(size_t x) { return (x + 255) & ~(size_t)255; }
constexpr size_t WS_CTL   = 0;
constexpr size_t CTL_BYTES = 65536;
constexpr size_t CTL_CNT  = 32768;
constexpr size_t CTL_PRO0 = 49152;
constexpr size_t WS_MOD   = WS_CTL + CTL_BYTES;
constexpr size_t WS_SCAL  = al256(WS_MOD + (size_t)2 * 9 * 6144 * 4);
constexpr size_t WS_ROPE  = al256(WS_SCAL + 2 * 16 * 4);
constexpr size_t WS_WIN   = al256(WS_ROPE + 64 * 8 * 2 * 4);
constexpr size_t WS_WOUT  = al256(WS_WIN + (size_t)2 * NIN * DM * 2);
constexpr size_t WS_W1    = al256(WS_WOUT + (size_t)2 * DM * DM * 2);
constexpr size_t WS_W2    = al256(WS_W1 + (size_t)2 * NE * 2048 * DM * 2);
constexpr size_t WS_DFTM  = al256(WS_W2 + (size_t)2 * NE * DM * FF * 2);
constexpr size_t WS_DFTC  = al256(WS_DFTM + (size_t)2048 * 2048 * 2);
constexpr size_t WS_H     = al256(WS_DFTC + (size_t)256 * 256 * 2);
constexpr size_t WS_PX    = al256(WS_H + (size_t)NT * DM * 2);
constexpr size_t QKV_ONE  = (size_t)NB * 4 * KEYS * 64 * 2;
constexpr size_t WS_QA    = al256(WS_PX + (size_t)NT * NIN * 2);
constexpr size_t WS_KA    = al256(WS_QA + QKV_ONE);
constexpr size_t WS_VTA   = al256(WS_KA + QKV_ONE);
constexpr size_t WS_QD    = al256(WS_VTA + QKV_ONE);
constexpr size_t WS_KD    = al256(WS_QD + QKV_ONE);
constexpr size_t WS_VTD   = al256(WS_KD + QKV_ONE);
constexpr size_t WS_XF    = al256(WS_VTD + QKV_ONE);
constexpr size_t WS_XFC   = al256(WS_XF + (size_t)2048 * 2048 * 2);
constexpr size_t WS_YCAT  = al256(WS_XFC + (size_t)2048 * 256 * 2);
constexpr size_t WS_X1    = al256(WS_YCAT + (size_t)NT * DM * 2);
constexpr size_t WS_X2    = al256(WS_X1 + (size_t)NT * DM * 4);
constexpr size_t WS_RTE   = al256(WS_X2 + (size_t)NT * DM * 4);
constexpr size_t WS_RTP   = al256(WS_RTE + (size_t)NT * 4 * 4);
constexpr size_t WS_RTG   = al256(WS_RTP + (size_t)NT * 4 * 4);
constexpr size_t WS_LIST  = al256(WS_RTG + (size_t)NT * 4 * 4);
constexpr size_t WS_ACT   = al256(WS_LIST + (size_t)NE * NT * 4);
constexpr size_t WS_Y2    = al256(WS_ACT + (size_t)MAXSLOT * FF * 2);
constexpr size_t WS_H8    = al256(WS_Y2 + (size_t)MAXSLOT * DM * 2);
constexpr size_t WS_RWT   = al256(WS_H8 + (size_t)NT * DM);
constexpr size_t WS_END   = al256(WS_RWT + (size_t)2 * NE * DM * 2);

struct Params {
    const float *x, *c, *ctx, *c_ctx, *w_ada, *b_ada, *g1w, *g2w, *w_in, *w_out, *na_qg, *na_kg, *na_rpb, *df_qg, *df_kg,
                *lq1, *lk1, *lq2, *lk2, *subln, *pool_w, *pool_scale, *fft_w, *router_w, *router_b, *w1, *b1, *w2, *b2;
    float* out;
    unsigned char* ws;
};
typedef __attribute__((address_space(1))) unsigned char g_u8;
__device__ __forceinline__ unsigned char* ws_base(unsigned char* w) { g_u8* g = (g_u8*)w; asm volatile("" : "+s"(g)); return (unsigned char*)g; }
#define WSP(T, off) ((T*)(ws_base(p.ws) + (off)))

__device__ __forceinline__ unsigned pk2(float lo, float hi) {
    typedef __bf16 bf2 __attribute__((ext_vector_type(2)));
    bf2 r = __builtin_convertvector((f32x2){lo, hi}, bf2);
    return *(unsigned*)&r;
}
__device__ __forceinline__ unsigned pk4_fp8(float a, float b, float c, float d) { int r = 0; r = __builtin_amdgcn_cvt_pk_fp8_f32(a, b, r, false); r = __builtin_amdgcn_cvt_pk_fp8_f32(c, d, r, true); return (unsigned)r; }
__device__ __forceinline__ bf16_t f2bf(float f) { return (bf16_t)(pk2(f, 0.f) & 0xffffu); }
__device__ __forceinline__ float bflo(unsigned u) { return __uint_as_float(u << 16); }
__device__ __forceinline__ float bfhi(unsigned u) { return __uint_as_float(u & 0xffff0000u); }
__device__ __forceinline__ float bf2f(bf16_t b) { return __uint_as_float(((unsigned)b) << 16); }
__device__ __forceinline__ float wave_sum(float v) {
#pragma unroll
    for (int o = 1; o < 64; o <<= 1) v += __shfl_xor(v, o);
    return v;
}
#define DPP_F(v, ctrl) __builtin_bit_cast(float, __builtin_amdgcn_update_dpp(0, __builtin_bit_cast(int, (v)), (ctrl), 0xf, 0xf, true))
__device__ __forceinline__ float sum8_dpp(float v)  { v += DPP_F(v, 0xB1); v += DPP_F(v, 0x4E); v += DPP_F(v, 0x141); return v; }
__device__ __forceinline__ float sum16_dpp(float v) { v += DPP_F(v, 0xB1); v += DPP_F(v, 0x4E); v += DPP_F(v, 0x141); v += DPP_F(v, 0x140); return v; }
__device__ __forceinline__ float wave_sum_fast(float v) {
    v += __builtin_bit_cast(float, __builtin_amdgcn_update_dpp(0, __builtin_bit_cast(int, v), 0xB1, 0xf, 0xf, true));
    v += __builtin_bit_cast(float, __builtin_amdgcn_update_dpp(0, __builtin_bit_cast(int, v), 0x4E, 0xf, 0xf, true));
    v += __builtin_bit_cast(float, __builtin_amdgcn_update_dpp(0, __builtin_bit_cast(int, v), 0x141, 0xf, 0xf, true));
    v += __builtin_bit_cast(float, __builtin_amdgcn_update_dpp(0, __builtin_bit_cast(int, v), 0x140, 0xf, 0xf, true));
    const float a = __builtin_bit_cast(float, __builtin_amdgcn_readlane(__builtin_bit_cast(int, v), 0)), b = __builtin_bit_cast(float, __builtin_amdgcn_readlane(__builtin_bit_cast(int, v), 16));
    const float c = __builtin_bit_cast(float, __builtin_amdgcn_readlane(__builtin_bit_cast(int, v), 32)), d = __builtin_bit_cast(float, __builtin_amdgcn_readlane(__builtin_bit_cast(int, v), 48));
    return (a + b) + (c + d);
}
__device__ __forceinline__ float wave_max(float v) {
#pragma unroll
    for (int o = 1; o < 64; o <<= 1) v = fmaxf(v, __shfl_xor(v, o));
    return v;
}
__device__ __forceinline__ int hid_tid() { int t = threadIdx.x; asm volatile("" : "+v"(t)); return t; }
__device__ __forceinline__ void unpack4(u32x2 r, float (&v)[4]) { v[0] = bflo(r.x); v[1] = bfhi(r.x); v[2] = bflo(r.y); v[3] = bfhi(r.y); }

__device__ __forceinline__ void mod_row(const float* xrow, const float* gw, const float* sh, const float* sc, bf16_t* orow, int lane, f32x4 (&hv)[4]) {
    f32x4 v[4]; float ss = 0.f;
#pragma unroll
    for (int j = 0; j < 4; ++j) { v[j] = ((const f32x4*)xrow)[lane + 64 * j]; ss += v[j].x * v[j].x + v[j].y * v[j].y + v[j].z * v[j].z + v[j].w * v[j].w; }
    ss = wave_sum_fast(ss);
    const float rs = rsqrtf(ss * (1.f / DM) + EPS);
#pragma unroll
    for (int j = 0; j < 4; ++j) {
        const int c = 4 * lane + 256 * j;
        const f32x4 g = *(const f32x4*)(gw + c), s1 = *(const f32x4*)(sc + c), s0 = *(const f32x4*)(sh + c);
        f32x4 o;
        o.x = v[j].x * rs * g.x * (1.f + s1.x) + s0.x; o.y = v[j].y * rs * g.y * (1.f + s1.y) + s0.y;
        o.z = v[j].z * rs * g.z * (1.f + s1.z) + s0.z; o.w = v[j].w * rs * g.w * (1.f + s1.w) + s0.w;
        hv[j] = o;
        u32x2 pk; pk.x = pk2(o.x, o.y); pk.y = pk2(o.z, o.w);
        *(u32x2*)(orow + c) = pk;
    }
}
__device__ __forceinline__ int mod_index(int r) { return r < NX ? (r >> 11) : 8; }

__device__ __forceinline__ void phase_pro0(const Params& p, unsigned char* smem) {
    float* act = (float*)smem;
    float* red = act + 9 * 1024;
    const int tid = hid_tid(), lane = tid & 63, wave = tid >> 6;
    for (int i = tid; i < 9 * 1024; i += 512) { const int r = i >> 10, k = i & 1023; const float v = (r < 8) ? p.c[r * 1024 + k] : p.c_ctx[k]; act[i] = v / (1.f + expf(-v)); }
    __syncthreads();
    float* MOD = WSP(float, WS_MOD);
    for (int item = blockIdx.x; item < 96; item += gridDim.x) {
        const int l = item / 48, ch = item % 48, hl = lane >> 5, cl = lane & 31;
        const float* w = p.w_ada + (size_t)l * 1024 * 6144 + ch * 128 + 4 * cl;
        f32x4 acc[9];
#pragma unroll
        for (int r = 0; r < 9; ++r) acc[r] = (f32x4){0.f, 0.f, 0.f, 0.f};
        const int k0 = wave * 128 + hl;
#pragma unroll 8
        for (int i = 0; i < 64; ++i) {
            const int k = k0 + 2 * i;
            const f32x4 wv = __builtin_nontemporal_load((const f32x4*)(w + (size_t)k * 6144));
#pragma unroll
            for (int r = 0; r < 9; ++r) { const float a = act[r * 1024 + k]; acc[r].x += a * wv.x; acc[r].y += a * wv.y; acc[r].z += a * wv.z; acc[r].w += a * wv.w; }
        }
#pragma unroll
        for (int r = 0; r < 9; ++r) {
            acc[r].x += __shfl_xor(acc[r].x, 32); acc[r].y += __shfl_xor(acc[r].y, 32); acc[r].z += __shfl_xor(acc[r].z, 32); acc[r].w += __shfl_xor(acc[r].w, 32);
            if (hl == 0) *(f32x4*)(red + (wave * 9 + r) * 128 + 4 * cl) = acc[r];
        }
        __syncthreads();
        for (int i = tid; i < 9 * 128; i += 512) {
            const int r = i >> 7, cc = i & 127; float s = 0.f;
#pragma unroll
            for (int w8 = 0; w8 < 8; ++w8) s += red[(w8 * 9 + r) * 128 + cc];
            MOD[(size_t)(l * 9 + r) * 6144 + ch * 128 + cc] = s + p.b_ada[l * 6144 + ch * 128 + cc];
        }
        __syncthreads();
    }
    if (blockIdx.x == gridDim.x - 2) {
        float* RT = WSP(float, WS_ROPE);
        const int pos = tid >> 3, f = tid & 7; const float ang = (float)pos * expf(-(float)f * 1.151292546497023f);
        RT[2 * tid] = cosf(ang); RT[2 * tid + 1] = sinf(ang);
    }
    if (blockIdx.x == gridDim.x - 1 && wave == 0) {
        float* SC = WSP(float, WS_SCAL);
        for (int l = 0; l < 2; ++l) {
            float s1 = lane < 32 ? p.lq1[l * 32 + lane] * p.lk1[l * 32 + lane] : 0.f;
            float s2 = lane < 32 ? p.lq2[l * 32 + lane] * p.lk2[l * 32 + lane] : 0.f;
            s1 = wave_sum(s1); s2 = wave_sum(s2);
            const float lam_init = 0.8f - 0.6f * expf(-0.3f * (float)l);
            const float lam = expf(s1) - expf(s2) + lam_init;
            const float mq = wave_max(lane < 32 ? fabsf(p.df_qg[l * 32 + lane]) : 0.f), mk = wave_max(lane < 32 ? fabsf(p.df_kg[l * 32 + lane]) : 0.f);
            const float aq = wave_max(fabsf(p.na_qg[l * 64 + lane])), ak = wave_max(fabsf(p.na_kg[l * 64 + lane]));
            if (lane == 0) { SC[l * 16 + 0] = lam; SC[l * 16 + 1] = lam_init; SC[l * 16 + 2] = 5.656854249f * 1.44269504f * mq * mk; }
            for (int h = 0; h < 4; ++h) {
                float mb = 0.f;
                for (int i = lane; i < 15 * 31; i += 64) mb = fmaxf(mb, p.na_rpb[((size_t)(l * 4 + h)) * 465 + i]);
                mb = wave_max(mb);
                if (lane == 0) SC[l * 16 + 4 + h] = (8.f * aq * ak + mb) * 1.44269504f;
            }
        }
    }
    asm volatile("s_waitcnt vmcnt(0)" ::: "memory");
    __syncthreads();
    if (tid == 0) {
        __builtin_amdgcn_fence(__ATOMIC_RELEASE, "agent");
        asm volatile("s_waitcnt vmcnt(0)" ::: "memory");
        __hip_atomic_fetch_add(WSP(unsigned, WS_CTL + CTL_PRO0), 1u, __ATOMIC_RELAXED, __HIP_MEMORY_SCOPE_AGENT);
    }
}

__device__ __forceinline__ void transpose_item(const float* W, int ldw, int K, bf16_t* WT, unsigned char* sm, int kb, int nb, int lane) {
    const int q = lane >> 4, c4 = lane & 15;
    const float* src = W + (size_t)(64 * kb + 16 * q) * ldw + 64 * nb + 4 * c4;
    f32x4 r[16];
#pragma unroll
    for (int j = 0; j < 16; ++j) r[j] = *(const f32x4*)(src + (size_t)j * ldw);
#pragma unroll
    for (int c = 0; c < 4; ++c) {
        u32x4 o0, o1;
        o0.x = pk2(r[0][c], r[1][c]); o0.y = pk2(r[2][c], r[3][c]); o0.z = pk2(r[4][c], r[5][c]); o0.w = pk2(r[6][c], r[7][c]);
        o1.x = pk2(r[8][c], r[9][c]); o1.y = pk2(r[10][c], r[11][c]); o1.z = pk2(r[12][c], r[13][c]); o1.w = pk2(r[14][c], r[15][c]);
        unsigned char* d = sm + (4 * c4 + c) * 144 + 32 * q;
        *(u32x4*)d = o0; *(u32x4*)(d + 16) = o1;
    }
    __builtin_amdgcn_s_waitcnt(0xc07f); asm volatile("" ::: "memory");
    bf16_t* dst = WT + (size_t)(64 * nb + (lane >> 3)) * K + 64 * kb + 8 * (lane & 7);
#pragma unroll
    for (int i = 0; i < 8; ++i) { const u32x4 o = *(const u32x4*)(sm + (8 * i + (lane >> 3)) * 144 + 16 * (lane & 7)); *(u32x4*)(dst + (size_t)(8 * i) * K) = o; }
    __builtin_amdgcn_s_waitcnt(0xc07f); asm volatile("" ::: "memory");
}

__device__ __forceinline__ void transpose_item8(const float* W, int ldw, int K, unsigned char* WT, unsigned char* sm, int kb, int nb, int lane) {
    const int q = lane >> 4, c4 = lane & 15;
    const float* src = W + (size_t)(64 * kb + 16 * q) * ldw + 64 * nb + 4 * c4;
    f32x4 r[16];
#pragma unroll
    for (int j = 0; j < 16; ++j) r[j] = *(const f32x4*)(src + (size_t)j * ldw) * SW8;
#pragma unroll
    for (int c = 0; c < 4; ++c) {
        u32x4 o; o.x = pk4_fp8(r[0][c], r[1][c], r[2][c], r[3][c]); o.y = pk4_fp8(r[4][c], r[5][c], r[6][c], r[7][c]);
        o.z = pk4_fp8(r[8][c], r[9][c], r[10][c], r[11][c]); o.w = pk4_fp8(r[12][c], r[13][c], r[14][c], r[15][c]);
        *(u32x4*)(sm + (4 * c4 + c) * 80 + 16 * q) = o;
    }
    __builtin_amdgcn_s_waitcnt(0xc07f); asm volatile("" ::: "memory");
    unsigned char* dst = WT + (size_t)(64 * nb + (lane >> 2)) * K + 64 * kb + 16 * (lane & 3);
#pragma unroll
    for (int i = 0; i < 4; ++i) { const u32x4 o = *(const u32x4*)(sm + (16 * i + (lane >> 2)) * 80 + 16 * (lane & 3)); *(u32x4*)(dst + (size_t)(16 * i) * K) = o; }
    __builtin_amdgcn_s_waitcnt(0xc07f); asm volatile("" ::: "memory");
}

__device__ __forceinline__ void phase_pro1(const Params& p, unsigned char* smem) {
    const int tid = hid_tid(), lane = tid & 63, wave = tid >> 6;
    const int gw = blockIdx.x * 8 + wave, ngw = gridDim.x * 8;
    bf16_t* WIN = WSP(bf16_t, WS_WIN);
    {
        float* Mf = (float*)smem;
        float* tile = Mf + 4096 + wave * (64 * 65);
        float* trig = Mf + 4096 + 8 * (64 * 65);
        if (tid < 128) { const int i = tid & 63; const float a = (float)i * (1.f / 32.f); trig[tid] = tid < 64 ? cospif(a) : sinpif(a); }
        __syncthreads();
        for (int rep_ = 0; rep_ < REP_FOLD; ++rep_)
        for (int it = blockIdx.x; it < 96; it += gridDim.x) {
            const int kq = it & 3, g = (it >> 2) & 3, kind = (it >> 4) % 3, l = it / 48;
            for (int i = tid; i < 4096; i += 512) {
                const int cch = i >> 6, e = i & 63; float v;
                if (kind == 0) v = p.pool_w[((size_t)(l * 4 + g) * 64 + cch) * 64 + e] * p.pool_scale[l * 256 + g * 64 + e];
                else {
                    const float* fw = p.fft_w + (size_t)(l * 4 + g) * 4096 + e; const float* tb = trig + (kind == 1 ? 0 : 64);
                    float s = 0.f;
#pragma unroll 8
                    for (int m = 0; m < 64; ++m) s += tb[(m * cch) & 63] * fw[m * 64];
                    v = s * 0.125f;
                }
                Mf[i] = v;
            }
            __syncthreads();
            const int srcb = (kind == 0 ? 1536 : 1792) + 64 * g, dstb = (kind == 0 ? 1536 : (kind == 1 ? 1792 : 2048)) + 64 * g;
            {
                const int kb = 4 * kq + (wave & 3), eh = wave >> 2;
                for (int i = 0; i < 64; ++i) tile[i * 65 + lane] = p.w_in[((size_t)l * 1024 + 64 * kb + i) * 2048 + srcb + lane];
                __builtin_amdgcn_s_waitcnt(0xc07f); asm volatile("" ::: "memory");
                float acc[32];
#pragma unroll
                for (int e = 0; e < 32; ++e) acc[e] = 0.f;
                for (int cch = 0; cch < 64; ++cch) {
                    const float a = tile[lane * 65 + cch];
#pragma unroll
                    for (int e = 0; e < 32; ++e) acc[e] += a * Mf[cch * 64 + eh * 32 + e];
                }
#pragma unroll
                for (int e = 0; e < 32; ++e) WIN[((size_t)l * NIN + dstb + eh * 32 + e) * 1024 + 64 * kb + lane] = f2bf(acc[e]);
                __builtin_amdgcn_s_waitcnt(0xc07f); asm volatile("" ::: "memory");
            }
            __syncthreads();
        }
    }
    {
        unsigned char* tsm = smem + wave * (64 * 144);
        __syncthreads();
        constexpr int I_IN = 16 * 24, I_OUT = 16 * 16;
        constexpr int T0 = 2 * I_IN, T1 = T0 + 2 * I_OUT;
        for (int rep_ = 0; rep_ < REP_TR; ++rep_)
        for (int it = gw; it < T1; it += ngw) {
            if (it < T0) { const int l = it / I_IN, r = it % I_IN; transpose_item(p.w_in + (size_t)l * 1024 * 2048, 2048, 1024, WIN + (size_t)l * NIN * 1024, tsm, r % 16, r / 16, lane); }
            else { const int q = it - T0, l = q / I_OUT, r = q % I_OUT; transpose_item(p.w_out + (size_t)l * 1024 * 1024, 1024, 1024, WSP(bf16_t, WS_WOUT) + (size_t)l * 1024 * 1024, tsm, r % 16, r / 16, lane); }
        }
    }
    {
        bf16_t* DM_ = WSP(bf16_t, WS_DFTM); bf16_t* DC_ = WSP(bf16_t, WS_DFTC);
        const int gt = blockIdx.x * 512 + tid, ngt = gridDim.x * 512;
        for (int i = gt; i < 2048 * 256; i += ngt) {
            const int k = i >> 8, j0 = (i & 255) * 8; unsigned o[4];
#pragma unroll
            for (int q = 0; q < 4; ++q) { float v[2];
#pragma unroll
                for (int e = 0; e < 2; ++e) { const int j = j0 + 2 * q + e;
                    if (j <= 1024) { const int ph = (k * j) & 2047; v[e] = cospif((float)ph * (1.f / 1024.f)) * 0.02209708691f; }
                    else { const int ph = (k * (j - 1024)) & 2047; v[e] = -sinpif((float)ph * (1.f / 1024.f)) * 0.02209708691f; } }
                o[q] = pk2(v[0], v[1]); }
            *(u32x4*)(DM_ + (size_t)k * 2048 + j0) = (u32x4){o[0], o[1], o[2], o[3]};
        }
        for (int i = gt; i < 256 * 32; i += ngt) {
            const int k = i >> 5, j0 = (i & 31) * 8; unsigned o[4];
#pragma unroll
            for (int q = 0; q < 4; ++q) { float v[2];
#pragma unroll
                for (int e = 0; e < 2; ++e) { const int j = j0 + 2 * q + e;
                    if (j <= 128) { const int ph = (k * j) & 255; v[e] = cospif((float)ph * (1.f / 128.f)) * 0.0625f; }
                    else { const int ph = (k * (j - 128)) & 255; v[e] = -sinpif((float)ph * (1.f / 128.f)) * 0.0625f; } }
                o[q] = pk2(v[0], v[1]); }
            *(u32x4*)(DC_ + (size_t)k * 256 + j0) = (u32x4){o[0], o[1], o[2], o[3]};
        }
    }
    {
        bf16_t* RWT = WSP(bf16_t, WS_RWT);
        const int gt = blockIdx.x * 512 + tid, ngt = gridDim.x * 512;
        for (int i = gt; i < 2 * 32 * 128; i += ngt) {
            const int l = i >> 12, e = (i >> 7) & 31, k0 = (i & 127) * 8;
            const float* s = p.router_w + ((size_t)l * 1024 + k0) * 32 + e;
            u32x4 o; o.x = pk2(s[0], s[32]); o.y = pk2(s[64], s[96]); o.z = pk2(s[128], s[160]); o.w = pk2(s[192], s[224]);
            *(u32x4*)(RWT + ((size_t)(l * 32 + e)) * 1024 + k0) = o;
        }
    }
    {
        if (tid == 0) {
            unsigned* cnt = WSP(unsigned, WS_CTL + CTL_PRO0); unsigned sp = 0;
            while (__hip_atomic_load(cnt, __ATOMIC_RELAXED, __HIP_MEMORY_SCOPE_AGENT) < gridDim.x) { __builtin_amdgcn_s_sleep(2); if (++sp > (1u << 22)) break; }
            __builtin_amdgcn_fence(__ATOMIC_ACQUIRE, "agent");
            asm volatile("s_waitcnt vmcnt(0)" ::: "memory");
        }
        __syncthreads();
    }
    {
        const float* MOD = WSP(float, WS_MOD); bf16_t* H = WSP(bf16_t, WS_H);
        for (int r = gw; r < NT; r += ngw) {
            const float* xr = r < NX ? p.x + (size_t)r * DM : p.ctx + (size_t)(r - NX) * DM;
            const float* m = MOD + (size_t)(0 * 9 + mod_index(r)) * 6144;
            f32x4 hv[4];
            mod_row(xr, p.g1w, m, m + 1024, H + (size_t)r * DM, lane, hv);
        }
    }
}

enum { G_WIN = 0, G_DFT = 1, G_DFTC = 2, G_WOUT = 3, G_MOE1 = 4, G_MOE2 = 5 };
__device__ __forceinline__ void moe_tinfo(const Params& p, int l, int* tinfo) {
    if (threadIdx.x == 0) {
        const int* cnt = WSP(int, WS_CTL + CTL_CNT) + l * 32; int s = 0;
        for (int e = 0; e < 32; ++e) { const int c = cnt[e]; tinfo[e] = s; tinfo[33 + e] = c; s += (c + 255) >> 8; }
        tinfo[32] = s;
    }
    __syncthreads();
}

#define LAS __attribute__((address_space(3)))
namespace g8 {
constexpr int BM = 256, BK = 64, HALF = 128, HTB = HALF * BK * 2, STAGE_BYTES = 8 * HTB, NXCD = 8, WGM = 8;
__host__ __device__ __forceinline__ int lds_xor(int r) { return (((r >> 1) & 1) * 3) | (r & 4); }
__host__ __device__ __forceinline__ int lds_byte(int r, int c) { return r * 128 + ((((c >> 3) ^ lds_xor(r)) & 7) << 4); }
__host__ __device__ __forceinline__ void stage_rc(int b, int& R, int& C) { const int r = b >> 7, cp = (b >> 4) & 7; R = r; C = ((cp ^ lds_xor(r)) & 7) * 8; }
}
struct UnitD { unsigned boff; const int* gather; int arow0, nvalid, orow0, ocol0, e; };
template <int KIND> __device__ __forceinline__ void phase_geom(int l, const int* tinfo, int& nM, int& nN, int& K) {
    if (KIND == G_WIN) { nM = 72; nN = 9; K = 1024; }
    else if (KIND == G_DFT) { nM = 8; nN = 8; K = 2048; }
    else if (KIND == G_DFTC) { nM = 1; nN = 8; K = 256; }
    else if (KIND == G_WOUT) { nM = (l == 0) ? 72 : 64; nN = 4; K = 1024; }
    else if (KIND == G_MOE1) { nM = __builtin_amdgcn_readfirstlane(tinfo[32]); nN = 8; K = 1024; }
    else { nM = __builtin_amdgcn_readfirstlane(tinfo[32]); nN = 4; K = 1024; }
}
template <int KIND> __device__ __forceinline__ const bf16_t* phase_A(const Params& p) {
    if (KIND == G_WIN) return WSP(bf16_t, WS_H);
    if (KIND == G_MOE1) return (const bf16_t*)WSP(unsigned char, WS_H8);
    if (KIND == G_DFT) return WSP(bf16_t, WS_DFTM);
    if (KIND == G_DFTC) return WSP(bf16_t, WS_DFTC);
    if (KIND == G_WOUT) return WSP(bf16_t, WS_YCAT);
    return WSP(bf16_t, WS_ACT);
}
template <int KIND> __device__ __forceinline__ const void* phase_B(const Params& p, int l) {
    if (KIND == G_WIN) return WSP(bf16_t, WS_WIN) + (size_t)l * NIN * 1024;
    if (KIND == G_DFT) return WSP(bf16_t, WS_XF);
    if (KIND == G_DFTC) return WSP(bf16_t, WS_XFC);
    if (KIND == G_WOUT) return WSP(bf16_t, WS_WOUT) + (size_t)l * 1024 * 1024;
    if (KIND == G_MOE1) return WSP(unsigned char, WS_W1) + (size_t)l * NE * 2048 * 1024;
    return WSP(unsigned char, WS_W2) + (size_t)l * NE * 1024 * 1024;
}
template <int KIND> __device__ __forceinline__ void get_unit(const Params& p, int l, int pm, int pn, const int* tinfo, UnitD& u) {
    u.gather = nullptr; u.nvalid = 256; u.e = 0; u.arow0 = pm * 256; u.orow0 = pm * 256; u.ocol0 = pn * 256;
    if (KIND == G_WIN) u.boff = (unsigned)pn * 256u * 1024u * 2u;
    else if (KIND == G_DFT) u.boff = (unsigned)pn * 256u * 2048u * 2u;
    else if (KIND == G_DFTC) u.boff = (unsigned)pn * 256u * 256u * 2u;
    else if (KIND == G_WOUT) u.boff = (unsigned)pn * 256u * 1024u * 2u;
    else {
        int e = 0; while (tinfo[e + 1] <= pm) ++e;
        e = __builtin_amdgcn_readfirstlane(e); u.e = e;
        if (KIND == G_MOE1) { u.gather = WSP(int, WS_LIST) + (size_t)e * NT; u.arow0 = __builtin_amdgcn_readfirstlane((pm - tinfo[e]) * 256); u.nvalid = __builtin_amdgcn_readfirstlane(tinfo[33 + e]) - u.arow0;
                              u.boff = (unsigned)(e * 2048 + pn * 256) * 1024u; }
        else u.boff = (unsigned)(e * 1024 + pn * 256) * 1024u;
    }
}
__device__ __forceinline__ bool static_order(int i, int G, int c, int nM, int nN, int& pm, int& pn) {
    const int nwg = nM * nN; const long L = (long)i * G + c; if (L >= nwg) return false;
    int wgid = (int)L; { const int q = nwg / g8::NXCD, r = nwg % g8::NXCD, xcd = wgid % g8::NXCD, off = wgid / g8::NXCD; wgid = (xcd < r ? xcd * (q + 1) : r * (q + 1) + (xcd - r) * q) + off; }
    const int nig = g8::WGM * nN, gid = wgid / nig, fm = gid * g8::WGM, gsz = (nM - fm) < g8::WGM ? (nM - fm) : g8::WGM;
    pm = fm + ((wgid % nig) % gsz); pn = (wgid % nig) / gsz; return true;
}
template <int KIND>
__device__ __forceinline__ void gemm_phase256(const Params& p, const int l, LAS unsigned char* lds, const int* tinfo) {
    using namespace g8;
    const int tid = hid_tid(), wid = __builtin_amdgcn_readfirstlane(tid >> 6), lane = tid & 63, wr = wid >> 2, wc = wid & 3, fr = lane & 15, fq = lane >> 4;
    int nM, nN, K; phase_geom<KIND>(l, tinfo, nM, nN, K);
    constexpr bool F8 = (KIND == G_MOE1 || KIND == G_MOE2);
    constexpr int ES = F8 ? 1 : 2;
    constexpr int KREP = F8 ? REP_KL8 : REP_KL16;
    const int nt1 = K * ES / 128, nt = nt1 * KREP, G = gridDim.x, cwg = blockIdx.x;
    const __amdgpu_buffer_rsrc_t rsA = __builtin_amdgcn_make_buffer_rsrc((void*)phase_A<KIND>(p), 0, 0x7ffffff0, 0x00020000);
    const __amdgpu_buffer_rsrc_t rsB = __builtin_amdgcn_make_buffer_rsrc((void*)phase_B<KIND>(p, l), 0, 0x7ffffff0, 0x00020000);
    unsigned voffB[2];
#pragma unroll
    for (int i = 0; i < 2; ++i) { int R_, C_; stage_rc(tid * 16 + i * 8192, R_, C_);
        const int rho = R_ & 31, Rb = F8 ? 64 * (R_ >> 5) + 16 * ((rho & 15) >> 2) + 4 * (rho >> 4) + (rho & 3) : (R_ & ~31) + 8 * ((rho & 15) >> 2) + 4 * (rho >> 4) + (rho & 3);
        voffB[i] = (unsigned)(Rb * K * ES + C_ * 2); }
    const unsigned kstep = 128u, hstepB = (unsigned)((F8 ? 8 : HALF) * K * ES);
    const unsigned ldsw = (unsigned)wid * 1024u;
    int aoffL[2], boffL[2];
    { const int ra = wr * 64 + fr, rb = wc * 32 + fr;
      if (F8) { aoffL[0] = lds_byte(ra, 16 * fq); aoffL[1] = lds_byte(ra, 16 * fq + 8); boffL[0] = lds_byte(rb, 16 * fq); boffL[1] = lds_byte(rb, 16 * fq + 8); }
      else { aoffL[0] = lds_byte(ra, fq * 8); aoffL[1] = lds_byte(ra, fq * 8 + 32); boffL[0] = lds_byte(rb, fq * 8); boffL[1] = lds_byte(rb, fq * 8 + 32); } }
#define G8_SA(b, h) (((b) * 2 + (h)) * HTB)
#define G8_SB(b, h) ((4 + (b) * 2 + (h)) * HTB)
#define G8_STAGE_A(bufoff, ktb, h) do { _Pragma("unroll") for (int _i = 0; _i < 2; ++_i) \
        __builtin_amdgcn_raw_ptr_buffer_load_lds(rsA, (LAS void*)(lds + (bufoff) + ldsw + _i * 8192), 16, aoff[h][_i], (int)(ktb), 0, 0); } while (0)
#define G8_STAGE_B(bufoff, soff) do { _Pragma("unroll") for (int _i = 0; _i < 2; ++_i) \
        __builtin_amdgcn_raw_ptr_buffer_load_lds(rsB, (LAS void*)(lds + (bufoff) + ldsw + _i * 8192), 16, voffB[_i], (int)(soff), 0, 0); } while (0)
#define G8_LDA(dst, b, h) do { _Pragma("unroll") for (int m = 0; m < 4; ++m) _Pragma("unroll") for (int k = 0; k < 2; ++k) { const u32x4 _v = *(const LAS u32x4*)(lds + G8_SA(b, h) + aoffL[k] + m * 2048); dst[m][4 * k] = (int)_v.x; dst[m][4 * k + 1] = (int)_v.y; dst[m][4 * k + 2] = (int)_v.z; dst[m][4 * k + 3] = (int)_v.w; } } while (0)
#define G8_LDB(dst, b, h) do { _Pragma("unroll") for (int n = 0; n < 2; ++n) _Pragma("unroll") for (int k = 0; k < 2; ++k) { const u32x4 _v = *(const LAS u32x4*)(lds + G8_SB(b, h) + boffL[k] + n * 2048); dst[n][4 * k] = (int)_v.x; dst[n][4 * k + 1] = (int)_v.y; dst[n][4 * k + 2] = (int)_v.z; dst[n][4 * k + 3] = (int)_v.w; } } while (0)
#define G8_MMA(ai, bj, At, Bt) do { __builtin_amdgcn_s_setprio(1); _Pragma("unroll") for (int m = 0; m < 4; ++m) _Pragma("unroll") for (int n = 0; n < 2; ++n) { \
        if (F8) acc[ai][bj][m][n] = __builtin_amdgcn_mfma_scale_f32_16x16x128_f8f6f4(Bt[n], At[m], acc[ai][bj][m][n], 0, 0, 0, 0, 0, 0); \
        else { typedef int i32x4_ __attribute__((ext_vector_type(4))); \
               const i32x4_ _a0 = __builtin_shufflevector(At[m], At[m], 0, 1, 2, 3), _a1 = __builtin_shufflevector(At[m], At[m], 4, 5, 6, 7); \
               const i32x4_ _b0 = __builtin_shufflevector(Bt[n], Bt[n], 0, 1, 2, 3), _b1 = __builtin_shufflevector(Bt[n], Bt[n], 4, 5, 6, 7); \
               acc[ai][bj][m][n] = __builtin_amdgcn_mfma_f32_16x16x32_bf16(*(const bf16x8*)&_b0, *(const bf16x8*)&_a0, acc[ai][bj][m][n], 0, 0, 0); \
               acc[ai][bj][m][n] = __builtin_amdgcn_mfma_f32_16x16x32_bf16(*(const bf16x8*)&_b1, *(const bf16x8*)&_a1, acc[ai][bj][m][n], 0, 0, 0); } } \
        __builtin_amdgcn_s_setprio(0); } while (0)
#define G8_WAIT_V(n) asm volatile("s_waitcnt vmcnt(" #n ")" ::: "memory")
#define G8_WAIT_L(n) asm volatile("s_waitcnt lgkmcnt(" #n ")" ::: "memory")
#define G8_BAR __builtin_amdgcn_s_barrier()
#define G8_SCHED __builtin_amdgcn_sched_barrier(0)
#define G8_AOFF(dst, u) do { _Pragma("unroll") for (int _h = 0; _h < 2; ++_h) _Pragma("unroll") for (int _i = 0; _i < 2; ++_i) { int _R, _C; stage_rc(tid * 16 + _i * 8192, _R, _C); const int _rt = _h * 128 + _R; int _ar; \
        if (KIND == G_MOE1) _ar = (u).gather[(u).arow0 + (_rt < (u).nvalid ? _rt : -(u).arow0)]; else _ar = (u).arow0 + _rt; \
        dst[_h][_i] = (unsigned)(_ar * K * ES + _C * 2); } } while (0)
    UnitD cur, nxt; int ui = 0, pm, pn;
    if (!static_order(0, G, cwg, nM, nN, pm, pn)) return;
    get_unit<KIND>(p, l, pm, pn, tinfo, cur);
    unsigned aoff[2][2]; G8_AOFF(aoff, cur);
    f32x4 acc[2][2][4][2];
#pragma unroll
    for (int a = 0; a < 2; ++a)
#pragma unroll
        for (int b = 0; b < 2; ++b)
#pragma unroll
            for (int m = 0; m < 4; ++m)
#pragma unroll
                for (int n = 0; n < 2; ++n) acc[a][b][m][n] = (f32x4){0.f, 0.f, 0.f, 0.f};
    i32x8 At[4], B0[2], B1[2];
    unsigned cB = cur.boff;
    G8_STAGE_B(G8_SB(0, 0), cB); G8_STAGE_A(G8_SA(0, 0), 0, 0); G8_STAGE_B(G8_SB(0, 1), cB + hstepB); G8_STAGE_A(G8_SA(0, 1), 0, 1);
    if (wr == 1) G8_BAR;
    G8_WAIT_V(4); G8_BAR;
    G8_STAGE_B(G8_SB(1, 0), cB + kstep); G8_STAGE_A(G8_SA(1, 0), kstep, 0); G8_STAGE_B(G8_SB(1, 1), cB + hstepB + kstep);
    G8_WAIT_V(6); G8_BAR;
    for (;;) {
        const bool has_next = static_order(ui + 1, G, cwg, nM, nN, pm, pn);
        if (has_next) get_unit<KIND>(p, l, pm, pn, tinfo, nxt);
        const unsigned nB = has_next ? nxt.boff : cB;
        if ((KIND == G_MOE1 || KIND == G_MOE2) && wid == 0) {
            const float* bsrc = ((KIND == G_MOE1) ? p.b1 + (size_t)(l * NE + cur.e) * 2048 : p.b2 + (size_t)(l * NE + cur.e) * 1024) + cur.ocol0 + 4 * lane;
            __builtin_amdgcn_global_load_lds((const unsigned*)bsrc, (LAS unsigned*)(lds + STAGE_BYTES + (ui & 1) * 1024), 16, 0, 0);
            if (KIND == G_MOE1 && has_next)
                __builtin_amdgcn_global_load_lds((const unsigned*)(nxt.gather + nxt.arow0 + 4 * lane), (LAS unsigned*)(lds + STAGE_BYTES + 2048 + ((ui + 1) & 1) * 1024), 16, 0, 0);
        }
#pragma unroll 1
        for (int t = 0; t < nt; t += 2) {
            const bool last = (t == nt - 2);
            if (KREP > 1 && t == nt - nt1) {
#pragma unroll
                for (int a = 0; a < 2; ++a)
#pragma unroll
                    for (int b = 0; b < 2; ++b)
#pragma unroll
                        for (int m = 0; m < 4; ++m)
#pragma unroll
                            for (int n = 0; n < 2; ++n) acc[a][b][m][n] = (f32x4){0.f, 0.f, 0.f, 0.f};
            }
            unsigned naoff1[2];
            if (KIND == G_MOE1 && last && has_next) {
                const LAS int* itab = (const LAS int*)(lds + STAGE_BYTES + 2048 + ((ui + 1) & 1) * 1024);
#pragma unroll
                for (int _i = 0; _i < 2; ++_i) { int _R, _C; stage_rc(tid * 16 + _i * 8192, _R, _C);
                    const int _r0 = _R, _r1 = 128 + _R;
                    const int a0 = itab[_r0 < nxt.nvalid ? _r0 : 0], a1 = itab[_r1 < nxt.nvalid ? _r1 : 0];
                    aoff[0][_i] = (unsigned)(a0 * K * ES + _C * 2); naoff1[_i] = (unsigned)(a1 * K * ES + _C * 2); }
            }
            G8_LDB(B0, 0, 0); G8_SCHED; G8_LDA(At, 0, 0); G8_STAGE_A(G8_SA(1, 1), (unsigned)((t + 1) & (nt1 - 1)) * kstep, 1);
            G8_WAIT_L(8); G8_BAR; G8_WAIT_L(0); G8_MMA(0, 0, At, B0); G8_BAR; G8_SCHED;
            unsigned kt2 = (unsigned)((t + 2) & (nt1 - 1)) * kstep; unsigned b2 = cB + kt2;
            if (last) { kt2 = 0; b2 = nB; if (has_next) { if (KIND == G_MOE1) { aoff[1][0] = naoff1[0]; aoff[1][1] = naoff1[1]; } else G8_AOFF(aoff, nxt); } }
            G8_LDB(B1, 0, 1); G8_STAGE_B(G8_SB(0, 0), b2);
            G8_BAR; G8_WAIT_L(0); G8_MMA(0, 1, At, B1); G8_BAR;
            G8_LDA(At, 0, 1); G8_STAGE_A(G8_SA(0, 0), kt2, 0);
            G8_BAR; G8_WAIT_L(0); G8_MMA(1, 0, At, B0); G8_BAR; G8_SCHED;
            G8_STAGE_B(G8_SB(0, 1), b2 + hstepB);
            G8_WAIT_V(6); G8_BAR; G8_MMA(1, 1, At, B1); G8_BAR;
            G8_LDB(B0, 1, 0); G8_SCHED; G8_LDA(At, 1, 0); G8_STAGE_A(G8_SA(0, 1), kt2, 1);
            G8_WAIT_L(8); G8_BAR; G8_WAIT_L(0); G8_MMA(0, 0, At, B0); G8_BAR; G8_SCHED;
            G8_LDB(B1, 1, 1); G8_STAGE_B(G8_SB(1, 0), b2 + kstep);
            G8_BAR; G8_WAIT_L(0); G8_MMA(0, 1, At, B1); G8_BAR;
            G8_LDA(At, 1, 1); G8_STAGE_A(G8_SA(1, 0), kt2 + kstep, 0);
            G8_BAR; G8_WAIT_L(0); G8_MMA(1, 0, At, B0); G8_BAR; G8_SCHED;
            G8_STAGE_B(G8_SB(1, 1), b2 + kstep + hstepB);
            G8_WAIT_V(6); G8_BAR; G8_MMA(1, 1, At, B1); G8_BAR;
        }
#if REP_EPI > 1
        int erep_n = F8 ? REP_EPI : 1; asm volatile("" : "+s"(erep_n));
#pragma unroll 1
        for (int erep_ = 0; erep_ < erep_n; ++erep_)
#endif
        {
            const int r0 = wr * 64 + fr, c0 = wc * 32 + 8 * fq;
            f32x4 cv[2][2];
            if (KIND == G_MOE1 || KIND == G_MOE2 || KIND == G_WOUT) {
                const float* cbase = WSP(float, WS_MOD) + (size_t)(l * 9 + mod_index(cur.orow0)) * 6144 + 2048;
#pragma unroll
                for (int bj = 0; bj < 2; ++bj)
#pragma unroll
                    for (int n = 0; n < 2; ++n) {
                        if (KIND == G_WOUT) cv[bj][n] = *(const f32x4*)(cbase + cur.ocol0 + bj * HALF + c0 + 4 * n);
                        else cv[bj][n] = *(const LAS f32x4*)(lds + STAGE_BYTES + (ui & 1) * 1024 + (wc * 64 + 16 * fq + 8 * bj + 4 * n) * 4);
                    }
            }
#pragma unroll
            for (int ai = 0; ai < 2; ++ai) {
                if (KIND == G_WOUT) {
                    f32x4 xv[4][2][2];
#pragma unroll
                    for (int m = 0; m < 4; ++m) {
                        const int row = cur.orow0 + ai * HALF + r0 + m * 16;
                        if (l == 0) {
                            const float* xin = row < NX ? p.x + (size_t)row * DM : p.ctx + (size_t)(row - NX) * DM;
#pragma unroll
                            for (int bj = 0; bj < 2; ++bj)
#pragma unroll
                                for (int n = 0; n < 2; ++n) xv[m][bj][n] = *(const f32x4*)(xin + cur.ocol0 + bj * HALF + c0 + 4 * n);
                        } else {
#pragma unroll
                            for (int bj = 0; bj < 2; ++bj) { const u32x4 w = *(const u32x4*)(WSP(bf16_t, WS_X2) + (size_t)row * DM + cur.ocol0 + bj * HALF + c0);
                                xv[m][bj][0] = (f32x4){bflo(w.x), bfhi(w.x), bflo(w.y), bfhi(w.y)}; xv[m][bj][1] = (f32x4){bflo(w.z), bfhi(w.z), bflo(w.w), bfhi(w.w)}; }
                        }
                    }
#pragma unroll
                    for (int m = 0; m < 4; ++m) {
                        const int row = cur.orow0 + ai * HALF + r0 + m * 16;
#pragma unroll
                        for (int bj = 0; bj < 2; ++bj) {
                            const f32x4 v0 = acc[ai][bj][m][0], v1 = acc[ai][bj][m][1], g0 = cv[bj][0], g1 = cv[bj][1], x0 = xv[m][bj][0], x1 = xv[m][bj][1];
                            u32x4 o; o.x = pk2(x0.x + g0.x * v0.x, x0.y + g0.y * v0.y); o.y = pk2(x0.z + g0.z * v0.z, x0.w + g0.w * v0.w);
                            o.z = pk2(x1.x + g1.x * v1.x, x1.y + g1.y * v1.y); o.w = pk2(x1.z + g1.z * v1.z, x1.w + g1.w * v1.w);
                            *(u32x4*)(WSP(bf16_t, WS_X1) + (size_t)row * DM + cur.ocol0 + bj * HALF + c0) = o;
                        }
                    }
                } else {
#pragma unroll
                    for (int m = 0; m < 4; ++m) {
                        const int row = cur.orow0 + ai * HALF + r0 + m * 16;
                        if (F8) {
                            const int colw = cur.ocol0 + wc * 64 + 16 * fq;
                            unsigned ow[2][2];
#pragma unroll
                            for (int bj = 0; bj < 2; ++bj) {
                                const f32x4 v0 = acc[ai][bj][m][0], v1 = acc[ai][bj][m][1];
                                if (KIND == G_MOE1) {
                                    constexpr float dq = 1.f / (SW8 * SH8);
                                    const f32x4 b0 = cv[bj][0], b1 = cv[bj][1];
                                    const float u[8] = {v0.x * dq + b0.x, v0.y * dq + b0.y, v0.z * dq + b0.z, v0.w * dq + b0.w, v1.x * dq + b1.x, v1.y * dq + b1.y, v1.z * dq + b1.z, v1.w * dq + b1.w};
                                    float o[4];
#pragma unroll
                                    for (int q = 0; q < 4; ++q) { const float g = fminf(u[2 * q], 7.f), li = fminf(fmaxf(u[2 * q + 1], -7.f), 7.f);
                                        o[q] = g * __builtin_amdgcn_rcpf(1.f + __builtin_amdgcn_exp2f(-2.45546696f * g)) * (li + 1.f) * SA8; }
                                    ow[bj][0] = pk4_fp8(o[0], o[1], o[2], o[3]); ow[bj][1] = 0u;
                                } else {
                                    constexpr float dq = SY8 / (SW8 * SA8);
                                    const f32x4 b0 = cv[bj][0] * SY8, b1 = cv[bj][1] * SY8;
#define CL8(x) fminf(fmaxf((x), -448.f), 448.f)
                                    ow[bj][0] = pk4_fp8(CL8(v0.x * dq + b0.x), CL8(v0.y * dq + b0.y), CL8(v0.z * dq + b0.z), CL8(v0.w * dq + b0.w));
                                    ow[bj][1] = pk4_fp8(CL8(v1.x * dq + b1.x), CL8(v1.y * dq + b1.y), CL8(v1.z * dq + b1.z), CL8(v1.w * dq + b1.w));
#undef CL8
                                }
                            }
                            if (KIND == G_MOE1) { u32x2 o; o.x = ow[0][0]; o.y = ow[1][0]; *(u32x2*)(WSP(unsigned char, WS_ACT) + (size_t)row * FF + (colw >> 1)) = o; }
                            else { u32x4 o; o.x = ow[0][0]; o.y = ow[0][1]; o.z = ow[1][0]; o.w = ow[1][1]; *(u32x4*)(WSP(unsigned char, WS_Y2) + (size_t)row * DM + colw) = o; }
                        } else {
#pragma unroll
                            for (int bj = 0; bj < 2; ++bj) {
                                const f32x4 v0 = acc[ai][bj][m][0], v1 = acc[ai][bj][m][1]; const int col = cur.ocol0 + bj * HALF + c0;
                                u32x4 o; o.x = pk2(v0.x, v0.y); o.y = pk2(v0.z, v0.w); o.z = pk2(v1.x, v1.y); o.w = pk2(v1.z, v1.w);
                                bf16_t* dst;
                                if (KIND == G_WIN) dst = WSP(bf16_t, WS_PX) + (size_t)row * NIN + col;
                                else if (KIND == G_DFT) dst = WSP(bf16_t, WS_YCAT) + (size_t)((col >> 8) * SEQ + row) * DM + 768 + (col & 255);
                                else dst = WSP(bf16_t, WS_YCAT) + (size_t)(NX + (col >> 8) * LC + row) * DM + 768 + (col & 255);
                                *(u32x4*)dst = o;
                            }
                        }
                    }
                }
            }
        }
        if (!has_next) break;
#pragma unroll
        for (int a = 0; a < 2; ++a)
#pragma unroll
            for (int b = 0; b < 2; ++b)
#pragma unroll
                for (int m = 0; m < 4; ++m)
#pragma unroll
                    for (int n = 0; n < 2; ++n) acc[a][b][m][n] = (f32x4){0.f, 0.f, 0.f, 0.f};
        cur = nxt; cB = nB; ++ui;
    }
    G8_WAIT_V(0);
    if (wr == 0) G8_BAR;
    G8_BAR;
#undef G8_SA
#undef G8_SB
#undef G8_STAGE_A
#undef G8_STAGE_B
#undef G8_LDA
#undef G8_LDB
#undef G8_MMA
#undef G8_WAIT_V
#undef G8_WAIT_L
#undef G8_BAR
#undef G8_SCHED
#undef G8_AOFF
}

__device__ __forceinline__ void wave_transpose_store(bf16_t* sm  , const u32x4 (&v)[8], bf16_t* dst, size_t dstride, int lane, int cpos) {
#pragma unroll
    for (int i = 0; i < 8; ++i) {
        const unsigned w[4] = {v[i].x, v[i].y, v[i].z, v[i].w};
#pragma unroll
        for (int q = 0; q < 4; ++q) { sm[(8 * i + 2 * q) * 72 + cpos] = (bf16_t)(w[q] & 0xffffu); sm[(8 * i + 2 * q + 1) * 72 + cpos] = (bf16_t)(w[q] >> 16); }
    }
    __builtin_amdgcn_s_waitcnt(0xc07f); asm volatile("" ::: "memory");
#pragma unroll
    for (int i = 0; i < 8; ++i) { const u32x4 o = *(const u32x4*)(sm + lane * 72 + 8 * i); *(u32x4*)(dst + (size_t)lane * dstride + 8 * i) = o; }
    __builtin_amdgcn_s_waitcnt(0xc07f); asm volatile("" ::: "memory");
}

__device__ __forceinline__ void phase_prep(const Params& p, const int l, unsigned char* smem) {
    const int tid = hid_tid(), lane = tid & 63, wave = tid >> 6;
    const int gw = blockIdx.x * 8 + wave, ngw = gridDim.x * 8;
    const bf16_t* PX = WSP(bf16_t, WS_PX); const float* ROPE = WSP(float, WS_ROPE);
    bf16_t *QA = WSP(bf16_t, WS_QA), *KA = WSP(bf16_t, WS_KA), *QD = WSP(bf16_t, WS_QD), *KD = WSP(bf16_t, WS_KD), *YC = WSP(bf16_t, WS_YCAT);
    struct RowRaw { u32x2 q[4]; u32x2 wv[16]; u32x2 cu; };
    auto row_load = [&](int r, RowRaw& R) {
        const bool isctx = r >= NX; const int t = isctx ? ((r - NX) & 255) : (r & 2047);
        const bf16_t* px = PX + (size_t)r * NIN;
        R.q[0] = *(const u32x2*)(px + 4 * lane); R.q[1] = *(const u32x2*)(px + 256 + 4 * lane); R.q[2] = *(const u32x2*)(px + 768 + 4 * lane); R.q[3] = *(const u32x2*)(px + 1024 + 4 * lane);
        if (!(l == 1 && isctx)) {
            const int g = lane >> 4, win = 2 << g, Ls = isctx ? LC : SEQ;
            int lo = t - win / 2, hi = lo + win; lo = lo < 0 ? 0 : lo; hi = hi > Ls ? Ls : hi;
            const bf16_t* base = PX + (size_t)(r - t) * NIN + 1536 + 4 * lane;
#pragma unroll
            for (int j = 0; j < 16; ++j) { const int tt = lo + j < hi ? lo + j : hi - 1; R.wv[j] = *(const u32x2*)(base + (size_t)tt * NIN); }
            R.cu = *(const u32x2*)(base + (size_t)t * NIN);
        }
    };
    RowRaw cur, nxt;
    if (gw < NT) row_load(gw, nxt);
    for (int r = gw; r < NT; r += ngw) {
        cur = nxt;
        if (r + ngw < NT) row_load(r + ngw, nxt);
        const bool isctx = r >= NX; int b, t, kidx;
        if (!isctx) { b = r >> 11; t = r & 2047; kidx = 256 + t; } else { const int rr = r - NX; b = rr >> 8; t = rr & 255; kidx = t; }
        const int h = lane >> 4, d4 = (4 * lane) & 63;
        const size_t obase = ((size_t)(b * 4 + h) * KEYS + kidx) * 64 + d4;
        float v[4];
        { unpack4(cur.q[0], v); float ss = v[0] * v[0] + v[1] * v[1] + v[2] * v[2] + v[3] * v[3];
          ss = sum16_dpp(ss);
          const float rs = rsqrtf(ss * (1.f / 64.f) + EPS) * 0.18033688f; const f32x4 g = *(const f32x4*)(p.na_qg + l * 64 + d4);
          u32x2 o; o.x = pk2(v[0] * rs * g.x, v[1] * rs * g.y); o.y = pk2(v[2] * rs * g.z, v[3] * rs * g.w); *(u32x2*)(QA + obase) = o; }
        { unpack4(cur.q[1], v); float ss = v[0] * v[0] + v[1] * v[1] + v[2] * v[2] + v[3] * v[3];
          ss = sum16_dpp(ss);
          const float rs = rsqrtf(ss * (1.f / 64.f) + EPS); const f32x4 g = *(const f32x4*)(p.na_kg + l * 64 + d4);
          u32x2 o; o.x = pk2(v[0] * rs * g.x, v[1] * rs * g.y); o.y = pk2(v[2] * rs * g.z, v[3] * rs * g.w); *(u32x2*)(KA + obase) = o; }
        const int li = lane & 7, d32 = 4 * li;
        float cs[4], sn[4];
        if (!isctx) {
            const int pos = (li & 4) ? (t & 63) : (t >> 6);
            const f32x4* rt = (const f32x4*)(ROPE + (pos * 8 + 4 * (li & 1)) * 2);
            const f32x4 r0 = rt[0], r1 = rt[1];
            cs[0] = r0.x; sn[0] = r0.y; cs[1] = r0.z; sn[1] = r0.w; cs[2] = r1.x; sn[2] = r1.y; cs[3] = r1.z; sn[3] = r1.w;
        }
#pragma unroll
        for (int which = 0; which < 2; ++which) {
            unpack4(cur.q[2 + which], v);
            float ss = v[0] * v[0] + v[1] * v[1] + v[2] * v[2] + v[3] * v[3];
            ss = sum8_dpp(ss);
            const float rs = rsqrtf(ss * (1.f / 32.f) + EPS);
            const f32x4 g = *(const f32x4*)((which ? p.df_kg : p.df_qg) + l * 32 + d32);
            float y[4] = {v[0] * rs * g.x, v[1] * rs * g.y, v[2] * rs * g.z, v[3] * rs * g.w};
            if (!isctx) {
#pragma unroll
                for (int e = 0; e < 4; ++e) { const float o = DPP_F(y[e], 0x4E); y[e] = (li & 2) ? (y[e] * cs[e] + o * sn[e]) : (y[e] * cs[e] - o * sn[e]); }
            }
            const float sc = which ? 1.f : 0.25503486f;
            u32x2 o; o.x = pk2(y[0] * sc, y[1] * sc); o.y = pk2(y[2] * sc, y[3] * sc);
            *(u32x2*)((which ? KD : QD) + obase) = o;
        }
        if (!(l == 1 && isctx)) {
            const int g = lane >> 4, win = 2 << g, Ls = isctx ? LC : SEQ;
            int lo = t - win / 2, hi = lo + win; lo = lo < 0 ? 0 : lo; hi = hi > Ls ? Ls : hi;
            float s[4] = {0.f, 0.f, 0.f, 0.f};
#pragma unroll
            for (int j = 0; j < 16; ++j) { float q[4]; unpack4(cur.wv[j], q); const float m = lo + j < hi ? 1.f : 0.f; s[0] += m * q[0]; s[1] += m * q[1]; s[2] += m * q[2]; s[3] += m * q[3]; }
            float u[4]; unpack4(cur.cu, u);
            const float inv = 1.f / (float)(hi - lo);
            u32x2 o; o.x = pk2(s[0] * inv - u[0], s[1] * inv - u[1]); o.y = pk2(s[2] * inv - u[2], s[3] * inv - u[3]);
            *(u32x2*)(YC + (size_t)r * DM + 512 + 4 * lane) = o;
        }
    }
    bf16_t* sm = (bf16_t*)smem + wave * (64 * 72);
    for (int it = gw; it < 2 * 8 * 4 * 36; it += ngw) {
        const int ch = it % 36, h = (it / 36) & 3, b = (it / 144) & 7, which = it / 1152;
        const int kidx = 64 * ch + lane; const int row = kidx < 256 ? NX + b * LC + kidx : b * SEQ + kidx - 256;
        const u32x4* src = (const u32x4*)(PX + (size_t)row * NIN + (which ? 1280 : 512) + 64 * h);
        u32x4 v[8];
#pragma unroll
        for (int i = 0; i < 8; ++i) v[i] = src[i];
        bf16_t* dst = (which ? WSP(bf16_t, WS_VTD) : WSP(bf16_t, WS_VTA)) + (size_t)(b * 4 + h) * 64 * KEYS + 64 * ch;
        wave_transpose_store(sm, v, dst, KEYS, lane, (lane & 48) | (((lane >> 2) & 1) << 3) | (((lane >> 3) & 1) << 2) | (lane & 3));
    }
    const int nC = 8 * 4 * 32 + (l == 0 ? 8 * 4 * 4 : 0);
    for (int it = gw; it < nC; it += ngw) {
        const bool cx = it >= 1024; const int q = cx ? it - 1024 : it;
        const int N = cx ? 256 : 2048, njc = N / 64;
        const int jc = q % njc, cc = (q / njc) & 3, b = q / (njc * 4);
        const int j = 64 * jc + lane; const int rowb = cx ? NX + b * LC : b * SEQ;
        int t1, t2, col; float sgn;
        if (j <= N / 2) { t1 = j; t2 = (j == 0 || j == N / 2) ? -1 : N - j; col = 1792 + 64 * cc; sgn = 1.f; }
        else { t1 = j - N / 2; t2 = N - t1; col = 2048 + 64 * cc; sgn = -1.f; }
        const u32x4* s1 = (const u32x4*)(PX + (size_t)(rowb + t1) * NIN + col);
        const u32x4* s2 = (const u32x4*)(PX + (size_t)(rowb + (t2 < 0 ? t1 : t2)) * NIN + col);
        const float w2 = t2 < 0 ? 0.f : sgn;
        u32x4 v[8];
#pragma unroll
        for (int i = 0; i < 8; ++i) {
            const u32x4 a = s1[i], bq = s2[i]; u32x4 o;
            o.x = pk2(bflo(a.x) + w2 * bflo(bq.x), bfhi(a.x) + w2 * bfhi(bq.x)); o.y = pk2(bflo(a.y) + w2 * bflo(bq.y), bfhi(a.y) + w2 * bfhi(bq.y));
            o.z = pk2(bflo(a.z) + w2 * bflo(bq.z), bfhi(a.z) + w2 * bfhi(bq.z)); o.w = pk2(bflo(a.w) + w2 * bflo(bq.w), bfhi(a.w) + w2 * bfhi(bq.w));
            v[i] = o;
        }
        bf16_t* dst = (cx ? WSP(bf16_t, WS_XFC) : WSP(bf16_t, WS_XF)) + (size_t)(b * 256 + 64 * cc) * N + 64 * jc;
        wave_transpose_store(sm, v, dst, N, lane, lane);
    }
}


__device__ __forceinline__ unsigned cvt_pk_bf16(float lo, float hi) { return pk2(lo, hi); }
__device__ __forceinline__ void phase_df_mfma(const Params& p, const int l, LAS unsigned char* lds) {
    const int tid = hid_tid(), wave = __builtin_amdgcn_readfirstlane(tid >> 6), lane = tid & 63, qn = lane & 31, hh = lane >> 5;
    const float* SC = WSP(float, WS_SCAL) + l * 16;
    const float lam = SC[0], lam_init = SC[1], negmb = -SC[2];
    const int nunits = 256 + (l == 0 ? 32 : 0);
    const int srow = tid >> 3, scq = (tid & 7) ^ ((srow >> 1) & 7);
    const unsigned ldsw = (unsigned)tid * 16u;
    f32x16 negm;
#pragma unroll
    for (int i = 0; i < 16; ++i) negm[i] = negmb;
    const int rsw = (qn >> 1) & 7;
    for (int it_ = 0;; ++it_) {
        int u;
        if (gridDim.x == 256) { if (it_ == 0) u = blockIdx.x; else { if (it_ > 1 || nunits <= 256 || blockIdx.x < 224) break; u = 256 + (255 - (int)blockIdx.x); } }
        else { u = blockIdx.x + it_ * (int)gridDim.x; if (u >= nunits) break; }
        const bool cx = u >= 256; const int qt = (u >> 3) & 7, bh = cx ? u - 256 : (u & 7) * 4 + (u >> 6), b = bh >> 2, h = bh & 3;
        const int q0 = cx ? 0 : 256 + 256 * qt, nkt = cx ? 4 : 36;
        const int orow = (cx ? NX + b * LC : b * SEQ + 256 * qt) + 32 * wave + qn;
        const char* Kg = (const char*)(WSP(bf16_t, WS_KD) + (size_t)bh * KEYS * 64) + srow * 128 + scq * 16;
        const char* Vg = (const char*)(WSP(bf16_t, WS_VTD) + (size_t)bh * 64 * KEYS) + (size_t)srow * KEYS * 2 + scq * 16;
        bf16x8 qf[2][2];
        { const bf16_t* Q = WSP(bf16_t, WS_QD) + ((size_t)bh * KEYS + q0 + 32 * wave + qn) * 64;
#pragma unroll
          for (int sub = 0; sub < 2; ++sub)
#pragma unroll
              for (int ks = 0; ks < 2; ++ks) qf[sub][ks] = *(const bf16x8*)(Q + 32 * sub + 16 * ks + 8 * hh); }
        f32x16 O1[2], O2[2]; float l1 = 0.f, l2 = 0.f;
        for (int trep_ = 0; trep_ < REP_TILE; ++trep_) {
#pragma unroll
        for (int db = 0; db < 2; ++db)
#pragma unroll
            for (int i = 0; i < 16; ++i) { O1[db][i] = 0.f; O2[db][i] = 0.f; }
        l1 = 0.f; l2 = 0.f;
        __syncthreads();
        __builtin_amdgcn_global_load_lds((const unsigned*)Kg, (LAS unsigned*)(lds + ldsw), 16, 0, 0);
        __builtin_amdgcn_global_load_lds((const unsigned*)Vg, (LAS unsigned*)(lds + 8192 + ldsw), 16, 0, 0);
        __builtin_amdgcn_global_load_lds((const unsigned*)(Kg + (size_t)64 * 128), (LAS unsigned*)(lds + 16384 + ldsw), 16, 0, 0);
        __builtin_amdgcn_global_load_lds((const unsigned*)(Vg + (size_t)64 * 2), (LAS unsigned*)(lds + 16384 + 8192 + ldsw), 16, 0, 0);
        asm volatile("s_waitcnt vmcnt(2)" ::: "memory"); __builtin_amdgcn_s_barrier();
        unsigned bo = 0u;
#pragma unroll 1
        for (int t = 0; t < nkt; ++t) {
            if (t + 2 < nkt) {
                const unsigned bn = bo == 0u ? 32768u : bo - 16384u;
                __builtin_amdgcn_global_load_lds((const unsigned*)(Kg + (size_t)(t + 2) * 64 * 128), (LAS unsigned*)(lds + bn + ldsw), 16, 0, 0);
                __builtin_amdgcn_global_load_lds((const unsigned*)(Vg + (size_t)(t + 2) * 64 * 2), (LAS unsigned*)(lds + bn + 8192 + ldsw), 16, 0, 0);
            }
#pragma unroll
            for (int kb = 0; kb < 2; ++kb) {
                const LAS unsigned char* kt = lds + bo + (32 * kb + qn) * 128;
                bf16x8 kf[2][2];
#pragma unroll
                for (int sub = 0; sub < 2; ++sub)
#pragma unroll
                    for (int ks = 0; ks < 2; ++ks) kf[sub][ks] = *(const LAS bf16x8*)(kt + (((4 * sub + 2 * ks + hh) ^ rsw) << 4));
                f32x16 S1 = __builtin_amdgcn_mfma_f32_32x32x16_bf16(kf[0][0], qf[0][0], negm, 0, 0, 0);
                S1 = __builtin_amdgcn_mfma_f32_32x32x16_bf16(kf[0][1], qf[0][1], S1, 0, 0, 0);
                f32x16 S2 = __builtin_amdgcn_mfma_f32_32x32x16_bf16(kf[1][0], qf[1][0], negm, 0, 0, 0);
                S2 = __builtin_amdgcn_mfma_f32_32x32x16_bf16(kf[1][1], qf[1][1], S2, 0, 0, 0);
                bf16x8 vf[2][2];
#pragma unroll
                for (int db = 0; db < 2; ++db)
#pragma unroll
                    for (int s = 0; s < 2; ++s) vf[db][s] = *(const LAS bf16x8*)(lds + bo + 8192 + (32 * db + qn) * 128 + (((4 * kb + 2 * s + hh) ^ rsw) << 4));
                unsigned pa[8], pb[8];
#pragma unroll
                for (int i = 0; i < 8; ++i) {
                    const float a0 = __builtin_amdgcn_exp2f(S1[2 * i]), a1 = __builtin_amdgcn_exp2f(S1[2 * i + 1]);
                    const float b0 = __builtin_amdgcn_exp2f(S2[2 * i]), b1 = __builtin_amdgcn_exp2f(S2[2 * i + 1]);
                    l1 += a0 + a1; l2 += b0 + b1;
                    pa[i] = cvt_pk_bf16(a0, a1); pb[i] = cvt_pk_bf16(b0, b1);
                }
                bf16x8 P1[2], P2[2];
#pragma unroll
                for (int s = 0; s < 2; ++s) {
                    const u32x4 wa = {pa[4 * s], pa[4 * s + 1], pa[4 * s + 2], pa[4 * s + 3]}, wb = {pb[4 * s], pb[4 * s + 1], pb[4 * s + 2], pb[4 * s + 3]};
                    P1[s] = *(const bf16x8*)&wa; P2[s] = *(const bf16x8*)&wb;
                }
#pragma unroll
                for (int db = 0; db < 2; ++db)
#pragma unroll
                    for (int s = 0; s < 2; ++s) {
                        O1[db] = __builtin_amdgcn_mfma_f32_32x32x16_bf16(vf[db][s], P1[s], O1[db], 0, 0, 0);
                        O2[db] = __builtin_amdgcn_mfma_f32_32x32x16_bf16(vf[db][s], P2[s], O2[db], 0, 0, 0);
                    }
            }
            if (t + 2 < nkt) asm volatile("s_waitcnt vmcnt(2)" ::: "memory"); else asm volatile("s_waitcnt vmcnt(0)" ::: "memory");
            __builtin_amdgcn_s_barrier();
            bo = bo >= 32768u ? 0u : bo + 16384u;
        }
        }
        l1 += __shfl_xor(l1, 32); l2 += __shfl_xor(l2, 32);
        const float i1 = 1.f / l1, i2 = lam / l2; float ss = 0.f;
#pragma unroll
        for (int db = 0; db < 2; ++db)
#pragma unroll
            for (int i = 0; i < 16; ++i) { const float o = O1[db][i] * i1 - O2[db][i] * i2; O1[db][i] = o; ss += o * o; }
        ss += __shfl_xor(ss, 32);
        const float rs = rsqrtf(ss * (1.f / 64.f) + EPS) * (1.f - lam_init);
        bf16_t* op = WSP(bf16_t, WS_YCAT) + (size_t)orow * DM + 256 + 64 * h + 4 * hh;
        const float* sl = p.subln + l * 64 + 4 * hh;
#pragma unroll
        for (int db = 0; db < 2; ++db)
#pragma unroll
            for (int i = 0; i < 4; ++i) {
                const int d = 32 * db + 8 * i; const f32x4 g = *(const f32x4*)(sl + d);
                u32x2 o; o.x = pk2(O1[db][4 * i] * rs * g.x, O1[db][4 * i + 1] * rs * g.y); o.y = pk2(O1[db][4 * i + 2] * rs * g.z, O1[db][4 * i + 3] * rs * g.w);
                *(u32x2*)(op + d) = o;
            }
    }
    __syncthreads();
}


__device__ __forceinline__ void phase_na_mfma(const Params& p, const int l, LAS unsigned char* lds) {
    const int tid = hid_tid(), wave = __builtin_amdgcn_readfirstlane(tid >> 6), lane = tid & 63, qn = lane & 31, hh = lane >> 5;
    const float* SC = WSP(float, WS_SCAL) + l * 16;
    const int nunits = 256 + (l == 0 ? 32 : 0);
    const int srow = tid >> 3, scq = (tid & 7) ^ ((srow >> 1) & 7);
    const unsigned ldsw = (unsigned)tid * 16u;
    const int rsw = (qn >> 1) & 7;
    LAS float* btab = (LAS float*)(lds + 49152);
    for (int it_ = 0;; ++it_) {
        int u;
        if (gridDim.x == 256) { if (it_ == 0) u = blockIdx.x; else { if (it_ > 1 || nunits <= 256 || blockIdx.x < 224) break; u = 256 + (255 - (int)blockIdx.x); } }
        else { u = blockIdx.x + it_ * (int)gridDim.x; if (u >= nunits) break; }
        const bool cx = u >= 256; const int bh = cx ? u - 256 : (u & 7) * 4 + (u >> 6), rg = (u >> 3) & 7, b = bh >> 2, h = bh & 3;
        __syncthreads();
        for (int i = tid; i < 15 * 32; i += 512) { const int rr = i >> 5, cc = i & 31; btab[i] = cc < 31 ? p.na_rpb[((size_t)(l * 4 + h) * 15 + rr) * 31 + cc] * 1.44269504f : -__builtin_inff(); }
        const int r = 4 * rg + (wave >> 1), qc = 32 * (wave & 1) + qn;
        const int qidx = cx ? 32 * wave + qn : 256 + 64 * r + qc;
        const int orow = cx ? NX + b * LC + 32 * wave + qn : b * SEQ + 64 * r + qc;
        bf16x8 qf[4];
        { const bf16_t* Q = WSP(bf16_t, WS_QA) + ((size_t)bh * KEYS + qidx) * 64;
#pragma unroll
          for (int ks = 0; ks < 4; ++ks) qf[ks] = *(const bf16x8*)(Q + 16 * ks + 8 * hh); }
        int cs = qc - 8; cs = cs < 0 ? 0 : (cs > 48 ? 48 : cs);
        int boff[2][16];
#pragma unroll
        for (int kb = 0; kb < 2; ++kb)
#pragma unroll
            for (int rg2 = 0; rg2 < 16; ++rg2) {
                const int kc = 32 * kb + (rg2 & 3) + 8 * (rg2 >> 2) + 4 * hh;
                int dk = kc - qc; dk = dk < -15 ? -15 : (dk > 15 ? 15 : dk);
                boff[kb][rg2] = ((unsigned)(kc - cs) < 16u) ? 4 * (dk + 15) : 4 * 31;
            }
        int rs = r - 4; rs = rs < 0 ? 0 : (rs > 24 ? 24 : rs);
        int krlo = 4 * rg - 4; krlo = krlo < 0 ? 0 : (krlo > 24 ? 24 : krlo);
        int krhi = 4 * rg - 1; krhi = (krhi < 0 ? 0 : (krhi > 24 ? 24 : krhi)) + 7;
        const int ntile = cx ? 4 : 4 + (krhi - krlo + 1);
        const float negmb = -SC[4 + h];
        f32x16 negm;
#pragma unroll
        for (int i = 0; i < 16; ++i) negm[i] = negmb;
        const char* Kg = (const char*)(WSP(bf16_t, WS_KA) + (size_t)bh * KEYS * 64) + srow * 128 + scq * 16;
        const char* Vg = (const char*)(WSP(bf16_t, WS_VTA) + (size_t)bh * 64 * KEYS) + (size_t)srow * KEYS * 2 + scq * 16;
        f32x16 O[2]; float ls = 0.f;
        for (int trep_ = 0; trep_ < REP_TILE; ++trep_) {
        if (trep_) __syncthreads();
#pragma unroll
        for (int db = 0; db < 2; ++db)
#pragma unroll
            for (int i = 0; i < 16; ++i) O[db][i] = 0.f;
        ls = 0.f;
        __builtin_amdgcn_global_load_lds((const unsigned*)Kg, (LAS unsigned*)(lds + ldsw), 16, 0, 0);
        __builtin_amdgcn_global_load_lds((const unsigned*)Vg, (LAS unsigned*)(lds + 8192 + ldsw), 16, 0, 0);
        __builtin_amdgcn_global_load_lds((const unsigned*)(Kg + (size_t)64 * 128), (LAS unsigned*)(lds + 16384 + ldsw), 16, 0, 0);
        __builtin_amdgcn_global_load_lds((const unsigned*)(Vg + (size_t)64 * 2), (LAS unsigned*)(lds + 16384 + 8192 + ldsw), 16, 0, 0);
        asm volatile("s_waitcnt vmcnt(2)" ::: "memory"); __builtin_amdgcn_s_barrier();
        unsigned bo = 0u;
#pragma unroll 1
        for (int i = 0; i < ntile; ++i) {
            if (i + 2 < ntile) {
                const int tn = (i + 2 < 4) ? i + 2 : 4 + krlo + (i + 2 - 4);
                const unsigned bn = bo == 0u ? 32768u : bo - 16384u;
                __builtin_amdgcn_global_load_lds((const unsigned*)(Kg + (size_t)tn * 64 * 128), (LAS unsigned*)(lds + bn + ldsw), 16, 0, 0);
                __builtin_amdgcn_global_load_lds((const unsigned*)(Vg + (size_t)tn * 64 * 2), (LAS unsigned*)(lds + bn + 8192 + ldsw), 16, 0, 0);
            }
            const int kr = krlo + i - 4;
            const bool local = i >= 4;
            if (!local || (kr >= rs && kr < rs + 8)) {
                const int brow = local ? (kr - r + 7) * 128 : 0;
#pragma unroll
                for (int kb = 0; kb < 2; ++kb) {
                    const LAS unsigned char* kt = lds + bo + (32 * kb + qn) * 128;
                    bf16x8 kf[4];
#pragma unroll
                    for (int ks = 0; ks < 4; ++ks) kf[ks] = *(const LAS bf16x8*)(kt + (((2 * ks + hh) ^ rsw) << 4));
                    f32x16 S = __builtin_amdgcn_mfma_f32_32x32x16_bf16(kf[0], qf[0], negm, 0, 0, 0);
#pragma unroll
                    for (int ks = 1; ks < 4; ++ks) S = __builtin_amdgcn_mfma_f32_32x32x16_bf16(kf[ks], qf[ks], S, 0, 0, 0);
                    bf16x8 vf[2][2];
#pragma unroll
                    for (int db = 0; db < 2; ++db)
#pragma unroll
                        for (int s = 0; s < 2; ++s) vf[db][s] = *(const LAS bf16x8*)(lds + bo + 8192 + (32 * db + qn) * 128 + (((4 * kb + 2 * s + hh) ^ rsw) << 4));
                    if (local) {
#pragma unroll
                        for (int rg2 = 0; rg2 < 16; ++rg2) S[rg2] += *(const LAS float*)((const LAS unsigned char*)btab + brow + boff[kb][rg2]);
                    }
                    unsigned pa[8];
#pragma unroll
                    for (int j = 0; j < 8; ++j) {
                        const float a0 = __builtin_amdgcn_exp2f(S[2 * j]), a1 = __builtin_amdgcn_exp2f(S[2 * j + 1]);
                        ls += a0 + a1; pa[j] = pk2(a0, a1);
                    }
                    bf16x8 P[2];
#pragma unroll
                    for (int s = 0; s < 2; ++s) { const u32x4 wa = {pa[4 * s], pa[4 * s + 1], pa[4 * s + 2], pa[4 * s + 3]}; P[s] = *(const bf16x8*)&wa; }
#pragma unroll
                    for (int db = 0; db < 2; ++db)
#pragma unroll
                        for (int s = 0; s < 2; ++s) O[db] = __builtin_amdgcn_mfma_f32_32x32x16_bf16(vf[db][s], P[s], O[db], 0, 0, 0);
                }
            }
            if (i + 2 < ntile) asm volatile("s_waitcnt vmcnt(2)" ::: "memory"); else asm volatile("s_waitcnt vmcnt(0)" ::: "memory");
            __builtin_amdgcn_s_barrier();
            bo = bo >= 32768u ? 0u : bo + 16384u;
        }
        }
        ls += __shfl_xor(ls, 32);
        const float il = 1.f / ls;
        bf16_t* op = WSP(bf16_t, WS_YCAT) + (size_t)orow * DM + 64 * h + 4 * hh;
#pragma unroll
        for (int db = 0; db < 2; ++db)
#pragma unroll
            for (int i = 0; i < 4; ++i) {
                u32x2 o; o.x = pk2(O[db][4 * i] * il, O[db][4 * i + 1] * il); o.y = pk2(O[db][4 * i + 2] * il, O[db][4 * i + 3] * il);
                *(u32x2*)(op + 32 * db + 8 * i) = o;
            }
    }
    __syncthreads();
}

constexpr int RB = 72;
constexpr int HSTR = 2064;
__device__ __forceinline__ void phase_route(const Params& p, const int l, unsigned char* smem, const int cnt_off) {
    unsigned char* HN = smem;
    float* LOGIT = (float*)(smem + RB * HSTR);
    int* hist = (int*)(smem + RB * HSTR + RB * 32 * 4); int* base = hist + 32; int* s_e = base + 32; int* s_lp = s_e + RB * 4; float* s_g = (float*)(s_lp + RB * 4);
    const int tid = hid_tid(), lane = tid & 63, wave = tid >> 6, fr = lane & 15, fq = lane >> 4;
    const int nrows = (l == 0) ? NT : NX;
    const float* MOD = WSP(float, WS_MOD); unsigned char* H8 = WSP(unsigned char, WS_H8); const bf16_t* X1 = WSP(bf16_t, WS_X1);
    const bf16_t* RWT = WSP(bf16_t, WS_RWT) + (size_t)l * 32 * 1024;
    int* cnt = WSP(int, WS_CTL + CTL_CNT + cnt_off) + l * 32;
    int *RTE = WSP(int, WS_RTE), *RTP = WSP(int, WS_RTP), *LIST = WSP(int, WS_LIST); float* RTG = WSP(float, WS_RTG);
    const float rb0 = p.router_b[l * 32 + fr], rb1 = p.router_b[l * 32 + 16 + fr];
    for (int r0 = blockIdx.x * RB; r0 < nrows; r0 += gridDim.x * RB) {
        __syncthreads();
        if (tid < 32) hist[tid] = 0;
        const int nr = (nrows - r0) < RB ? (nrows - r0) : RB;
        u32x2 vn[4];
        if (wave < nr) {
#pragma unroll
            for (int j = 0; j < 4; ++j) vn[j] = ((const u32x2*)(X1 + (size_t)(r0 + wave) * DM))[lane + 64 * j];
        }
        int cmi = -1; f32x4 mA[4], mB[4];
        for (int i = wave; i < nr; i += 8) {
            const int r = r0 + i;
            if (mod_index(r) != cmi) {
                cmi = mod_index(r);
                const float* m = MOD + (size_t)(l * 9 + cmi) * 6144; const float* gw = p.g2w + l * 1024;
#pragma unroll
                for (int j = 0; j < 4; ++j) { const int c = 4 * lane + 256 * j; const f32x4 g = *(const f32x4*)(gw + c), s1 = *(const f32x4*)(m + 4 * 1024 + c);
                    mA[j].x = g.x * (1.f + s1.x); mA[j].y = g.y * (1.f + s1.y); mA[j].z = g.z * (1.f + s1.z); mA[j].w = g.w * (1.f + s1.w); mB[j] = *(const f32x4*)(m + 3 * 1024 + c); }
            }
            f32x4 v[4]; float ss = 0.f;
#pragma unroll
            for (int j = 0; j < 4; ++j) { v[j] = (f32x4){bflo(vn[j].x), bfhi(vn[j].x), bflo(vn[j].y), bfhi(vn[j].y)}; ss += v[j].x * v[j].x + v[j].y * v[j].y + v[j].z * v[j].z + v[j].w * v[j].w; }
            if (i + 8 < nr) {
#pragma unroll
                for (int j = 0; j < 4; ++j) vn[j] = ((const u32x2*)(X1 + (size_t)(r + 8) * DM))[lane + 64 * j];
            }
            ss = wave_sum_fast(ss);
            const float rs = rsqrtf(ss * (1.f / DM) + EPS);
#pragma unroll
            for (int j = 0; j < 4; ++j) {
                const int c = 4 * lane + 256 * j;
                f32x4 o;
                o.x = v[j].x * rs * mA[j].x + mB[j].x; o.y = v[j].y * rs * mA[j].y + mB[j].y;
                o.z = v[j].z * rs * mA[j].z + mB[j].z; o.w = v[j].w * rs * mA[j].w + mB[j].w;
                *(unsigned*)(H8 + (size_t)r * DM + c) = pk4_fp8(fminf(fmaxf(o.x * SH8, -448.f), 448.f), fminf(fmaxf(o.y * SH8, -448.f), 448.f), fminf(fmaxf(o.z * SH8, -448.f), 448.f), fminf(fmaxf(o.w * SH8, -448.f), 448.f));
                u32x2 hb; hb.x = pk2(o.x, o.y); hb.y = pk2(o.z, o.w);
                *(u32x2*)(HN + i * HSTR + c * 2) = hb;
            }
        }
        __syncthreads();
        if (wave < 5 && 16 * wave < nr) {
            f32x4 a0 = {0.f, 0.f, 0.f, 0.f}, a1 = {0.f, 0.f, 0.f, 0.f};
            const unsigned char* arow = HN + (16 * wave + fr) * HSTR + fq * 16;
            const bf16_t* b0p = RWT + (size_t)fr * 1024 + fq * 8; const bf16_t* b1p = b0p + 16 * 1024;
#pragma unroll 8
            for (int ks = 0; ks < 32; ++ks) {
                const bf16x8 a = *(const bf16x8*)(arow + ks * 64);
                const bf16x8 b0 = *(const bf16x8*)(b0p + ks * 32), b1 = *(const bf16x8*)(b1p + ks * 32);
                a0 = __builtin_amdgcn_mfma_f32_16x16x32_bf16(a, b0, a0, 0, 0, 0);
                a1 = __builtin_amdgcn_mfma_f32_16x16x32_bf16(a, b1, a1, 0, 0, 0);
            }
#pragma unroll
            for (int q = 0; q < 4; ++q) { const int row = 16 * wave + 4 * fq + q; if (row < nr) { LOGIT[row * 32 + fr] = a0[q] + rb0; LOGIT[row * 32 + 16 + fr] = a1[q] + rb1; } }
        }
        __syncthreads();
        for (int i = wave; i < nr; i += 8) {
            const float logit = LOGIT[i * 32 + (lane & 31)];
            float tv[4]; int ti[4];
            {
                const int me = lane & 31; int rank = 0;
#pragma unroll
                for (int e = 0; e < 32; ++e) { const float ov = __builtin_bit_cast(float, __builtin_amdgcn_readlane(__builtin_bit_cast(int, logit), e)); rank += ((ov > logit) || (ov == logit && e < me)) ? 1 : 0; }
#pragma unroll
                for (int k = 0; k < 4; ++k) {
                    const unsigned long long mk = __ballot(rank == k);
                    const int srcl = __builtin_amdgcn_readfirstlane((int)__builtin_ctzll(mk));
                    ti[k] = srcl & 31; tv[k] = __builtin_bit_cast(float, __builtin_amdgcn_readlane(__builtin_bit_cast(int, logit), srcl));
                }
            }
            const float e1 = __expf(tv[1] - tv[0]), e2 = __expf(tv[2] - tv[0]), e3 = __expf(tv[3] - tv[0]); const float inv = 1.f / (1.f + e1 + e2 + e3);
            if (lane < 4) {
                const int te = lane == 0 ? ti[0] : lane == 1 ? ti[1] : lane == 2 ? ti[2] : ti[3];
                const float tg = (lane == 0 ? 1.f : lane == 1 ? e1 : lane == 2 ? e2 : e3) * inv;
                s_e[i * 4 + lane] = te; s_g[i * 4 + lane] = tg; s_lp[i * 4 + lane] = atomicAdd(&hist[te], 1);
            }
        }
        __syncthreads();
        if (tid < 32) base[tid] = hist[tid] ? atomicAdd(&cnt[tid], hist[tid]) : 0;
        __syncthreads();
        for (int i = tid; i < nr * 4; i += 512) {
            const int r = r0 + (i >> 2), e = s_e[i], pos = base[e] + s_lp[i];
            RTE[(size_t)r * 4 + (i & 3)] = e; RTP[(size_t)r * 4 + (i & 3)] = pos; RTG[(size_t)r * 4 + (i & 3)] = s_g[i];
            LIST[(size_t)e * NT + pos] = r;
        }
    }
    __syncthreads();
}

__device__ __forceinline__ void phase_combine(const Params& p, const int l, const int* tinfo) {
    const int tid = hid_tid(), lane = tid & 63, wave = tid >> 6;
    const int gw = blockIdx.x * 8 + wave, ngw = gridDim.x * 8;
    const int nrows = (l == 0) ? NT : NX;
    const float* MOD = WSP(float, WS_MOD); const bf16_t* X1 = WSP(bf16_t, WS_X1); const unsigned char* Y2 = WSP(unsigned char, WS_Y2);
    const int *RTE = WSP(int, WS_RTE), *RTP = WSP(int, WS_RTP); const float* RTG = WSP(float, WS_RTG);
    int ne[4], np_[4]; float ng[4];
    if (gw < nrows) {
#pragma unroll
        for (int k = 0; k < 4; ++k) { ne[k] = RTE[(size_t)gw * 4 + k]; np_[k] = RTP[(size_t)gw * 4 + k]; ng[k] = RTG[(size_t)gw * 4 + k]; }
    }
    int cmi = -1; f32x4 g2v[4], nA[4], nB[4];
    for (int r = gw; r < nrows; r += ngw) {
        if (mod_index(r) != cmi) {
            cmi = mod_index(r);
            const float* g2 = MOD + (size_t)(l * 9 + cmi) * 6144 + 5 * 1024; const float* m = MOD + (size_t)(1 * 9 + cmi) * 6144;
#pragma unroll
            for (int j = 0; j < 4; ++j) { const int c = 4 * lane + 256 * j; g2v[j] = *(const f32x4*)(g2 + c);
                if (l == 0) { const f32x4 g = *(const f32x4*)(p.g1w + 1024 + c), s1 = *(const f32x4*)(m + 1024 + c);
                    nA[j].x = g.x * (1.f + s1.x); nA[j].y = g.y * (1.f + s1.y); nA[j].z = g.z * (1.f + s1.z); nA[j].w = g.w * (1.f + s1.w); nB[j] = *(const f32x4*)(m + c); } }
        }
        const unsigned char* yr[4]; float gk[4];
#pragma unroll
        for (int k = 0; k < 4; ++k) { yr[k] = Y2 + ((size_t)tinfo[ne[k]] * 256 + np_[k]) * DM; gk[k] = ng[k] * (1.f / SY8); }
        unsigned yv[4][4]; u32x2 x1v[4]; f32x4 gv[4];
#pragma unroll
        for (int j = 0; j < 4; ++j) {
            const int c = 4 * lane + 256 * j;
#pragma unroll
            for (int k = 0; k < 4; ++k) yv[j][k] = *(const unsigned*)(yr[k] + c);
            x1v[j] = *(const u32x2*)(X1 + (size_t)r * DM + c); gv[j] = g2v[j];
        }
        if (r + ngw < nrows) {
#pragma unroll
            for (int k = 0; k < 4; ++k) { ne[k] = RTE[(size_t)(r + ngw) * 4 + k]; np_[k] = RTP[(size_t)(r + ngw) * 4 + k]; ng[k] = RTG[(size_t)(r + ngw) * 4 + k]; }
        }
        f32x4 xv[4];
#pragma unroll
        for (int j = 0; j < 4; ++j) {
            const int c = 4 * lane + 256 * j;
            float s[4] = {0.f, 0.f, 0.f, 0.f};
#pragma unroll
            for (int k = 0; k < 4; ++k) { const f32x2 ya = __builtin_amdgcn_cvt_pk_f32_fp8((int)yv[j][k], false), yb = __builtin_amdgcn_cvt_pk_f32_fp8((int)yv[j][k], true); s[0] += gk[k] * ya.x; s[1] += gk[k] * ya.y; s[2] += gk[k] * yb.x; s[3] += gk[k] * yb.y; }
            const f32x4 x1 = {bflo(x1v[j].x), bfhi(x1v[j].x), bflo(x1v[j].y), bfhi(x1v[j].y)}, g = gv[j];
            f32x4 o; o.x = x1.x + g.x * s[0]; o.y = x1.y + g.y * s[1]; o.z = x1.z + g.z * s[2]; o.w = x1.w + g.w * s[3];
            if (l == 0) { u32x2 ob; ob.x = pk2(o.x, o.y); ob.y = pk2(o.z, o.w); *(u32x2*)(WSP(bf16_t, WS_X2) + (size_t)r * DM + c) = ob; }
            else *(f32x4*)(p.out + (size_t)r * DM + c) = o;
            xv[j] = o;
        }
        if (l == 0) {
            float ss = 0.f;
#pragma unroll
            for (int j = 0; j < 4; ++j) ss += xv[j].x * xv[j].x + xv[j].y * xv[j].y + xv[j].z * xv[j].z + xv[j].w * xv[j].w;
            ss = wave_sum_fast(ss); const float rs = rsqrtf(ss * (1.f / DM) + EPS);
            bf16_t* hrow = WSP(bf16_t, WS_H) + (size_t)r * DM;
#pragma unroll
            for (int j = 0; j < 4; ++j) {
                const int c = 4 * lane + 256 * j;
                u32x2 pk; pk.x = pk2(xv[j].x * rs * nA[j].x + nB[j].x, xv[j].y * rs * nA[j].y + nB[j].y);
                pk.y = pk2(xv[j].z * rs * nA[j].z + nB[j].z, xv[j].w * rs * nA[j].w + nB[j].w);
                *(u32x2*)(hrow + c) = pk;
            }
        }
    }
}

#define XB_TMO      128
#define XB_XCNT(j)  (256  + 64 * (j))
#define XB_XSUB(j)  (1280 + 64 * (j))
#define XB_XGEN(j)  (2304 + 64 * (j))
#define XB_TOP      3328
#define XB_TOPGEN   3392
#define XCD_BAR_WORDS 3456
#define XB_SPIN_CAP (1u << 18)
__device__ __forceinline__ unsigned xb_ld(unsigned* p)              { return __hip_atomic_load(p, __ATOMIC_RELAXED, __HIP_MEMORY_SCOPE_AGENT); }
__device__ __forceinline__ unsigned xb_add(unsigned* p, unsigned v) { return __hip_atomic_fetch_add(p, v, __ATOMIC_RELAXED, __HIP_MEMORY_SCOPE_AGENT); }
__device__ __forceinline__ unsigned xb_xcc_id() { return (unsigned)__builtin_amdgcn_s_getreg((3 << 11) | 20) & 0xFu; }
#define XB_SPIN(cond, bar) do { unsigned _sp = 0; while (cond) { __builtin_amdgcn_s_sleep(1); \
    if ((++_sp & 255u) == 0u) { if (xb_ld(&(bar)[XB_TMO])) break; if (_sp > XB_SPIN_CAP) { atomicAdd(&(bar)[XB_TMO], 1u); break; } } } } while (0)
struct XcdBarrier { unsigned* bar; unsigned x; volatile LAS unsigned* st; };
__device__ __forceinline__ XcdBarrier xcd_barrier_post(unsigned* bar, volatile LAS unsigned* st) {
    XcdBarrier b; b.bar = bar; b.x = xb_xcc_id(); b.st = st;
    if (threadIdx.x == 0) (void)xb_add(&bar[XB_XCNT(b.x)], 1u);
    return b;
}
__device__ __forceinline__ void xcd_barrier_complete(unsigned* bar, unsigned x, unsigned& nloc, unsigned& nx) {
    const unsigned G = gridDim.x * gridDim.y * gridDim.z;
    unsigned sum, cnt, mine, sp = 0u;
    for (;;) {
        sum = 0u; cnt = 0u; mine = 0u;
#pragma unroll
        for (unsigned j = 0; j < 16; ++j) { const unsigned c = xb_ld(&bar[XB_XCNT(j)]); sum += c; cnt += (c > 0u) ? 1u : 0u; mine = (j == x) ? c : mine; }
        if (sum == G) break;
        __builtin_amdgcn_s_sleep(1);
        if ((++sp & 255u) == 0u) { if (xb_ld(&bar[XB_TMO])) break; if (sp > XB_SPIN_CAP) { atomicAdd(&bar[XB_TMO], 1u); break; } }
    }
    nloc = mine > 0u ? mine : 1u; nx = cnt > 0u ? cnt : 1u;
}
__device__ __forceinline__ void xcd_barrier(const XcdBarrier& b) {
    asm volatile("s_waitcnt vmcnt(0)" ::: "memory");
    __syncthreads();
    if (threadIdx.x == 0) {
        unsigned* bar = b.bar;
        __builtin_amdgcn_s_waitcnt(0);
        unsigned nloc = b.st[0], nx = b.st[1];
        if (nloc == 0u) { xcd_barrier_complete(bar, b.x, nloc, nx); b.st[0] = nloc; b.st[1] = nx; }
        const unsigned old = xb_add(&bar[XB_XSUB(b.x)], 1u);
        const unsigned gen = old / nloc;
        if (old + 1u == (gen + 1u) * nloc) {
            __builtin_amdgcn_fence(__ATOMIC_RELEASE, "agent");
            asm volatile("s_waitcnt vmcnt(0)" ::: "memory");
            const unsigned og = xb_add(&bar[XB_TOP], 1u);
            const unsigned tg = og / nx;
            if (og + 1u == (tg + 1u) * nx) xb_add(&bar[XB_TOPGEN], 1u);
            else XB_SPIN(xb_ld(&bar[XB_TOPGEN]) == tg, bar);
            __builtin_amdgcn_fence(__ATOMIC_ACQUIRE, "agent");
            xb_add(&bar[XB_XGEN(b.x)], 1u);
            asm volatile("s_waitcnt vmcnt(0)" ::: "memory");
        } else {
            XB_SPIN(xb_ld(&bar[XB_XGEN(b.x)]) == gen, bar);
            __builtin_amdgcn_fence(__ATOMIC_ACQUIRE, "agent");
            asm volatile("s_waitcnt vmcnt(0)" ::: "memory");
        }
    }
    __syncthreads();
}

constexpr int LDS_BYTES = 163840;
constexpr int MISC_OFF = LDS_BYTES - 2048;
constexpr int NCH_L = 3072;
constexpr size_t CTL_CHUNK = 40960, CTL_DONE = 41472;
__device__ __forceinline__ void conv_item(const Params& p, unsigned char* smem, int l, int q, int wave, int lane) {
    unsigned char* tsm = smem + wave * (64 * 144);
    if (q < 16384) { const int m = l * 32 + (q >> 9), r = q & 511; transpose_item8(p.w1 + (size_t)m * 1024 * 2048, 2048, 1024, WSP(unsigned char, WS_W1) + (size_t)m * 2048 * 1024, tsm, r & 15, r >> 4, lane); }
    else { const int q2 = q - 16384, m = l * 32 + (q2 >> 8), r = q2 & 255; transpose_item8(p.w2 + (size_t)m * 1024 * 1024, 1024, 1024, WSP(unsigned char, WS_W2) + (size_t)m * 1024 * 1024, tsm, r & 15, r >> 4, lane); }
}
__device__ __forceinline__ void idle_fill(const Params& p, unsigned char* smem, const int phase, const int l) {
    const int tid = hid_tid(), lane = tid & 63, wave = tid >> 6;
    volatile int* cslot = (volatile int*)(smem + MISC_OFF + 512);
    unsigned* chunk = WSP(unsigned, WS_CTL + CTL_CHUNK + 256 * l); unsigned* done = WSP(unsigned, WS_CTL + CTL_DONE + 256 * phase);
    __syncthreads();
    if (tid == 0) {
        __hip_atomic_fetch_add(done, 1u, __ATOMIC_RELAXED, __HIP_MEMORY_SCOPE_AGENT);
        int c = -1;
        if (__hip_atomic_load(done, __ATOMIC_RELAXED, __HIP_MEMORY_SCOPE_AGENT) < gridDim.x) { const unsigned g = __hip_atomic_fetch_add(chunk, 1u, __ATOMIC_RELAXED, __HIP_MEMORY_SCOPE_AGENT); if (g < (unsigned)NCH_L) c = (int)g; }
        cslot[0] = c;
    }
    __syncthreads();
    int c = cslot[0];
    while (c >= 0) {
        __syncthreads();
        unsigned gnext = 0xffffffffu; bool more = false;
        if (tid == 0) { more = __hip_atomic_load(done, __ATOMIC_RELAXED, __HIP_MEMORY_SCOPE_AGENT) < gridDim.x; if (more) gnext = __hip_atomic_fetch_add(chunk, 1u, __ATOMIC_RELAXED, __HIP_MEMORY_SCOPE_AGENT); }
        conv_item(p, smem, l, c * 8 + wave, wave, lane);
        if (tid == 0) cslot[0] = (more && gnext < (unsigned)NCH_L) ? (int)gnext : -1;
        __syncthreads();
        c = cslot[0];
    }
}
__device__ __forceinline__ void conv_drain(const Params& p, unsigned char* smem, const int l) {
    const int tid = hid_tid(), lane = tid & 63, wave = tid >> 6;
    const int gw = blockIdx.x * 8 + wave, ngw = gridDim.x * 8;
    unsigned cst = __hip_atomic_load(WSP(unsigned, WS_CTL + CTL_CHUNK + 256 * l), __ATOMIC_RELAXED, __HIP_MEMORY_SCOPE_AGENT);
    cst = cst > (unsigned)NCH_L ? (unsigned)NCH_L : cst;
    __syncthreads();
    for (int q = (int)cst * 8 + gw; q < NCH_L * 8; q += ngw) conv_item(p, smem, l, q, wave, lane);
    __syncthreads();
}

__global__ void __launch_bounds__(512, 2) k_fwd(Params p) {
    extern __shared__ __attribute__((aligned(16))) unsigned char smem[];
    int* tinfo = (int*)(smem + MISC_OFF + 64);
    if (threadIdx.x < 4) ((unsigned*)(smem + MISC_OFF))[threadIdx.x] = 0u;
    __syncthreads();
    XcdBarrier bar = xcd_barrier_post(WSP(unsigned, WS_CTL), (volatile LAS unsigned*)(smem + MISC_OFF));
    phase_pro0(p, smem);
    __syncthreads();
    REPEAT(REP_PRO1, phase_pro1(p, smem); __syncthreads());
    xcd_barrier(bar);
#define LAYER(l) do { \
        REPEAT(REP_WIN, gemm_phase256<G_WIN>(p, l, (LAS unsigned char*)smem, tinfo)); \
        REPEAT(REP_BAR, xcd_barrier(bar)); \
        REPEAT(REP_PREP, phase_prep(p, l, smem); __syncthreads()); \
        REPEAT(REP_BAR, xcd_barrier(bar)); \
          \
        REPEAT(REP_DFT, gemm_phase256<G_DFT>(p, l, (LAS unsigned char*)smem, tinfo)); \
        if (l == 0) gemm_phase256<G_DFTC>(p, l, (LAS unsigned char*)smem, tinfo); \
        __syncthreads(); \
        REPEAT(REP_DF, phase_df_mfma(p, l, (LAS unsigned char*)smem)); \
        REPEAT(REP_NA, phase_na_mfma(p, l, (LAS unsigned char*)smem)); \
        idle_fill(p, smem, 3 + 8 * l, l); \
        REPEAT(REP_BAR, xcd_barrier(bar)); \
        REPEAT(REP_WOUT, gemm_phase256<G_WOUT>(p, l, (LAS unsigned char*)smem, tinfo)); \
        if (l == 0) idle_fill(p, smem, 4 + 8 * l, l); \
        REPEAT(REP_BAR, xcd_barrier(bar)); \
        if (REP_ROUTE > 1) { phase_route(p, l, smem, 1024); __syncthreads(); } \
        phase_route(p, l, smem, 0); \
        conv_drain(p, smem, l); \
        REPEAT(REP_BAR, xcd_barrier(bar)); \
        moe_tinfo(p, l, tinfo); \
        REPEAT(REP_MOE1, gemm_phase256<G_MOE1>(p, l, (LAS unsigned char*)smem, tinfo)); \
        REPEAT(REP_BAR, xcd_barrier(bar)); \
        REPEAT(REP_MOE2, gemm_phase256<G_MOE2>(p, l, (LAS unsigned char*)smem, tinfo)); \
        REPEAT(REP_BAR, xcd_barrier(bar)); \
        REPEAT(REP_COMB, phase_combine(p, l, tinfo)); \
        if (l == 0) xcd_barrier(bar); \
    } while (0)
    LAYER(0);
    LAYER(1);
#undef LAYER
}

extern "C" void kernel_launch(void* const* d_in, const int* in_sizes, int n_in, void* d_out, int out_size, void* d_ws, size_t ws_size, hipStream_t stream) {
    static int grid = 0;
    if (n_in != 29 || ws_size < WS_END) { fprintf(stderr, "kernel_launch: need 29 inputs and %zu bytes of workspace (got %d, %zu)\n", (size_t)WS_END, n_in, ws_size); return; }
    if (!grid) {
        int dev = 0, cus = 0, per_cu = 0;
        (void)hipGetDevice(&dev);
        (void)hipDeviceGetAttribute(&cus, hipDeviceAttributeMultiprocessorCount, dev);
        (void)hipFuncSetAttribute((const void*)k_fwd, hipFuncAttributeMaxDynamicSharedMemorySize, LDS_BYTES);
        (void)hipOccupancyMaxActiveBlocksPerMultiprocessor(&per_cu, (const void*)k_fwd, 512, LDS_BYTES);
        if (per_cu < 1) fprintf(stderr, "kernel_launch: occupancy query reports %d workgroups per CU\n", per_cu);
        grid = cus > 0 ? cus : 256;
    }
    Params p;
    const float** pp = (const float**)&p;
    for (int i = 0; i < 29; ++i) pp[i] = (const float*)d_in[i];
    p.out = (float*)d_out; p.ws = (unsigned char*)d_ws;
    (void)hipMemsetAsync((char*)d_ws + WS_CTL, 0, CTL_BYTES, stream);
    hipLaunchKernelGGL(k_fwd, dim3(grid), dim3(512), LDS_BYTES, stream, p);
}
```

```cpp
#include <hip/hip_runtime.h>
#include <cstdio>
#include <cstdint>

#define REP_PRO0 1
#define REP_TILE 1
#define REP_EPI 1
#define REP_KL8 1
#define REP_KL16 1
#define REP_ROUTE 1
#define REP_BAR 1
#define REP_PRO1 1
#define REP_TR 1
#define REP_FOLD 1
#define REP_WIN 1
#define REP_PREP 1
#define REP_DF 1
#define REP_NA 1
#define REP_DFT 1
#define REP_WOUT 1
#define REP_MOE1 1
#define REP_MOE2 1
#define REP_COMB 1
#define REPEAT(n, stmt) do { _Pragma("unroll") for (int _r = 0; _r < (n); ++_r) { stmt; } } while (0)
typedef unsigned short bf16_t;
typedef short bf16x8 __attribute__((ext_vector_type(8)));
typedef float f32x4 __attribute__((ext_vector_type(4)));
typedef float f32x16 __attribute__((ext_vector_type(16)));
typedef float f32x2 __attribute__((ext_vector_type(2)));
typedef unsigned u32x4 __attribute__((ext_vector_type(4)));
typedef unsigned u32x2 __attribute__((ext_vector_type(2)));
typedef int i32x8 __attribute__((ext_vector_type(8)));
constexpr float SW8 = 64.f, SH8 = 16.f, SA8 = 4.f, SY8 = 16.f;

constexpr int NB = 8, SEQ = 2048, DM = 1024, LC = 256;
constexpr int NX = NB * SEQ, NC = NB * LC, NT = NX + NC;
constexpr int NIN = 2304;
constexpr int NE = 32, FF = 1024, KEYS = LC + SEQ;
constexpr int MAXSLOT = 81920;
constexpr float EPS = 1e-6f;

constexpr size_t al256(size_t x) { return (x + 255) & ~(size_t)255; }
constexpr size_t WS_CTL   = 0;
constexpr size_t CTL_BYTES = 65536;
constexpr size_t CTL_CNT  = 32768;
constexpr size_t CTL_PRO0 = 49152;
constexpr size_t WS_MOD   = WS_CTL + CTL_BYTES;
constexpr size_t WS_SCAL  = al256(WS_MOD + (size_t)2 * 9 * 6144 * 4);
constexpr size_t WS_ROPE  = al256(WS_SCAL + 2 * 16 * 4);
constexpr size_t WS_WIN   = al256(WS_ROPE + 64 * 8 * 2 * 4);
constexpr size_t WS_WOUT  = al256(WS_WIN + (size_t)2 * NIN * DM * 2);
constexpr size_t WS_W1    = al256(WS_WOUT + (size_t)2 * DM * DM * 2);
constexpr size_t WS_W2    = al256(WS_W1 + (size_t)2 * NE * 2048 * DM * 2);
constexpr size_t WS_DFTM  = al256(WS_W2 + (size_t)2 * NE * DM * FF * 2);
constexpr size_t WS_DFTC  = al256(WS_DFTM + (size_t)2048 * 2048 * 2);
constexpr size_t WS_H     = al256(WS_DFTC + (size_t)256 * 256 * 2);
constexpr size_t WS_PX    = al256(WS_H + (size_t)NT * DM * 2);
constexpr size_t QKV_ONE  = (size_t)NB * 4 * KEYS * 64 * 2;
constexpr size_t WS_QA    = al256(WS_PX + (size_t)NT * NIN * 2);
constexpr size_t WS_KA    = al256(WS_QA + QKV_ONE);
constexpr size_t WS_VTA   = al256(WS_KA + QKV_ONE);
constexpr size_t WS_QD    = al256(WS_VTA + QKV_ONE);
constexpr size_t WS_KD    = al256(WS_QD + QKV_ONE);
constexpr size_t WS_VTD   = al256(WS_KD + QKV_ONE);
constexpr size_t WS_XF    = al256(WS_VTD + QKV_ONE);
constexpr size_t WS_XFC   = al256(WS_XF + (size_t)2048 * 2048 * 2);
constexpr size_t WS_YCAT  = al256(WS_XFC + (size_t)2048 * 256 * 2);
constexpr size_t WS_X1    = al256(WS_YCAT + (size_t)NT * DM * 2);
constexpr size_t WS_X2    = al256(WS_X1 + (size_t)NT * DM * 4);
constexpr size_t WS_RTE   = al256(WS_X2 + (size_t)NT * DM * 4);
constexpr size_t WS_RTP   = al256(WS_RTE + (size_t)NT * 4 * 4);
constexpr size_t WS_RTG   = al256(WS_RTP + (size_t)NT * 4 * 4);
constexpr size_t WS_LIST  = al256(WS_RTG + (size_t)NT * 4 * 4);
constexpr size_t WS_ACT   = al256(WS_LIST + (size_t)NE * NT * 4);
constexpr size_t WS_Y2    = al256(WS_ACT + (size_t)MAXSLOT * FF * 2);
constexpr size_t WS_H8    = al256(WS_Y2 + (size_t)MAXSLOT * DM * 2);
constexpr size_t WS_RWT   = al256(WS_H8 + (size_t)NT * DM);
constexpr size_t WS_END   = al256(WS_RWT + (size_t)2 * NE * DM * 2);

struct Params {
    const float *x, *c, *ctx, *c_ctx, *w_ada, *b_ada, *g1w, *g2w, *w_in, *w_out, *na_qg, *na_kg, *na_rpb, *df_qg, *df_kg,
                *lq1, *lk1, *lq2, *lk2, *subln, *pool_w, *pool_scale, *fft_w, *router_w, *router_b, *w1, *b1, *w2, *b2;
    float* out;
    unsigned char* ws;
};
typedef __attribute__((address_space(1))) unsigned char g_u8;
__device__ __forceinline__ unsigned char* ws_base(unsigned char* w) { g_u8* g = (g_u8*)w; asm volatile("" : "+s"(g)); return (unsigned char*)g; }
#define WSP(T, off) ((T*)(ws_base(p.ws) + (off)))

__device__ __forceinline__ unsigned pk2(float lo, float hi) {
    typedef __bf16 bf2 __attribute__((ext_vector_type(2)));
    bf2 r = __builtin_convertvector((f32x2){lo, hi}, bf2);
    return *(unsigned*)&r;
}
__device__ __forceinline__ unsigned pk4_fp8(float a, float b, float c, float d) { int r = 0; r = __builtin_amdgcn_cvt_pk_fp8_f32(a, b, r, false); r = __builtin_amdgcn_cvt_pk_fp8_f32(c, d, r, true); return (unsigned)r; }
__device__ __forceinline__ bf16_t f2bf(float f) { return (bf16_t)(pk2(f, 0.f) & 0xffffu); }
__device__ __forceinline__ float bflo(unsigned u) { return __uint_as_float(u << 16); }
__device__ __forceinline__ float bfhi(unsigned u) { return __uint_as_float(u & 0xffff0000u); }
__device__ __forceinline__ float bf2f(bf16_t b) { return __uint_as_float(((unsigned)b) << 16); }
__device__ __forceinline__ float wave_sum(float v) {
#pragma unroll
    for (int o = 1; o < 64; o <<= 1) v += __shfl_xor(v, o);
    return v;
}
#define DPP_F(v, ctrl) __builtin_bit_cast(float, __builtin_amdgcn_update_dpp(0, __builtin_bit_cast(int, (v)), (ctrl), 0xf, 0xf, true))
__device__ __forceinline__ float sum8_dpp(float v)  { v += DPP_F(v, 0xB1); v += DPP_F(v, 0x4E); v += DPP_F(v, 0x141); return v; }
__device__ __forceinline__ float sum16_dpp(float v) { v += DPP_F(v, 0xB1); v += DPP_F(v, 0x4E); v += DPP_F(v, 0x141); v += DPP_F(v, 0x140); return v; }
__device__ __forceinline__ float wave_sum_fast(float v) {
    v += __builtin_bit_cast(float, __builtin_amdgcn_update_dpp(0, __builtin_bit_cast(int, v), 0xB1, 0xf, 0xf, true));
    v += __builtin_bit_cast(float, __builtin_amdgcn_update_dpp(0, __builtin_bit_cast(int, v), 0x4E, 0xf, 0xf, true));
    v += __builtin_bit_cast(float, __builtin_amdgcn_update_dpp(0, __builtin_bit_cast(int, v), 0x141, 0xf, 0xf, true));
    v += __builtin_bit_cast(float, __builtin_amdgcn_update_dpp(0, __builtin_bit_cast(int, v), 0x140, 0xf, 0xf, true));
    const float a = __builtin_bit_cast(float, __builtin_amdgcn_readlane(__builtin_bit_cast(int, v), 0)), b = __builtin_bit_cast(float, __builtin_amdgcn_readlane(__builtin_bit_cast(int, v), 16));
    const float c = __builtin_bit_cast(float, __builtin_amdgcn_readlane(__builtin_bit_cast(int, v), 32)), d = __builtin_bit_cast(float, __builtin_amdgcn_readlane(__builtin_bit_cast(int, v), 48));
    return (a + b) + (c + d);
}
__device__ __forceinline__ float wave_max(float v) {
#pragma unroll
    for (int o = 1; o < 64; o <<= 1) v = fmaxf(v, __shfl_xor(v, o));
    return v;
}
__device__ __forceinline__ int hid_tid() { int t = threadIdx.x; asm volatile("" : "+v"(t)); return t; }
__device__ __forceinline__ void unpack4(u32x2 r, float (&v)[4]) { v[0] = bflo(r.x); v[1] = bfhi(r.x); v[2] = bflo(r.y); v[3] = bfhi(r.y); }

__device__ __forceinline__ void mod_row(const float* xrow, const float* gw, const float* sh, const float* sc, bf16_t* orow, int lane, f32x4 (&hv)[4]) {
    f32x4 v[4]; float ss = 0.f;
#pragma unroll
    for (int j = 0; j < 4; ++j) { v[j] = ((const f32x4*)xrow)[lane + 64 * j]; ss += v[j].x * v[j].x + v[j].y * v[j].y + v[j].z * v[j].z + v[j].w * v[j].w; }
    ss = wave_sum_fast(ss);
    const float rs = rsqrtf(ss * (1.f / DM) + EPS);
#pragma unroll
    for (int j = 0; j < 4; ++j) {
        const int c = 4 * lane + 256 * j;
        const f32x4 g = *(const f32x4*)(gw + c), s1 = *(const f32x4*)(sc + c), s0 = *(const f32x4*)(sh + c);
        f32x4 o;
        o.x = v[j].x * rs * g.x * (1.f + s1.x) + s0.x; o.y = v[j].y * rs * g.y * (1.f + s1.y) + s0.y;
        o.z = v[j].z * rs * g.z * (1.f + s1.z) + s0.z; o.w = v[j].w * rs * g.w * (1.f + s1.w) + s0.w;
        hv[j] = o;
        u32x2 pk; pk.x = pk2(o.x, o.y); pk.y = pk2(o.z, o.w);
        *(u32x2*)(orow + c) = pk;
    }
}
__device__ __forceinline__ int mod_index(int r) { return r < NX ? (r >> 11) : 8; }

__device__ __forceinline__ void phase_pro0(const Params& p, unsigned char* smem) {
    float* act = (float*)smem;
    float* red = act + 9 * 1024;
    const int tid = hid_tid(), lane = tid & 63, wave = tid >> 6;
    for (int i = tid; i < 9 * 1024; i += 512) { const int r = i >> 10, k = i & 1023; const float v = (r < 8) ? p.c[r * 1024 + k] : p.c_ctx[k]; act[i] = v / (1.f + expf(-v)); }
    __syncthreads();
    float* MOD = WSP(float, WS_MOD);
    for (int item = blockIdx.x; item < 96; item += gridDim.x) {
        const int l = item / 48, ch = item % 48, hl = lane >> 5, cl = lane & 31;
        const float* w = p.w_ada + (size_t)l * 1024 * 6144 + ch * 128 + 4 * cl;
        f32x4 acc[9];
#pragma unroll
        for (int r = 0; r < 9; ++r) acc[r] = (f32x4){0.f, 0.f, 0.f, 0.f};
        const int k0 = wave * 128 + hl;
#pragma unroll 8
        for (int i = 0; i < 64; ++i) {
            const int k = k0 + 2 * i;
            const f32x4 wv = __builtin_nontemporal_load((const f32x4*)(w + (size_t)k * 6144));
#pragma unroll
            for (int r = 0; r < 9; ++r) { const float a = act[r * 1024 + k]; acc[r].x += a * wv.x; acc[r].y += a * wv.y; acc[r].z += a * wv.z; acc[r].w += a * wv.w; }
        }
#pragma unroll
        for (int r = 0; r < 9; ++r) {
            acc[r].x += __shfl_xor(acc[r].x, 32); acc[r].y += __shfl_xor(acc[r].y, 32); acc[r].z += __shfl_xor(acc[r].z, 32); acc[r].w += __shfl_xor(acc[r].w, 32);
            if (hl == 0) *(f32x4*)(red + (wave * 9 + r) * 128 + 4 * cl) = acc[r];
        }
        __syncthreads();
        for (int i = tid; i < 9 * 128; i += 512) {
            const int r = i >> 7, cc = i & 127; float s = 0.f;
#pragma unroll
            for (int w8 = 0; w8 < 8; ++w8) s += red[(w8 * 9 + r) * 128 + cc];
            MOD[(size_t)(l * 9 + r) * 6144 + ch * 128 + cc] = s + p.b_ada[l * 6144 + ch * 128 + cc];
        }
        __syncthreads();
    }
    if (blockIdx.x == gridDim.x - 2) {
        float* RT = WSP(float, WS_ROPE);
        const int pos = tid >> 3, f = tid & 7; const float ang = (float)pos * expf(-(float)f * 1.151292546497023f);
        RT[2 * tid] = cosf(ang); RT[2 * tid + 1] = sinf(ang);
    }
    if (blockIdx.x == gridDim.x - 1 && wave == 0) {
        float* SC = WSP(float, WS_SCAL);
        for (int l = 0; l < 2; ++l) {
            float s1 = lane < 32 ? p.lq1[l * 32 + lane] * p.lk1[l * 32 + lane] : 0.f;
            float s2 = lane < 32 ? p.lq2[l * 32 + lane] * p.lk2[l * 32 + lane] : 0.f;
            s1 = wave_sum(s1); s2 = wave_sum(s2);
            const float lam_init = 0.8f - 0.6f * expf(-0.3f * (float)l);
            const float lam = expf(s1) - expf(s2) + lam_init;
            const float mq = wave_max(lane < 32 ? fabsf(p.df_qg[l * 32 + lane]) : 0.f), mk = wave_max(lane < 32 ? fabsf(p.df_kg[l * 32 + lane]) : 0.f);
            const float aq = wave_max(fabsf(p.na_qg[l * 64 + lane])), ak = wave_max(fabsf(p.na_kg[l * 64 + lane]));
            if (lane == 0) { SC[l * 16 + 0] = lam; SC[l * 16 + 1] = lam_init; SC[l * 16 + 2] = 5.656854249f * 1.44269504f * mq * mk; }
            for (int h = 0; h < 4; ++h) {
                float mb = 0.f;
                for (int i = lane; i < 15 * 31; i += 64) mb = fmaxf(mb, p.na_rpb[((size_t)(l * 4 + h)) * 465 + i]);
                mb = wave_max(mb);
                if (lane == 0) SC[l * 16 + 4 + h] = (8.f * aq * ak + mb) * 1.44269504f;
            }
        }
    }
    asm volatile("s_waitcnt vmcnt(0)" ::: "memory");
    __syncthreads();
    if (tid == 0) {
        __builtin_amdgcn_fence(__ATOMIC_RELEASE, "agent");
        asm volatile("s_waitcnt vmcnt(0)" ::: "memory");
        __hip_atomic_fetch_add(WSP(unsigned, WS_CTL + CTL_PRO0), 1u, __ATOMIC_RELAXED, __HIP_MEMORY_SCOPE_AGENT);
    }
}

__device__ __forceinline__ void transpose_item(const float* W, int ldw, int K, bf16_t* WT, unsigned char* sm, int kb, int nb, int lane) {
    const int q = lane >> 4, c4 = lane & 15;
    const float* src = W + (size_t)(64 * kb + 16 * q) * ldw + 64 * nb + 4 * c4;
    f32x4 r[16];
#pragma unroll
    for (int j = 0; j < 16; ++j) r[j] = *(const f32x4*)(src + (size_t)j * ldw);
#pragma unroll
    for (int c = 0; c < 4; ++c) {
        u32x4 o0, o1;
        o0.x = pk2(r[0][c], r[1][c]); o0.y = pk2(r[2][c], r[3][c]); o0.z = pk2(r[4][c], r[5][c]); o0.w = pk2(r[6][c], r[7][c]);
        o1.x = pk2(r[8][c], r[9][c]); o1.y = pk2(r[10][c], r[11][c]); o1.z = pk2(r[12][c], r[13][c]); o1.w = pk2(r[14][c], r[15][c]);
        unsigned char* d = sm + (4 * c4 + c) * 144 + 32 * q;
        *(u32x4*)d = o0; *(u32x4*)(d + 16) = o1;
    }
    __builtin_amdgcn_s_waitcnt(0xc07f); asm volatile("" ::: "memory");
    bf16_t* dst = WT + (size_t)(64 * nb + (lane >> 3)) * K + 64 * kb + 8 * (lane & 7);
#pragma unroll
    for (int i = 0; i < 8; ++i) { const u32x4 o = *(const u32x4*)(sm + (8 * i + (lane >> 3)) * 144 + 16 * (lane & 7)); *(u32x4*)(dst + (size_t)(8 * i) * K) = o; }
    __builtin_amdgcn_s_waitcnt(0xc07f); asm volatile("" ::: "memory");
}

__device__ __forceinline__ void transpose_item8(const float* W, int ldw, int K, unsigned char* WT, unsigned char* sm, int kb, int nb, int lane) {
    const int q = lane >> 4, c4 = lane & 15;
    const float* src = W + (size_t)(64 * kb + 16 * q) * ldw + 64 * nb + 4 * c4;
    f32x4 r[16];
#pragma unroll
    for (int j = 0; j < 16; ++j) r[j] = *(const f32x4*)(src + (size_t)j * ldw) * SW8;
#pragma unroll
    for (int c = 0; c < 4; ++c) {
        u32x4 o; o.x = pk4_fp8(r[0][c], r[1][c], r[2][c], r[3][c]); o.y = pk4_fp8(r[4][c], r[5][c], r[6][c], r[7][c]);
        o.z = pk4_fp8(r[8][c], r[9][c], r[10][c], r[11][c]); o.w = pk4_fp8(r[12][c], r[13][c], r[14][c], r[15][c]);
        *(u32x4*)(sm + (4 * c4 + c) * 80 + 16 * q) = o;
    }
    __builtin_amdgcn_s_waitcnt(0xc07f); asm volatile("" ::: "memory");
    unsigned char* dst = WT + (size_t)(64 * nb + (lane >> 2)) * K + 64 * kb + 16 * (lane & 3);
#pragma unroll
    for (int i = 0; i < 4; ++i) { const u32x4 o = *(const u32x4*)(sm + (16 * i + (lane >> 2)) * 80 + 16 * (lane & 3)); *(u32x4*)(dst + (size_t)(16 * i) * K) = o; }
    __builtin_amdgcn_s_waitcnt(0xc07f); asm volatile("" ::: "memory");
}

__device__ __forceinline__ void phase_pro1(const Params& p, unsigned char* smem) {
    const int tid = hid_tid(), lane = tid & 63, wave = tid >> 6;
    const int gw = blockIdx.x * 8 + wave, ngw = gridDim.x * 8;
    bf16_t* WIN = WSP(bf16_t, WS_WIN);
    {
        float* Mf = (float*)smem;
        float* tile = Mf + 4096 + wave * (64 * 65);
        float* trig = Mf + 4096 + 8 * (64 * 65);
        if (tid < 128) { const int i = tid & 63; const float a = (float)i * (1.f / 32.f); trig[tid] = tid < 64 ? cospif(a) : sinpif(a); }
        __syncthreads();
        for (int rep_ = 0; rep_ < REP_FOLD; ++rep_)
        for (int it = blockIdx.x; it < 96; it += gridDim.x) {
            const int kq = it & 3, g = (it >> 2) & 3, kind = (it >> 4) % 3, l = it / 48;
            for (int i = tid; i < 4096; i += 512) {
                const int cch = i >> 6, e = i & 63; float v;
                if (kind == 0) v = p.pool_w[((size_t)(l * 4 + g) * 64 + cch) * 64 + e] * p.pool_scale[l * 256 + g * 64 + e];
                else {
                    const float* fw = p.fft_w + (size_t)(l * 4 + g) * 4096 + e; const float* tb = trig + (kind == 1 ? 0 : 64);
                    float s = 0.f;
#pragma unroll 8
                    for (int m = 0; m < 64; ++m) s += tb[(m * cch) & 63] * fw[m * 64];
                    v = s * 0.125f;
                }
                Mf[i] = v;
            }
            __syncthreads();
            const int srcb = (kind == 0 ? 1536 : 1792) + 64 * g, dstb = (kind == 0 ? 1536 : (kind == 1 ? 1792 : 2048)) + 64 * g;
            {
                const int kb = 4 * kq + (wave & 3), eh = wave >> 2;
                for (int i = 0; i < 64; ++i) tile[i * 65 + lane] = p.w_in[((size_t)l * 1024 + 64 * kb + i) * 2048 + srcb + lane];
                __builtin_amdgcn_s_waitcnt(0xc07f); asm volatile("" ::: "memory");
                float acc[32];
#pragma unroll
                for (int e = 0; e < 32; ++e) acc[e] = 0.f;
                for (int cch = 0; cch < 64; ++cch) {
                    const float a = tile[lane * 65 + cch];
#pragma unroll
                    for (int e = 0; e < 32; ++e) acc[e] += a * Mf[cch * 64 + eh * 32 + e];
                }
#pragma unroll
                for (int e = 0; e < 32; ++e) WIN[((size_t)l * NIN + dstb + eh * 32 + e) * 1024 + 64 * kb + lane] = f2bf(acc[e]);
                __builtin_amdgcn_s_waitcnt(0xc07f); asm volatile("" ::: "memory");
            }
            __syncthreads();
        }
    }
    {
        unsigned char* tsm = smem + wave * (64 * 144);
        __syncthreads();
        constexpr int I_IN = 16 * 24, I_OUT = 16 * 16;
        constexpr int T0 = 2 * I_IN, T1 = T0 + 2 * I_OUT;
        for (int rep_ = 0; rep_ < REP_TR; ++rep_)
        for (int it = gw; it < T1; it += ngw) {
            if (it < T0) { const int l = it / I_IN, r = it % I_IN; transpose_item(p.w_in + (size_t)l * 1024 * 2048, 2048, 1024, WIN + (size_t)l * NIN * 1024, tsm, r % 16, r / 16, lane); }
            else { const int q = it - T0, l = q / I_OUT, r = q % I_OUT; transpose_item(p.w_out + (size_t)l * 1024 * 1024, 1024, 1024, WSP(bf16_t, WS_WOUT) + (size_t)l * 1024 * 1024, tsm, r % 16, r / 16, lane); }
        }
    }
    {
        bf16_t* DM_ = WSP(bf16_t, WS_DFTM); bf16_t* DC_ = WSP(bf16_t, WS_DFTC);
        const int gt = blockIdx.x * 512 + tid, ngt = gridDim.x * 512;
        for (int i = gt; i < 2048 * 256; i += ngt) {
            const int k = i >> 8, j0 = (i & 255) * 8; unsigned o[4];
#pragma unroll
            for (int q = 0; q < 4; ++q) { float v[2];
#pragma unroll
                for (int e = 0; e < 2; ++e) { const int j = j0 + 2 * q + e;
                    if (j <= 1024) { const int ph = (k * j) & 2047; v[e] = cospif((float)ph * (1.f / 1024.f)) * 0.02209708691f; }
                    else { const int ph = (k * (j - 1024)) & 2047; v[e] = -sinpif((float)ph * (1.f / 1024.f)) * 0.02209708691f; } }
                o[q] = pk2(v[0], v[1]); }
            *(u32x4*)(DM_ + (size_t)k * 2048 + j0) = (u32x4){o[0], o[1], o[2], o[3]};
        }
        for (int i = gt; i < 256 * 32; i += ngt) {
            const int k = i >> 5, j0 = (i & 31) * 8; unsigned o[4];
#pragma unroll
            for (int q = 0; q < 4; ++q) { float v[2];
#pragma unroll
                for (int e = 0; e < 2; ++e) { const int j = j0 + 2 * q + e;
                    if (j <= 128) { const int ph = (k * j) & 255; v[e] = cospif((float)ph * (1.f / 128.f)) * 0.0625f; }
                    else { const int ph = (k * (j - 128)) & 255; v[e] = -sinpif((float)ph * (1.f / 128.f)) * 0.0625f; } }
                o[q] = pk2(v[0], v[1]); }
            *(u32x4*)(DC_ + (size_t)k * 256 + j0) = (u32x4){o[0], o[1], o[2], o[3]};
        }
    }
    {
        bf16_t* RWT = WSP(bf16_t, WS_RWT);
        const int gt = blockIdx.x * 512 + tid, ngt = gridDim.x * 512;
        for (int i = gt; i < 2 * 32 * 128; i += ngt) {
            const int l = i >> 12, e = (i >> 7) & 31, k0 = (i & 127) * 8;
            const float* s = p.router_w + ((size_t)l * 1024 + k0) * 32 + e;
            u32x4 o; o.x = pk2(s[0], s[32]); o.y = pk2(s[64], s[96]); o.z = pk2(s[128], s[160]); o.w = pk2(s[192], s[224]);
            *(u32x4*)(RWT + ((size_t)(l * 32 + e)) * 1024 + k0) = o;
        }
    }
    {
        if (tid == 0) {
            unsigned* cnt = WSP(unsigned, WS_CTL + CTL_PRO0); unsigned sp = 0;
            while (__hip_atomic_load(cnt, __ATOMIC_RELAXED, __HIP_MEMORY_SCOPE_AGENT) < gridDim.x) { __builtin_amdgcn_s_sleep(2); if (++sp > (1u << 22)) break; }
            __builtin_amdgcn_fence(__ATOMIC_ACQUIRE, "agent");
            asm volatile("s_waitcnt vmcnt(0)" ::: "memory");
        }
        __syncthreads();
    }
    {
        const float* MOD = WSP(float, WS_MOD); bf16_t* H = WSP(bf16_t, WS_H);
        for (int r = gw; r < NT; r += ngw) {
            const float* xr = r < NX ? p.x + (size_t)r * DM : p.ctx + (size_t)(r - NX) * DM;
            const float* m = MOD + (size_t)(0 * 9 + mod_index(r)) * 6144;
            f32x4 hv[4];
            mod_row(xr, p.g1w, m, m + 1024, H + (size_t)r * DM, lane, hv);
        }
    }
}

enum { G_WIN = 0, G_DFT = 1, G_DFTC = 2, G_WOUT = 3, G_MOE1 = 4, G_MOE2 = 5 };
__device__ __forceinline__ void moe_tinfo(const Params& p, int l, int* tinfo) {
    if (threadIdx.x == 0) {
        const int* cnt = WSP(int, WS_CTL + CTL_CNT) + l * 32; int s = 0;
        for (int e = 0; e < 32; ++e) { const int c = cnt[e]; tinfo[e] = s; tinfo[33 + e] = c; s += (c + 255) >> 8; }
        tinfo[32] = s;
    }
    __syncthreads();
}

#define LAS __attribute__((address_space(3)))
namespace g8 {
constexpr int BM = 256, BK = 64, HALF = 128, HTB = HALF * BK * 2, STAGE_BYTES = 8 * HTB, NXCD = 8, WGM = 8;
__host__ __device__ __forceinline__ int lds_xor(int r) { return (((r >> 1) & 1) * 3) | (r & 4); }
__host__ __device__ __forceinline__ int lds_byte(int r, int c) { return r * 128 + ((((c >> 3) ^ lds_xor(r)) & 7) << 4); }
__host__ __device__ __forceinline__ void stage_rc(int b, int& R, int& C) { const int r = b >> 7, cp = (b >> 4) & 7; R = r; C = ((cp ^ lds_xor(r)) & 7) * 8; }
}
struct UnitD { unsigned boff; const int* gather; int arow0, nvalid, orow0, ocol0, e; };
template <int KIND> __device__ __forceinline__ void phase_geom(int l, const int* tinfo, int& nM, int& nN, int& K) {
    if (KIND == G_WIN) { nM = 72; nN = 9; K = 1024; }
    else if (KIND == G_DFT) { nM = 8; nN = 8; K = 2048; }
    else if (KIND == G_DFTC) { nM = 1; nN = 8; K = 256; }
    else if (KIND == G_WOUT) { nM = (l == 0) ? 72 : 64; nN = 4; K = 1024; }
    else if (KIND == G_MOE1) { nM = __builtin_amdgcn_readfirstlane(tinfo[32]); nN = 8; K = 1024; }
    else { nM = __builtin_amdgcn_readfirstlane(tinfo[32]); nN = 4; K = 1024; }
}
template <int KIND> __device__ __forceinline__ const bf16_t* phase_A(const Params& p) {
    if (KIND == G_WIN) return WSP(bf16_t, WS_H);
    if (KIND == G_MOE1) return (const bf16_t*)WSP(unsigned char, WS_H8);
    if (KIND == G_DFT) return WSP(bf16_t, WS_DFTM);
    if (KIND == G_DFTC) return WSP(bf16_t, WS_DFTC);
    if (KIND == G_WOUT) return WSP(bf16_t, WS_YCAT);
    return WSP(bf16_t, WS_ACT);
}
template <int KIND> __device__ __forceinline__ const void* phase_B(const Params& p, int l) {
    if (KIND == G_WIN) return WSP(bf16_t, WS_WIN) + (size_t)l * NIN * 1024;
    if (KIND == G_DFT) return WSP(bf16_t, WS_XF);
    if (KIND == G_DFTC) return WSP(bf16_t, WS_XFC);
    if (KIND == G_WOUT) return WSP(bf16_t, WS_WOUT) + (size_t)l * 1024 * 1024;
    if (KIND == G_MOE1) return WSP(unsigned char, WS_W1) + (size_t)l * NE * 2048 * 1024;
    return WSP(unsigned char, WS_W2) + (size_t)l * NE * 1024 * 1024;
}
template <int KIND> __device__ __forceinline__ void get_unit(const Params& p, int l, int pm, int pn, const int* tinfo, UnitD& u) {
    u.gather = nullptr; u.nvalid = 256; u.e = 0; u.arow0 = pm * 256; u.orow0 = pm * 256; u.ocol0 = pn * 256;
    if (KIND == G_WIN) u.boff = (unsigned)pn * 256u * 1024u * 2u;
    else if (KIND == G_DFT) u.boff = (unsigned)pn * 256u * 2048u * 2u;
    else if (KIND == G_DFTC) u.boff = (unsigned)pn * 256u * 256u * 2u;
    else if (KIND == G_WOUT) u.boff = (unsigned)pn * 256u * 1024u * 2u;
    else {
        int e = 0; while (tinfo[e + 1] <= pm) ++e;
        e = __builtin_amdgcn_readfirstlane(e); u.e = e;
        if (KIND == G_MOE1) { u.gather = WSP(int, WS_LIST) + (size_t)e * NT; u.arow0 = __builtin_amdgcn_readfirstlane((pm - tinfo[e]) * 256); u.nvalid = __builtin_amdgcn_readfirstlane(tinfo[33 + e]) - u.arow0;
                              u.boff = (unsigned)(e * 2048 + pn * 256) * 1024u; }
        else u.boff = (unsigned)(e * 1024 + pn * 256) * 1024u;
    }
}
__device__ __forceinline__ bool static_order(int i, int G, int c, int nM, int nN, int& pm, int& pn) {
    const int nwg = nM * nN; const long L = (long)i * G + c; if (L >= nwg) return false;
    int wgid = (int)L; { const int q = nwg / g8::NXCD, r = nwg % g8::NXCD, xcd = wgid % g8::NXCD, off = wgid / g8::NXCD; wgid = (xcd < r ? xcd * (q + 1) : r * (q + 1) + (xcd - r) * q) + off; }
    const int nig = g8::WGM * nN, gid = wgid / nig, fm = gid * g8::WGM, gsz = (nM - fm) < g8::WGM ? (nM - fm) : g8::WGM;
    pm = fm + ((wgid % nig) % gsz); pn = (wgid % nig) / gsz; return true;
}
template <int KIND>
__device__ __forceinline__ void gemm_phase256(const Params& p, const int l, LAS unsigned char* lds, const int* tinfo) {
    using namespace g8;
    const int tid = hid_tid(), wid = __builtin_amdgcn_readfirstlane(tid >> 6), lane = tid & 63, wr = wid >> 2, wc = wid & 3, fr = lane & 15, fq = lane >> 4;
    int nM, nN, K; phase_geom<KIND>(l, tinfo, nM, nN, K);
    constexpr bool F8 = (KIND == G_MOE1 || KIND == G_MOE2);
    constexpr int ES = F8 ? 1 : 2;
    constexpr int KREP = F8 ? REP_KL8 : REP_KL16;
    const int nt1 = K * ES / 128, nt = nt1 * KREP, G = gridDim.x, cwg = blockIdx.x;
    const __amdgpu_buffer_rsrc_t rsA = __builtin_amdgcn_make_buffer_rsrc((void*)phase_A<KIND>(p), 0, 0x7ffffff0, 0x00020000);
    const __amdgpu_buffer_rsrc_t rsB = __builtin_amdgcn_make_buffer_rsrc((void*)phase_B<KIND>(p, l), 0, 0x7ffffff0, 0x00020000);
    unsigned voffB[2];
#pragma unroll
    for (int i = 0; i < 2; ++i) { int R_, C_; stage_rc(tid * 16 + i * 8192, R_, C_);
        const int rho = R_ & 31, Rb = F8 ? 64 * (R_ >> 5) + 16 * ((rho & 15) >> 2) + 4 * (rho >> 4) + (rho & 3) : (R_ & ~31) + 8 * ((rho & 15) >> 2) + 4 * (rho >> 4) + (rho & 3);
        voffB[i] = (unsigned)(Rb * K * ES + C_ * 2); }
    const unsigned kstep = 128u, hstepB = (unsigned)((F8 ? 8 : HALF) * K * ES);
    const unsigned ldsw = (unsigned)wid * 1024u;
    int aoffL[2], boffL[2];
    { const int ra = wr * 64 + fr, rb = wc * 32 + fr;
      if (F8) { aoffL[0] = lds_byte(ra, 16 * fq); aoffL[1] = lds_byte(ra, 16 * fq + 8); boffL[0] = lds_byte(rb, 16 * fq); boffL[1] = lds_byte(rb, 16 * fq + 8); }
      else { aoffL[0] = lds_byte(ra, fq * 8); aoffL[1] = lds_byte(ra, fq * 8 + 32); boffL[0] = lds_byte(rb, fq * 8); boffL[1] = lds_byte(rb, fq * 8 + 32); } }
#define G8_SA(b, h) (((b) * 2 + (h)) * HTB)
#define G8_SB(b, h) ((4 + (b) * 2 + (h)) * HTB)
#define G8_STAGE_A(bufoff, ktb, h) do { _Pragma("unroll") for (int _i = 0; _i < 2; ++_i) \
        __builtin_amdgcn_raw_ptr_buffer_load_lds(rsA, (LAS void*)(lds + (bufoff) + ldsw + _i * 8192), 16, aoff[h][_i], (int)(ktb), 0, 0); } while (0)
#define G8_STAGE_B(bufoff, soff) do { _Pragma("unroll") for (int _i = 0; _i < 2; ++_i) \
        __builtin_amdgcn_raw_ptr_buffer_load_lds(rsB, (LAS void*)(lds + (bufoff) + ldsw + _i * 8192), 16, voffB[_i], (int)(soff), 0, 0); } while (0)
#define G8_LDA(dst, b, h) do { _Pragma("unroll") for (int m = 0; m < 4; ++m) _Pragma("unroll") for (int k = 0; k < 2; ++k) { const u32x4 _v = *(const LAS u32x4*)(lds + G8_SA(b, h) + aoffL[k] + m * 2048); dst[m][4 * k] = (int)_v.x; dst[m][4 * k + 1] = (int)_v.y; dst[m][4 * k + 2] = (int)_v.z; dst[m][4 * k + 3] = (int)_v.w; } } while (0)
#define G8_LDB(dst, b, h) do { _Pragma("unroll") for (int n = 0; n < 2; ++n) _Pragma("unroll") for (int k = 0; k < 2; ++k) { const u32x4 _v = *(const LAS u32x4*)(lds + G8_SB(b, h) + boffL[k] + n * 2048); dst[n][4 * k] = (int)_v.x; dst[n][4 * k + 1] = (int)_v.y; dst[n][4 * k + 2] = (int)_v.z; dst[n][4 * k + 3] = (int)_v.w; } } while (0)
#define G8_MMA(ai, bj, At, Bt) do { __builtin_amdgcn_s_setprio(1); _Pragma("unroll") for (int m = 0; m < 4; ++m) _Pragma("unroll") for (int n = 0; n < 2; ++n) { \
        if (F8) acc[ai][bj][m][n] = __builtin_amdgcn_mfma_scale_f32_16x16x128_f8f6f4(Bt[n], At[m], acc[ai][bj][m][n], 0, 0, 0, 0, 0, 0); \
        else { typedef int i32x4_ __attribute__((ext_vector_type(4))); \
               const i32x4_ _a0 = __builtin_shufflevector(At[m], At[m], 0, 1, 2, 3), _a1 = __builtin_shufflevector(At[m], At[m], 4, 5, 6, 7); \
               const i32x4_ _b0 = __builtin_shufflevector(Bt[n], Bt[n], 0, 1, 2, 3), _b1 = __builtin_shufflevector(Bt[n], Bt[n], 4, 5, 6, 7); \
               acc[ai][bj][m][n] = __builtin_amdgcn_mfma_f32_16x16x32_bf16(*(const bf16x8*)&_b0, *(const bf16x8*)&_a0, acc[ai][bj][m][n], 0, 0, 0); \
               acc[ai][bj][m][n] = __builtin_amdgcn_mfma_f32_16x16x32_bf16(*(const bf16x8*)&_b1, *(const bf16x8*)&_a1, acc[ai][bj][m][n], 0, 0, 0); } } \
        __builtin_amdgcn_s_setprio(0); } while (0)
#define G8_WAIT_V(n) asm volatile("s_waitcnt vmcnt(" #n ")" ::: "memory")
#define G8_WAIT_L(n) asm volatile("s_waitcnt lgkmcnt(" #n ")" ::: "memory")
#define G8_BAR __builtin_amdgcn_s_barrier()
#define G8_SCHED __builtin_amdgcn_sched_barrier(0)
#define G8_AOFF(dst, u) do { _Pragma("unroll") for (int _h = 0; _h < 2; ++_h) _Pragma("unroll") for (int _i = 0; _i < 2; ++_i) { int _R, _C; stage_rc(tid * 16 + _i * 8192, _R, _C); const int _rt = _h * 128 + _R; int _ar; \
        if (KIND == G_MOE1) _ar = (u).gather[(u).arow0 + (_rt < (u).nvalid ? _rt : -(u).arow0)]; else _ar = (u).arow0 + _rt; \
        dst[_h][_i] = (unsigned)(_ar * K * ES + _C * 2); } } while (0)
    UnitD cur, nxt; int ui = 0, pm, pn;
    if (!static_order(0, G, cwg, nM, nN, pm, pn)) return;
    get_unit<KIND>(p, l, pm, pn, tinfo, cur);
    unsigned aoff[2][2]; G8_AOFF(aoff, cur);
    f32x4 acc[2][2][4][2];
#pragma unroll
    for (int a = 0; a < 2; ++a)
#pragma unroll
        for (int b = 0; b < 2; ++b)
#pragma unroll
            for (int m = 0; m < 4; ++m)
#pragma unroll
                for (int n = 0; n < 2; ++n) acc[a][b][m][n] = (f32x4){0.f, 0.f, 0.f, 0.f};
    i32x8 At[4], B0[2], B1[2];
    unsigned cB = cur.boff;
    G8_STAGE_B(G8_SB(0, 0), cB); G8_STAGE_A(G8_SA(0, 0), 0, 0); G8_STAGE_B(G8_SB(0, 1), cB + hstepB); G8_STAGE_A(G8_SA(0, 1), 0, 1);
    if (wr == 1) G8_BAR;
    G8_WAIT_V(4); G8_BAR;
    G8_STAGE_B(G8_SB(1, 0), cB + kstep); G8_STAGE_A(G8_SA(1, 0), kstep, 0); G8_STAGE_B(G8_SB(1, 1), cB + hstepB + kstep);
    G8_WAIT_V(6); G8_BAR;
    G8_LDB(B0, 0, 0);
    for (;;) {
        const bool has_next = static_order(ui + 1, G, cwg, nM, nN, pm, pn);
        if (has_next) get_unit<KIND>(p, l, pm, pn, tinfo, nxt);
        const unsigned nB = has_next ? nxt.boff : cB;
        if ((KIND == G_MOE1 || KIND == G_MOE2) && wid == 0) {
            const float* bsrc = ((KIND == G_MOE1) ? p.b1 + (size_t)(l * NE + cur.e) * 2048 : p.b2 + (size_t)(l * NE + cur.e) * 1024) + cur.ocol0 + 4 * lane;
            __builtin_amdgcn_global_load_lds((const unsigned*)bsrc, (LAS unsigned*)(lds + STAGE_BYTES + (ui & 1) * 1024), 16, 0, 0);
            if (KIND == G_MOE1 && has_next)
                __builtin_amdgcn_global_load_lds((const unsigned*)(nxt.gather + nxt.arow0 + 4 * lane), (LAS unsigned*)(lds + STAGE_BYTES + 2048 + ((ui + 1) & 1) * 1024), 16, 0, 0);
        }
#pragma unroll 1
        for (int t = 0; t < nt; t += 2) {
            const bool last = (t == nt - 2);
            if (KREP > 1 && t == nt - nt1) {
#pragma unroll
                for (int a = 0; a < 2; ++a)
#pragma unroll
                    for (int b = 0; b < 2; ++b)
#pragma unroll
                        for (int m = 0; m < 4; ++m)
#pragma unroll
                            for (int n = 0; n < 2; ++n) acc[a][b][m][n] = (f32x4){0.f, 0.f, 0.f, 0.f};
            }
            unsigned naoff1[2];
            if (KIND == G_MOE1 && last && has_next) {
                const LAS int* itab = (const LAS int*)(lds + STAGE_BYTES + 2048 + ((ui + 1) & 1) * 1024);
#pragma unroll
                for (int _i = 0; _i < 2; ++_i) { int _R, _C; stage_rc(tid * 16 + _i * 8192, _R, _C);
                    const int _r0 = _R, _r1 = 128 + _R;
                    const int a0 = itab[_r0 < nxt.nvalid ? _r0 : 0], a1 = itab[_r1 < nxt.nvalid ? _r1 : 0];
                    aoff[0][_i] = (unsigned)(a0 * K * ES + _C * 2); naoff1[_i] = (unsigned)(a1 * K * ES + _C * 2); }
            }
            G8_LDA(At, 0, 0); G8_STAGE_A(G8_SA(1, 1), (unsigned)((t + 1) & (nt1 - 1)) * kstep, 1);
            G8_BAR; G8_WAIT_L(0); G8_MMA(0, 0, At, B0); G8_BAR; G8_SCHED;
            unsigned kt2 = (unsigned)((t + 2) & (nt1 - 1)) * kstep; unsigned b2 = cB + kt2;
            if (last) { kt2 = 0; b2 = nB; if (has_next) { if (KIND == G_MOE1) { aoff[1][0] = naoff1[0]; aoff[1][1] = naoff1[1]; } else G8_AOFF(aoff, nxt); } }
            G8_LDB(B1, 0, 1); G8_STAGE_B(G8_SB(0, 0), b2);
            G8_BAR; G8_WAIT_L(0); G8_MMA(0, 1, At, B1); G8_BAR;
            G8_LDA(At, 0, 1); G8_STAGE_A(G8_SA(0, 0), kt2, 0);
            G8_WAIT_V(10); G8_BAR; G8_WAIT_L(0); G8_MMA(1, 0, At, B0); G8_BAR; G8_SCHED;
            G8_LDB(B0, 1, 0); G8_STAGE_B(G8_SB(0, 1), b2 + hstepB);
            G8_WAIT_V(6); G8_BAR; G8_MMA(1, 1, At, B1); G8_BAR;
            G8_LDA(At, 1, 0); G8_STAGE_A(G8_SA(0, 1), kt2, 1);
            G8_BAR; G8_WAIT_L(0); G8_MMA(0, 0, At, B0); G8_BAR; G8_SCHED;
            G8_LDB(B1, 1, 1); G8_STAGE_B(G8_SB(1, 0), b2 + kstep);
            G8_BAR; G8_WAIT_L(0); G8_MMA(0, 1, At, B1); G8_BAR;
            G8_LDA(At, 1, 1); G8_STAGE_A(G8_SA(1, 0), kt2 + kstep, 0);
            G8_WAIT_V(10); G8_BAR; G8_WAIT_L(0); G8_MMA(1, 0, At, B0); G8_BAR; G8_SCHED;
            if (!last) G8_LDB(B0, 0, 0);
            G8_STAGE_B(G8_SB(1, 1), b2 + kstep + hstepB);
            G8_WAIT_V(6); G8_BAR; G8_MMA(1, 1, At, B1); G8_BAR;
        }
#if REP_EPI > 1
        int erep_n = F8 ? REP_EPI : 1; asm volatile("" : "+s"(erep_n));
#pragma unroll 1
        for (int erep_ = 0; erep_ < erep_n; ++erep_)
#endif
        {
            const int r0 = wr * 64 + fr, c0 = wc * 32 + 8 * fq;
            f32x4 cv[2][2];
            if (KIND == G_MOE1 || KIND == G_MOE2 || KIND == G_WOUT) {
                const float* cbase = WSP(float, WS_MOD) + (size_t)(l * 9 + mod_index(cur.orow0)) * 6144 + 2048;
#pragma unroll
                for (int bj = 0; bj < 2; ++bj)
#pragma unroll
                    for (int n = 0; n < 2; ++n) {
                        if (KIND == G_WOUT) cv[bj][n] = *(const f32x4*)(cbase + cur.ocol0 + bj * HALF + c0 + 4 * n);
                        else cv[bj][n] = *(const LAS f32x4*)(lds + STAGE_BYTES + (ui & 1) * 1024 + (wc * 64 + 16 * fq + 8 * bj + 4 * n) * 4);
                    }
            }
#pragma unroll
            for (int ai = 0; ai < 2; ++ai) {
                if (KIND == G_WOUT) {
                    f32x4 xv[4][2][2];
#pragma unroll
                    for (int m = 0; m < 4; ++m) {
                        const int row = cur.orow0 + ai * HALF + r0 + m * 16;
                        if (l == 0) {
                            const float* xin = row < NX ? p.x + (size_t)row * DM : p.ctx + (size_t)(row - NX) * DM;
#pragma unroll
                            for (int bj = 0; bj < 2; ++bj)
#pragma unroll
                                for (int n = 0; n < 2; ++n) xv[m][bj][n] = *(const f32x4*)(xin + cur.ocol0 + bj * HALF + c0 + 4 * n);
                        } else {
#pragma unroll
                            for (int bj = 0; bj < 2; ++bj) { const u32x4 w = *(const u32x4*)(WSP(bf16_t, WS_X2) + (size_t)row * DM + cur.ocol0 + bj * HALF + c0);
                                xv[m][bj][0] = (f32x4){bflo(w.x), bfhi(w.x), bflo(w.y), bfhi(w.y)}; xv[m][bj][1] = (f32x4){bflo(w.z), bfhi(w.z), bflo(w.w), bfhi(w.w)}; }
                        }
                    }
#pragma unroll
                    for (int m = 0; m < 4; ++m) {
                        const int row = cur.orow0 + ai * HALF + r0 + m * 16;
#pragma unroll
                        for (int bj = 0; bj < 2; ++bj) {
                            const f32x4 v0 = acc[ai][bj][m][0], v1 = acc[ai][bj][m][1], g0 = cv[bj][0], g1 = cv[bj][1], x0 = xv[m][bj][0], x1 = xv[m][bj][1];
                            u32x4 o; o.x = pk2(x0.x + g0.x * v0.x, x0.y + g0.y * v0.y); o.y = pk2(x0.z + g0.z * v0.z, x0.w + g0.w * v0.w);
                            o.z = pk2(x1.x + g1.x * v1.x, x1.y + g1.y * v1.y); o.w = pk2(x1.z + g1.z * v1.z, x1.w + g1.w * v1.w);
                            *(u32x4*)(WSP(bf16_t, WS_X1) + (size_t)row * DM + cur.ocol0 + bj * HALF + c0) = o;
                        }
                    }
                } else {
#pragma unroll
                    for (int m = 0; m < 4; ++m) {
                        const int row = cur.orow0 + ai * HALF + r0 + m * 16;
                        if (F8) {
                            const int colw = cur.ocol0 + wc * 64 + 16 * fq;
                            unsigned ow[2][2];
#pragma unroll
                            for (int bj = 0; bj < 2; ++bj) {
                                const f32x4 v0 = acc[ai][bj][m][0], v1 = acc[ai][bj][m][1];
                                if (KIND == G_MOE1) {
                                    constexpr float dq = 1.f / (SW8 * SH8);
                                    const f32x4 b0 = cv[bj][0], b1 = cv[bj][1];
                                    const float u[8] = {v0.x * dq + b0.x, v0.y * dq + b0.y, v0.z * dq + b0.z, v0.w * dq + b0.w, v1.x * dq + b1.x, v1.y * dq + b1.y, v1.z * dq + b1.z, v1.w * dq + b1.w};
                                    float o[4];
#pragma unroll
                                    for (int q = 0; q < 4; ++q) { const float g = fminf(u[2 * q], 7.f), li = fminf(fmaxf(u[2 * q + 1], -7.f), 7.f);
                                        o[q] = g * __builtin_amdgcn_rcpf(1.f + __builtin_amdgcn_exp2f(-2.45546696f * g)) * (li + 1.f) * SA8; }
                                    ow[bj][0] = pk4_fp8(o[0], o[1], o[2], o[3]); ow[bj][1] = 0u;
                                } else {
                                    constexpr float dq = SY8 / (SW8 * SA8);
                                    const f32x4 b0 = cv[bj][0] * SY8, b1 = cv[bj][1] * SY8;
#define CL8(x) fminf(fmaxf((x), -448.f), 448.f)
                                    ow[bj][0] = pk4_fp8(CL8(v0.x * dq + b0.x), CL8(v0.y * dq + b0.y), CL8(v0.z * dq + b0.z), CL8(v0.w * dq + b0.w));
                                    ow[bj][1] = pk4_fp8(CL8(v1.x * dq + b1.x), CL8(v1.y * dq + b1.y), CL8(v1.z * dq + b1.z), CL8(v1.w * dq + b1.w));
#undef CL8
                                }
                            }
                            if (KIND == G_MOE1) { u32x2 o; o.x = ow[0][0]; o.y = ow[1][0]; *(u32x2*)(WSP(unsigned char, WS_ACT) + (size_t)row * FF + (colw >> 1)) = o; }
                            else { u32x4 o; o.x = ow[0][0]; o.y = ow[0][1]; o.z = ow[1][0]; o.w = ow[1][1]; *(u32x4*)(WSP(unsigned char, WS_Y2) + (size_t)row * DM + colw) = o; }
                        } else {
#pragma unroll
                            for (int bj = 0; bj < 2; ++bj) {
                                const f32x4 v0 = acc[ai][bj][m][0], v1 = acc[ai][bj][m][1]; const int col = cur.ocol0 + bj * HALF + c0;
                                u32x4 o; o.x = pk2(v0.x, v0.y); o.y = pk2(v0.z, v0.w); o.z = pk2(v1.x, v1.y); o.w = pk2(v1.z, v1.w);
                                bf16_t* dst;
                                if (KIND == G_WIN) dst = WSP(bf16_t, WS_PX) + (size_t)row * NIN + col;
                                else if (KIND == G_DFT) dst = WSP(bf16_t, WS_YCAT) + (size_t)((col >> 8) * SEQ + row) * DM + 768 + (col & 255);
                                else dst = WSP(bf16_t, WS_YCAT) + (size_t)(NX + (col >> 8) * LC + row) * DM + 768 + (col & 255);
                                *(u32x4*)dst = o;
                            }
                        }
                    }
                }
            }
        }
        if (!has_next) break;
#pragma unroll
        for (int a = 0; a < 2; ++a)
#pragma unroll
            for (int b = 0; b < 2; ++b)
#pragma unroll
                for (int m = 0; m < 4; ++m)
#pragma unroll
                    for (int n = 0; n < 2; ++n) acc[a][b][m][n] = (f32x4){0.f, 0.f, 0.f, 0.f};
        cur = nxt; cB = nB; ++ui;
        G8_LDB(B0, 0, 0);
    }
    G8_WAIT_V(0);
    if (wr == 0) G8_BAR;
    G8_BAR;
#undef G8_SA
#undef G8_SB
#undef G8_STAGE_A
#undef G8_STAGE_B
#undef G8_LDA
#undef G8_LDB
#undef G8_MMA
#undef G8_WAIT_V
#undef G8_WAIT_L
#undef G8_BAR
#undef G8_SCHED
#undef G8_AOFF
}

__device__ __forceinline__ void wave_transpose_store(bf16_t* sm  , const u32x4 (&v)[8], bf16_t* dst, size_t dstride, int lane, int cpos) {
#pragma unroll
    for (int i = 0; i < 8; ++i) {
        const unsigned w[4] = {v[i].x, v[i].y, v[i].z, v[i].w};
#pragma unroll
        for (int q = 0; q < 4; ++q) { sm[(8 * i + 2 * q) * 72 + cpos] = (bf16_t)(w[q] & 0xffffu); sm[(8 * i + 2 * q + 1) * 72 + cpos] = (bf16_t)(w[q] >> 16); }
    }
    __builtin_amdgcn_s_waitcnt(0xc07f); asm volatile("" ::: "memory");
#pragma unroll
    for (int i = 0; i < 8; ++i) { const u32x4 o = *(const u32x4*)(sm + lane * 72 + 8 * i); *(u32x4*)(dst + (size_t)lane * dstride + 8 * i) = o; }
    __builtin_amdgcn_s_waitcnt(0xc07f); asm volatile("" ::: "memory");
}

__device__ __forceinline__ void phase_prep(const Params& p, const int l, unsigned char* smem) {
    const int tid = hid_tid(), lane = tid & 63, wave = tid >> 6;
    const int gw = blockIdx.x * 8 + wave, ngw = gridDim.x * 8;
    const bf16_t* PX = WSP(bf16_t, WS_PX); const float* ROPE = WSP(float, WS_ROPE);
    bf16_t *QA = WSP(bf16_t, WS_QA), *KA = WSP(bf16_t, WS_KA), *QD = WSP(bf16_t, WS_QD), *KD = WSP(bf16_t, WS_KD), *YC = WSP(bf16_t, WS_YCAT);
    struct RowRaw { u32x2 q[4]; u32x2 wv[16]; u32x2 cu; };
    auto row_load = [&](int r, RowRaw& R) {
        const bool isctx = r >= NX; const int t = isctx ? ((r - NX) & 255) : (r & 2047);
        const bf16_t* px = PX + (size_t)r * NIN;
        R.q[0] = *(const u32x2*)(px + 4 * lane); R.q[1] = *(const u32x2*)(px + 256 + 4 * lane); R.q[2] = *(const u32x2*)(px + 768 + 4 * lane); R.q[3] = *(const u32x2*)(px + 1024 + 4 * lane);
        if (!(l == 1 && isctx)) {
            const int g = lane >> 4, win = 2 << g, Ls = isctx ? LC : SEQ;
            int lo = t - win / 2, hi = lo + win; lo = lo < 0 ? 0 : lo; hi = hi > Ls ? Ls : hi;
            const bf16_t* base = PX + (size_t)(r - t) * NIN + 1536 + 4 * lane;
#pragma unroll
            for (int j = 0; j < 16; ++j) { const int tt = lo + j < hi ? lo + j : hi - 1; R.wv[j] = *(const u32x2*)(base + (size_t)tt * NIN); }
            R.cu = *(const u32x2*)(base + (size_t)t * NIN);
        }
    };
    RowRaw cur, nxt;
    if (gw < NT) row_load(gw, nxt);
    for (int r = gw; r < NT; r += ngw) {
        cur = nxt;
        if (r + ngw < NT) row_load(r + ngw, nxt);
        const bool isctx = r >= NX; int b, t, kidx;
        if (!isctx) { b = r >> 11; t = r & 2047; kidx = 256 + t; } else { const int rr = r - NX; b = rr >> 8; t = rr & 255; kidx = t; }
        const int h = lane >> 4, d4 = (4 * lane) & 63;
        const size_t obase = ((size_t)(b * 4 + h) * KEYS + kidx) * 64 + d4;
        float v[4];
        { unpack4(cur.q[0], v); float ss = v[0] * v[0] + v[1] * v[1] + v[2] * v[2] + v[3] * v[3];
          ss = sum16_dpp(ss);
          const float rs = rsqrtf(ss * (1.f / 64.f) + EPS) * 0.18033688f; const f32x4 g = *(const f32x4*)(p.na_qg + l * 64 + d4);
          u32x2 o; o.x = pk2(v[0] * rs * g.x, v[1] * rs * g.y); o.y = pk2(v[2] * rs * g.z, v[3] * rs * g.w); *(u32x2*)(QA + obase) = o; }
        { unpack4(cur.q[1], v); float ss = v[0] * v[0] + v[1] * v[1] + v[2] * v[2] + v[3] * v[3];
          ss = sum16_dpp(ss);
          const float rs = rsqrtf(ss * (1.f / 64.f) + EPS); const f32x4 g = *(const f32x4*)(p.na_kg + l * 64 + d4);
          u32x2 o; o.x = pk2(v[0] * rs * g.x, v[1] * rs * g.y); o.y = pk2(v[2] * rs * g.z, v[3] * rs * g.w); *(u32x2*)(KA + obase) = o; }
        const int li = lane & 7, d32 = 4 * li;
        float cs[4], sn[4];
        if (!isctx) {
            const int pos = (li & 4) ? (t & 63) : (t >> 6);
            const f32x4* rt = (const f32x4*)(ROPE + (pos * 8 + 4 * (li & 1)) * 2);
            const f32x4 r0 = rt[0], r1 = rt[1];
            cs[0] = r0.x; sn[0] = r0.y; cs[1] = r0.z; sn[1] = r0.w; cs[2] = r1.x; sn[2] = r1.y; cs[3] = r1.z; sn[3] = r1.w;
        }
#pragma unroll
        for (int which = 0; which < 2; ++which) {
            unpack4(cur.q[2 + which], v);
            float ss = v[0] * v[0] + v[1] * v[1] + v[2] * v[2] + v[3] * v[3];
            ss = sum8_dpp(ss);
            const float rs = rsqrtf(ss * (1.f / 32.f) + EPS);
            const f32x4 g = *(const f32x4*)((which ? p.df_kg : p.df_qg) + l * 32 + d32);
            float y[4] = {v[0] * rs * g.x, v[1] * rs * g.y, v[2] * rs * g.z, v[3] * rs * g.w};
            if (!isctx) {
#pragma unroll
                for (int e = 0; e < 4; ++e) { const float o = DPP_F(y[e], 0x4E); y[e] = (li & 2) ? (y[e] * cs[e] + o * sn[e]) : (y[e] * cs[e] - o * sn[e]); }
            }
            const float sc = which ? 1.f : 0.25503486f;
            u32x2 o; o.x = pk2(y[0] * sc, y[1] * sc); o.y = pk2(y[2] * sc, y[3] * sc);
            *(u32x2*)((which ? KD : QD) + obase) = o;
        }
        if (!(l == 1 && isctx)) {
            const int g = lane >> 4, win = 2 << g, Ls = isctx ? LC : SEQ;
            int lo = t - win / 2, hi = lo + win; lo = lo < 0 ? 0 : lo; hi = hi > Ls ? Ls : hi;
            float s[4] = {0.f, 0.f, 0.f, 0.f};
#pragma unroll
            for (int j = 0; j < 16; ++j) { float q[4]; unpack4(cur.wv[j], q); const float m = lo + j < hi ? 1.f : 0.f; s[0] += m * q[0]; s[1] += m * q[1]; s[2] += m * q[2]; s[3] += m * q[3]; }
            float u[4]; unpack4(cur.cu, u);
            const float inv = 1.f / (float)(hi - lo);
            u32x2 o; o.x = pk2(s[0] * inv - u[0], s[1] * inv - u[1]); o.y = pk2(s[2] * inv - u[2], s[3] * inv - u[3]);
            *(u32x2*)(YC + (size_t)r * DM + 512 + 4 * lane) = o;
        }
    }
    bf16_t* sm = (bf16_t*)smem + wave * (64 * 72);
    for (int it = gw; it < 2 * 8 * 4 * 36; it += ngw) {
        const int ch = it % 36, h = (it / 36) & 3, b = (it / 144) & 7, which = it / 1152;
        const int kidx = 64 * ch + lane; const int row = kidx < 256 ? NX + b * LC + kidx : b * SEQ + kidx - 256;
        const u32x4* src = (const u32x4*)(PX + (size_t)row * NIN + (which ? 1280 : 512) + 64 * h);
        u32x4 v[8];
#pragma unroll
        for (int i = 0; i < 8; ++i) v[i] = src[i];
        bf16_t* dst = (which ? WSP(bf16_t, WS_VTD) : WSP(bf16_t, WS_VTA)) + (size_t)(b * 4 + h) * 64 * KEYS + 64 * ch;
        wave_transpose_store(sm, v, dst, KEYS, lane, (lane & 48) | (((lane >> 2) & 1) << 3) | (((lane >> 3) & 1) << 2) | (lane & 3));
    }
    const int nC = 8 * 4 * 32 + (l == 0 ? 8 * 4 * 4 : 0);
    for (int it = gw; it < nC; it += ngw) {
        const bool cx = it >= 1024; const int q = cx ? it - 1024 : it;
        const int N = cx ? 256 : 2048, njc = N / 64;
        const int jc = q % njc, cc = (q / njc) & 3, b = q / (njc * 4);
        const int j = 64 * jc + lane; const int rowb = cx ? NX + b * LC : b * SEQ;
        int t1, t2, col; float sgn;
        if (j <= N / 2) { t1 = j; t2 = (j == 0 || j == N / 2) ? -1 : N - j; col = 1792 + 64 * cc; sgn = 1.f; }
        else { t1 = j - N / 2; t2 = N - t1; col = 2048 + 64 * cc; sgn = -1.f; }
        const u32x4* s1 = (const u32x4*)(PX + (size_t)(rowb + t1) * NIN + col);
        const u32x4* s2 = (const u32x4*)(PX + (size_t)(rowb + (t2 < 0 ? t1 : t2)) * NIN + col);
        const float w2 = t2 < 0 ? 0.f : sgn;
        u32x4 v[8];
#pragma unroll
        for (int i = 0; i < 8; ++i) {
            const u32x4 a = s1[i], bq = s2[i]; u32x4 o;
            o.x = pk2(bflo(a.x) + w2 * bflo(bq.x), bfhi(a.x) + w2 * bfhi(bq.x)); o.y = pk2(bflo(a.y) + w2 * bflo(bq.y), bfhi(a.y) + w2 * bfhi(bq.y));
            o.z = pk2(bflo(a.z) + w2 * bflo(bq.z), bfhi(a.z) + w2 * bfhi(bq.z)); o.w = pk2(bflo(a.w) + w2 * bflo(bq.w), bfhi(a.w) + w2 * bfhi(bq.w));
            v[i] = o;
        }
        bf16_t* dst = (cx ? WSP(bf16_t, WS_XFC) : WSP(bf16_t, WS_XF)) + (size_t)(b * 256 + 64 * cc) * N + 64 * jc;
        wave_transpose_store(sm, v, dst, N, lane, lane);
    }
}


__device__ __forceinline__ unsigned cvt_pk_bf16(float lo, float hi) { return pk2(lo, hi); }
__device__ __forceinline__ void phase_df_mfma(const Params& p, const int l, LAS unsigned char* lds) {
    const int tid = hid_tid(), wave = __builtin_amdgcn_readfirstlane(tid >> 6), lane = tid & 63, qn = lane & 31, hh = lane >> 5;
    const float* SC = WSP(float, WS_SCAL) + l * 16;
    const float lam = SC[0], lam_init = SC[1], negmb = -SC[2];
    const int nunits = 256 + (l == 0 ? 32 : 0);
    const int srow = tid >> 3, scq = (tid & 7) ^ ((srow >> 1) & 7);
    const unsigned ldsw = (unsigned)tid * 16u;
    f32x16 negm;
#pragma unroll
    for (int i = 0; i < 16; ++i) negm[i] = negmb;
    const int rsw = (qn >> 1) & 7;
    for (int it_ = 0;; ++it_) {
        int u;
        if (gridDim.x == 256) { if (it_ == 0) u = blockIdx.x; else { if (it_ > 1 || nunits <= 256 || blockIdx.x < 224) break; u = 256 + (255 - (int)blockIdx.x); } }
        else { u = blockIdx.x + it_ * (int)gridDim.x; if (u >= nunits) break; }
        const bool cx = u >= 256; const int qt = (u >> 3) & 7, bh = cx ? u - 256 : (u & 7) * 4 + (u >> 6), b = bh >> 2, h = bh & 3;
        const int q0 = cx ? 0 : 256 + 256 * qt, nkt = cx ? 4 : 36;
        const int orow = (cx ? NX + b * LC : b * SEQ + 256 * qt) + 32 * wave + qn;
        const char* Kg = (const char*)(WSP(bf16_t, WS_KD) + (size_t)bh * KEYS * 64) + srow * 128 + scq * 16;
        const char* Vg = (const char*)(WSP(bf16_t, WS_VTD) + (size_t)bh * 64 * KEYS) + (size_t)srow * KEYS * 2 + scq * 16;
        bf16x8 qf[2][2];
        { const bf16_t* Q = WSP(bf16_t, WS_QD) + ((size_t)bh * KEYS + q0 + 32 * wave + qn) * 64;
#pragma unroll
          for (int sub = 0; sub < 2; ++sub)
#pragma unroll
              for (int ks = 0; ks < 2; ++ks) qf[sub][ks] = *(const bf16x8*)(Q + 32 * sub + 16 * ks + 8 * hh); }
        f32x16 O1[2], O2[2]; float l1 = 0.f, l2 = 0.f;
        for (int trep_ = 0; trep_ < REP_TILE; ++trep_) {
#pragma unroll
        for (int db = 0; db < 2; ++db)
#pragma unroll
            for (int i = 0; i < 16; ++i) { O1[db][i] = 0.f; O2[db][i] = 0.f; }
        l1 = 0.f; l2 = 0.f;
        __syncthreads();
        __builtin_amdgcn_global_load_lds((const unsigned*)Kg, (LAS unsigned*)(lds + ldsw), 16, 0, 0);
        __builtin_amdgcn_global_load_lds((const unsigned*)Vg, (LAS unsigned*)(lds + 8192 + ldsw), 16, 0, 0);
        __builtin_amdgcn_global_load_lds((const unsigned*)(Kg + (size_t)64 * 128), (LAS unsigned*)(lds + 16384 + ldsw), 16, 0, 0);
        __builtin_amdgcn_global_load_lds((const unsigned*)(Vg + (size_t)64 * 2), (LAS unsigned*)(lds + 16384 + 8192 + ldsw), 16, 0, 0);
        asm volatile("s_waitcnt vmcnt(2)" ::: "memory"); __builtin_amdgcn_s_barrier();
        unsigned bo = 0u;
#pragma unroll 1
        for (int t = 0; t < nkt; ++t) {
            if (t + 2 < nkt) {
                const unsigned bn = bo == 0u ? 32768u : bo - 16384u;
                __builtin_amdgcn_global_load_lds((const unsigned*)(Kg + (size_t)(t + 2) * 64 * 128), (LAS unsigned*)(lds + bn + ldsw), 16, 0, 0);
                __builtin_amdgcn_global_load_lds((const unsigned*)(Vg + (size_t)(t + 2) * 64 * 2), (LAS unsigned*)(lds + bn + 8192 + ldsw), 16, 0, 0);
            }
#pragma unroll
            for (int kb = 0; kb < 2; ++kb) {
                const LAS unsigned char* kt = lds + bo + (32 * kb + qn) * 128;
                bf16x8 kf[2][2];
#pragma unroll
                for (int sub = 0; sub < 2; ++sub)
#pragma unroll
                    for (int ks = 0; ks < 2; ++ks) kf[sub][ks] = *(const LAS bf16x8*)(kt + (((4 * sub + 2 * ks + hh) ^ rsw) << 4));
                f32x16 S1 = __builtin_amdgcn_mfma_f32_32x32x16_bf16(kf[0][0], qf[0][0], negm, 0, 0, 0);
                S1 = __builtin_amdgcn_mfma_f32_32x32x16_bf16(kf[0][1], qf[0][1], S1, 0, 0, 0);
                f32x16 S2 = __builtin_amdgcn_mfma_f32_32x32x16_bf16(kf[1][0], qf[1][0], negm, 0, 0, 0);
                S2 = __builtin_amdgcn_mfma_f32_32x32x16_bf16(kf[1][1], qf[1][1], S2, 0, 0, 0);
                bf16x8 vf[2][2];
#pragma unroll
                for (int db = 0; db < 2; ++db)
#pragma unroll
                    for (int s = 0; s < 2; ++s) vf[db][s] = *(const LAS bf16x8*)(lds + bo + 8192 + (32 * db + qn) * 128 + (((4 * kb + 2 * s + hh) ^ rsw) << 4));
                unsigned pa[8], pb[8];
#pragma unroll
                for (int i = 0; i < 8; ++i) {
                    const float a0 = __builtin_amdgcn_exp2f(S1[2 * i]), a1 = __builtin_amdgcn_exp2f(S1[2 * i + 1]);
                    const float b0 = __builtin_amdgcn_exp2f(S2[2 * i]), b1 = __builtin_amdgcn_exp2f(S2[2 * i + 1]);
                    l1 += a0 + a1; l2 += b0 + b1;
                    pa[i] = cvt_pk_bf16(a0, a1); pb[i] = cvt_pk_bf16(b0, b1);
                }
                bf16x8 P1[2], P2[2];
#pragma unroll
                for (int s = 0; s < 2; ++s) {
                    const u32x4 wa = {pa[4 * s], pa[4 * s + 1], pa[4 * s + 2], pa[4 * s + 3]}, wb = {pb[4 * s], pb[4 * s + 1], pb[4 * s + 2], pb[4 * s + 3]};
                    P1[s] = *(const bf16x8*)&wa; P2[s] = *(const bf16x8*)&wb;
                }
#pragma unroll
                for (int db = 0; db < 2; ++db)
#pragma unroll
                    for (int s = 0; s < 2; ++s) {
                        O1[db] = __builtin_amdgcn_mfma_f32_32x32x16_bf16(vf[db][s], P1[s], O1[db], 0, 0, 0);
                        O2[db] = __builtin_amdgcn_mfma_f32_32x32x16_bf16(vf[db][s], P2[s], O2[db], 0, 0, 0);
                    }
            }
            if (t + 2 < nkt) asm volatile("s_waitcnt vmcnt(2)" ::: "memory"); else asm volatile("s_waitcnt vmcnt(0)" ::: "memory");
            __builtin_amdgcn_s_barrier();
            bo = bo >= 32768u ? 0u : bo + 16384u;
        }
        }
        l1 += __shfl_xor(l1, 32); l2 += __shfl_xor(l2, 32);
        const float i1 = 1.f / l1, i2 = lam / l2; float ss = 0.f;
#pragma unroll
        for (int db = 0; db < 2; ++db)
#pragma unroll
            for (int i = 0; i < 16; ++i) { const float o = O1[db][i] * i1 - O2[db][i] * i2; O1[db][i] = o; ss += o * o; }
        ss += __shfl_xor(ss, 32);
        const float rs = rsqrtf(ss * (1.f / 64.f) + EPS) * (1.f - lam_init);
        bf16_t* op = WSP(bf16_t, WS_YCAT) + (size_t)orow * DM + 256 + 64 * h + 4 * hh;
        const float* sl = p.subln + l * 64 + 4 * hh;
#pragma unroll
        for (int db = 0; db < 2; ++db)
#pragma unroll
            for (int i = 0; i < 4; ++i) {
                const int d = 32 * db + 8 * i; const f32x4 g = *(const f32x4*)(sl + d);
                u32x2 o; o.x = pk2(O1[db][4 * i] * rs * g.x, O1[db][4 * i + 1] * rs * g.y); o.y = pk2(O1[db][4 * i + 2] * rs * g.z, O1[db][4 * i + 3] * rs * g.w);
                *(u32x2*)(op + d) = o;
            }
    }
    __syncthreads();
}


__device__ __forceinline__ void phase_na_mfma(const Params& p, const int l, LAS unsigned char* lds) {
    const int tid = hid_tid(), wave = __builtin_amdgcn_readfirstlane(tid >> 6), lane = tid & 63, qn = lane & 31, hh = lane >> 5;
    const float* SC = WSP(float, WS_SCAL) + l * 16;
    const int nunits = 256 + (l == 0 ? 32 : 0);
    const int srow = tid >> 3, scq = (tid & 7) ^ ((srow >> 1) & 7);
    const unsigned ldsw = (unsigned)tid * 16u;
    const int rsw = (qn >> 1) & 7;
    LAS float* btab = (LAS float*)(lds + 49152);
    for (int it_ = 0;; ++it_) {
        int u;
        if (gridDim.x == 256) { if (it_ == 0) u = blockIdx.x; else { if (it_ > 1 || nunits <= 256 || blockIdx.x < 224) break; u = 256 + (255 - (int)blockIdx.x); } }
        else { u = blockIdx.x + it_ * (int)gridDim.x; if (u >= nunits) break; }
        const bool cx = u >= 256; const int bh = cx ? u - 256 : (u & 7) * 4 + (u >> 6), rg = (u >> 3) & 7, b = bh >> 2, h = bh & 3;
        __syncthreads();
        for (int i = tid; i < 15 * 32; i += 512) { const int rr = i >> 5, cc = i & 31; btab[i] = cc < 31 ? p.na_rpb[((size_t)(l * 4 + h) * 15 + rr) * 31 + cc] * 1.44269504f : -__builtin_inff(); }
        const int r = 4 * rg + (wave >> 1), qc = 32 * (wave & 1) + qn;
        const int qidx = cx ? 32 * wave + qn : 256 + 64 * r + qc;
        const int orow = cx ? NX + b * LC + 32 * wave + qn : b * SEQ + 64 * r + qc;
        bf16x8 qf[4];
        { const bf16_t* Q = WSP(bf16_t, WS_QA) + ((size_t)bh * KEYS + qidx) * 64;
#pragma unroll
          for (int ks = 0; ks < 4; ++ks) qf[ks] = *(const bf16x8*)(Q + 16 * ks + 8 * hh); }
        int cs = qc - 8; cs = cs < 0 ? 0 : (cs > 48 ? 48 : cs);
        int boff[2][16];
#pragma unroll
        for (int kb = 0; kb < 2; ++kb)
#pragma unroll
            for (int rg2 = 0; rg2 < 16; ++rg2) {
                const int kc = 32 * kb + (rg2 & 3) + 8 * (rg2 >> 2) + 4 * hh;
                int dk = kc - qc; dk = dk < -15 ? -15 : (dk > 15 ? 15 : dk);
                boff[kb][rg2] = ((unsigned)(kc - cs) < 16u) ? 4 * (dk + 15) : 4 * 31;
            }
        int rs = r - 4; rs = rs < 0 ? 0 : (rs > 24 ? 24 : rs);
        int krlo = 4 * rg - 4; krlo = krlo < 0 ? 0 : (krlo > 24 ? 24 : krlo);
        int krhi = 4 * rg - 1; krhi = (krhi < 0 ? 0 : (krhi > 24 ? 24 : krhi)) + 7;
        const int ntile = cx ? 4 : 4 + (krhi - krlo + 1);
        const float negmb = -SC[4 + h];
        f32x16 negm;
#pragma unroll
        for (int i = 0; i < 16; ++i) negm[i] = negmb;
        const char* Kg = (const char*)(WSP(bf16_t, WS_KA) + (size_t)bh * KEYS * 64) + srow * 128 + scq * 16;
        const char* Vg = (const char*)(WSP(bf16_t, WS_VTA) + (size_t)bh * 64 * KEYS) + (size_t)srow * KEYS * 2 + scq * 16;
        f32x16 O[2]; float ls = 0.f;
        for (int trep_ = 0; trep_ < REP_TILE; ++trep_) {
        if (trep_) __syncthreads();
#pragma unroll
        for (int db = 0; db < 2; ++db)
#pragma unroll
            for (int i = 0; i < 16; ++i) O[db][i] = 0.f;
        ls = 0.f;
        __builtin_amdgcn_global_load_lds((const unsigned*)Kg, (LAS unsigned*)(lds + ldsw), 16, 0, 0);
        __builtin_amdgcn_global_load_lds((const unsigned*)Vg, (LAS unsigned*)(lds + 8192 + ldsw), 16, 0, 0);
        __builtin_amdgcn_global_load_lds((const unsigned*)(Kg + (size_t)64 * 128), (LAS unsigned*)(lds + 16384 + ldsw), 16, 0, 0);
        __builtin_amdgcn_global_load_lds((const unsigned*)(Vg + (size_t)64 * 2), (LAS unsigned*)(lds + 16384 + 8192 + ldsw), 16, 0, 0);
        asm volatile("s_waitcnt vmcnt(2)" ::: "memory"); __builtin_amdgcn_s_barrier();
        unsigned bo = 0u;
#pragma unroll 1
        for (int i = 0; i < ntile; ++i) {
            if (i + 2 < ntile) {
                const int tn = (i + 2 < 4) ? i + 2 : 4 + krlo + (i + 2 - 4);
                const unsigned bn = bo == 0u ? 32768u : bo - 16384u;
                __builtin_amdgcn_global_load_lds((const unsigned*)(Kg + (size_t)tn * 64 * 128), (LAS unsigned*)(lds + bn + ldsw), 16, 0, 0);
                __builtin_amdgcn_global_load_lds((const unsigned*)(Vg + (size_t)tn * 64 * 2), (LAS unsigned*)(lds + bn + 8192 + ldsw), 16, 0, 0);
            }
            const int kr = krlo + i - 4;
            const bool local = i >= 4;
            if (!local || (kr >= rs && kr < rs + 8)) {
                const int brow = local ? (kr - r + 7) * 128 : 0;
#pragma unroll
                for (int kb = 0; kb < 2; ++kb) {
                    const LAS unsigned char* kt = lds + bo + (32 * kb + qn) * 128;
                    bf16x8 kf[4];
#pragma unroll
                    for (int ks = 0; ks < 4; ++ks) kf[ks] = *(const LAS bf16x8*)(kt + (((2 * ks + hh) ^ rsw) << 4));
                    f32x16 S = __builtin_amdgcn_mfma_f32_32x32x16_bf16(kf[0], qf[0], negm, 0, 0, 0);
#pragma unroll
                    for (int ks = 1; ks < 4; ++ks) S = __builtin_amdgcn_mfma_f32_32x32x16_bf16(kf[ks], qf[ks], S, 0, 0, 0);
                    bf16x8 vf[2][2];
#pragma unroll
                    for (int db = 0; db < 2; ++db)
#pragma unroll
                        for (int s = 0; s < 2; ++s) vf[db][s] = *(const LAS bf16x8*)(lds + bo + 8192 + (32 * db + qn) * 128 + (((4 * kb + 2 * s + hh) ^ rsw) << 4));
                    if (local) {
#pragma unroll
                        for (int rg2 = 0; rg2 < 16; ++rg2) S[rg2] += *(const LAS float*)((const LAS unsigned char*)btab + brow + boff[kb][rg2]);
                    }
                    unsigned pa[8];
#pragma unroll
                    for (int j = 0; j < 8; ++j) {
                        const float a0 = __builtin_amdgcn_exp2f(S[2 * j]), a1 = __builtin_amdgcn_exp2f(S[2 * j + 1]);
                        ls += a0 + a1; pa[j] = pk2(a0, a1);
                    }
                    bf16x8 P[2];
#pragma unroll
                    for (int s = 0; s < 2; ++s) { const u32x4 wa = {pa[4 * s], pa[4 * s + 1], pa[4 * s + 2], pa[4 * s + 3]}; P[s] = *(const bf16x8*)&wa; }
#pragma unroll
                    for (int db = 0; db < 2; ++db)
#pragma unroll
                        for (int s = 0; s < 2; ++s) O[db] = __builtin_amdgcn_mfma_f32_32x32x16_bf16(vf[db][s], P[s], O[db], 0, 0, 0);
                }
            }
            if (i + 2 < ntile) asm volatile("s_waitcnt vmcnt(2)" ::: "memory"); else asm volatile("s_waitcnt vmcnt(0)" ::: "memory");
            __builtin_amdgcn_s_barrier();
            bo = bo >= 32768u ? 0u : bo + 16384u;
        }
        }
        ls += __shfl_xor(ls, 32);
        const float il = 1.f / ls;
        bf16_t* op = WSP(bf16_t, WS_YCAT) + (size_t)orow * DM + 64 * h + 4 * hh;
#pragma unroll
        for (int db = 0; db < 2; ++db)
#pragma unroll
            for (int i = 0; i < 4; ++i) {
                u32x2 o; o.x = pk2(O[db][4 * i] * il, O[db][4 * i + 1] * il); o.y = pk2(O[db][4 * i + 2] * il, O[db][4 * i + 3] * il);
                *(u32x2*)(op + 32 * db + 8 * i) = o;
            }
    }
    __syncthreads();
}

constexpr int RB = 72;
constexpr int HSTR = 2064;
__device__ __forceinline__ void phase_route(const Params& p, const int l, unsigned char* smem, const int cnt_off) {
    unsigned char* HN = smem;
    float* LOGIT = (float*)(smem + RB * HSTR);
    int* hist = (int*)(smem + RB * HSTR + RB * 32 * 4); int* base = hist + 32; int* s_e = base + 32; int* s_lp = s_e + RB * 4; float* s_g = (float*)(s_lp + RB * 4);
    const int tid = hid_tid(), lane = tid & 63, wave = tid >> 6, fr = lane & 15, fq = lane >> 4;
    const int nrows = (l == 0) ? NT : NX;
    const float* MOD = WSP(float, WS_MOD); unsigned char* H8 = WSP(unsigned char, WS_H8); const bf16_t* X1 = WSP(bf16_t, WS_X1);
    const bf16_t* RWT = WSP(bf16_t, WS_RWT) + (size_t)l * 32 * 1024;
    int* cnt = WSP(int, WS_CTL + CTL_CNT + cnt_off) + l * 32;
    int *RTE = WSP(int, WS_RTE), *RTP = WSP(int, WS_RTP), *LIST = WSP(int, WS_LIST); float* RTG = WSP(float, WS_RTG);
    const float rb0 = p.router_b[l * 32 + fr], rb1 = p.router_b[l * 32 + 16 + fr];
    for (int r0 = blockIdx.x * RB; r0 < nrows; r0 += gridDim.x * RB) {
        __syncthreads();
        if (tid < 32) hist[tid] = 0;
        const int nr = (nrows - r0) < RB ? (nrows - r0) : RB;
        u32x2 vn[4];
        if (wave < nr) {
#pragma unroll
            for (int j = 0; j < 4; ++j) vn[j] = ((const u32x2*)(X1 + (size_t)(r0 + wave) * DM))[lane + 64 * j];
        }
        int cmi = -1; f32x4 mA[4], mB[4];
        for (int i = wave; i < nr; i += 8) {
            const int r = r0 + i;
            if (mod_index(r) != cmi) {
                cmi = mod_index(r);
                const float* m = MOD + (size_t)(l * 9 + cmi) * 6144; const float* gw = p.g2w + l * 1024;
#pragma unroll
                for (int j = 0; j < 4; ++j) { const int c = 4 * lane + 256 * j; const f32x4 g = *(const f32x4*)(gw + c), s1 = *(const f32x4*)(m + 4 * 1024 + c);
                    mA[j].x = g.x * (1.f + s1.x); mA[j].y = g.y * (1.f + s1.y); mA[j].z = g.z * (1.f + s1.z); mA[j].w = g.w * (1.f + s1.w); mB[j] = *(const f32x4*)(m + 3 * 1024 + c); }
            }
            f32x4 v[4]; float ss = 0.f;
#pragma unroll
            for (int j = 0; j < 4; ++j) { v[j] = (f32x4){bflo(vn[j].x), bfhi(vn[j].x), bflo(vn[j].y), bfhi(vn[j].y)}; ss += v[j].x * v[j].x + v[j].y * v[j].y + v[j].z * v[j].z + v[j].w * v[j].w; }
            if (i + 8 < nr) {
#pragma unroll
                for (int j = 0; j < 4; ++j) vn[j] = ((const u32x2*)(X1 + (size_t)(r + 8) * DM))[lane + 64 * j];
            }
            ss = wave_sum_fast(ss);
            const float rs = rsqrtf(ss * (1.f / DM) + EPS);
#pragma unroll
            for (int j = 0; j < 4; ++j) {
                const int c = 4 * lane + 256 * j;
                f32x4 o;
                o.x = v[j].x * rs * mA[j].x + mB[j].x; o.y = v[j].y * rs * mA[j].y + mB[j].y;
                o.z = v[j].z * rs * mA[j].z + mB[j].z; o.w = v[j].w * rs * mA[j].w + mB[j].w;
                *(unsigned*)(H8 + (size_t)r * DM + c) = pk4_fp8(fminf(fmaxf(o.x * SH8, -448.f), 448.f), fminf(fmaxf(o.y * SH8, -448.f), 448.f), fminf(fmaxf(o.z * SH8, -448.f), 448.f), fminf(fmaxf(o.w * SH8, -448.f), 448.f));
                u32x2 hb; hb.x = pk2(o.x, o.y); hb.y = pk2(o.z, o.w);
                *(u32x2*)(HN + i * HSTR + c * 2) = hb;
            }
        }
        __syncthreads();
        if (wave < 5 && 16 * wave < nr) {
            f32x4 a0 = {0.f, 0.f, 0.f, 0.f}, a1 = {0.f, 0.f, 0.f, 0.f};
            const unsigned char* arow = HN + (16 * wave + fr) * HSTR + fq * 16;
            const bf16_t* b0p = RWT + (size_t)fr * 1024 + fq * 8; const bf16_t* b1p = b0p + 16 * 1024;
#pragma unroll 8
            for (int ks = 0; ks < 32; ++ks) {
                const bf16x8 a = *(const bf16x8*)(arow + ks * 64);
                const bf16x8 b0 = *(const bf16x8*)(b0p + ks * 32), b1 = *(const bf16x8*)(b1p + ks * 32);
                a0 = __builtin_amdgcn_mfma_f32_16x16x32_bf16(a, b0, a0, 0, 0, 0);
                a1 = __builtin_amdgcn_mfma_f32_16x16x32_bf16(a, b1, a1, 0, 0, 0);
            }
#pragma unroll
            for (int q = 0; q < 4; ++q) { const int row = 16 * wave + 4 * fq + q; if (row < nr) { LOGIT[row * 32 + fr] = a0[q] + rb0; LOGIT[row * 32 + 16 + fr] = a1[q] + rb1; } }
        }
        __syncthreads();
        for (int i = wave; i < nr; i += 8) {
            const float logit = LOGIT[i * 32 + (lane & 31)];
            float tv[4]; int ti[4];
            {
                const int me = lane & 31; int rank = 0;
#pragma unroll
                for (int e = 0; e < 32; ++e) { const float ov = __builtin_bit_cast(float, __builtin_amdgcn_readlane(__builtin_bit_cast(int, logit), e)); rank += ((ov > logit) || (ov == logit && e < me)) ? 1 : 0; }
#pragma unroll
                for (int k = 0; k < 4; ++k) {
                    const unsigned long long mk = __ballot(rank == k);
                    const int srcl = __builtin_amdgcn_readfirstlane((int)__builtin_ctzll(mk));
                    ti[k] = srcl & 31; tv[k] = __builtin_bit_cast(float, __builtin_amdgcn_readlane(__builtin_bit_cast(int, logit), srcl));
                }
            }
            const float e1 = __expf(tv[1] - tv[0]), e2 = __expf(tv[2] - tv[0]), e3 = __expf(tv[3] - tv[0]); const float inv = 1.f / (1.f + e1 + e2 + e3);
            if (lane < 4) {
                const int te = lane == 0 ? ti[0] : lane == 1 ? ti[1] : lane == 2 ? ti[2] : ti[3];
                const float tg = (lane == 0 ? 1.f : lane == 1 ? e1 : lane == 2 ? e2 : e3) * inv;
                s_e[i * 4 + lane] = te; s_g[i * 4 + lane] = tg; s_lp[i * 4 + lane] = atomicAdd(&hist[te], 1);
            }
        }
        __syncthreads();
        if (tid < 32) base[tid] = hist[tid] ? atomicAdd(&cnt[tid], hist[tid]) : 0;
        __syncthreads();
        for (int i = tid; i < nr * 4; i += 512) {
            const int r = r0 + (i >> 2), e = s_e[i], pos = base[e] + s_lp[i];
            RTE[(size_t)r * 4 + (i & 3)] = e; RTP[(size_t)r * 4 + (i & 3)] = pos; RTG[(size_t)r * 4 + (i & 3)] = s_g[i];
            LIST[(size_t)e * NT + pos] = r;
        }
    }
    __syncthreads();
}

__device__ __forceinline__ void phase_combine(const Params& p, const int l, const int* tinfo) {
    const int tid = hid_tid(), lane = tid & 63, wave = tid >> 6;
    const int gw = blockIdx.x * 8 + wave, ngw = gridDim.x * 8;
    const int nrows = (l == 0) ? NT : NX;
    const float* MOD = WSP(float, WS_MOD); const bf16_t* X1 = WSP(bf16_t, WS_X1); const unsigned char* Y2 = WSP(unsigned char, WS_Y2);
    const int *RTE = WSP(int, WS_RTE), *RTP = WSP(int, WS_RTP); const float* RTG = WSP(float, WS_RTG);
    int ne[4], np_[4]; float ng[4];
    if (gw < nrows) {
#pragma unroll
        for (int k = 0; k < 4; ++k) { ne[k] = RTE[(size_t)gw * 4 + k]; np_[k] = RTP[(size_t)gw * 4 + k]; ng[k] = RTG[(size_t)gw * 4 + k]; }
    }
    int cmi = -1; f32x4 g2v[4], nA[4], nB[4];
    for (int r = gw; r < nrows; r += ngw) {
        if (mod_index(r) != cmi) {
            cmi = mod_index(r);
            const float* g2 = MOD + (size_t)(l * 9 + cmi) * 6144 + 5 * 1024; const float* m = MOD + (size_t)(1 * 9 + cmi) * 6144;
#pragma unroll
            for (int j = 0; j < 4; ++j) { const int c = 4 * lane + 256 * j; g2v[j] = *(const f32x4*)(g2 + c);
                if (l == 0) { const f32x4 g = *(const f32x4*)(p.g1w + 1024 + c), s1 = *(const f32x4*)(m + 1024 + c);
                    nA[j].x = g.x * (1.f + s1.x); nA[j].y = g.y * (1.f + s1.y); nA[j].z = g.z * (1.f + s1.z); nA[j].w = g.w * (1.f + s1.w); nB[j] = *(const f32x4*)(m + c); } }
        }
        const unsigned char* yr[4]; float gk[4];
#pragma unroll
        for (int k = 0; k < 4; ++k) { yr[k] = Y2 + ((size_t)tinfo[ne[k]] * 256 + np_[k]) * DM; gk[k] = ng[k] * (1.f / SY8); }
        unsigned yv[4][4]; u32x2 x1v[4]; f32x4 gv[4];
#pragma unroll
        for (int j = 0; j < 4; ++j) {
            const int c = 4 * lane + 256 * j;
#pragma unroll
            for (int k = 0; k < 4; ++k) yv[j][k] = *(const unsigned*)(yr[k] + c);
            x1v[j] = *(const u32x2*)(X1 + (size_t)r * DM + c); gv[j] = g2v[j];
        }
        if (r + ngw < nrows) {
#pragma unroll
            for (int k = 0; k < 4; ++k) { ne[k] = RTE[(size_t)(r + ngw) * 4 + k]; np_[k] = RTP[(size_t)(r + ngw) * 4 + k]; ng[k] = RTG[(size_t)(r + ngw) * 4 + k]; }
        }
        f32x4 xv[4];
#pragma unroll
        for (int j = 0; j < 4; ++j) {
            const int c = 4 * lane + 256 * j;
            float s[4] = {0.f, 0.f, 0.f, 0.f};
#pragma unroll
            for (int k = 0; k < 4; ++k) { const f32x2 ya = __builtin_amdgcn_cvt_pk_f32_fp8((int)yv[j][k], false), yb = __builtin_amdgcn_cvt_pk_f32_fp8((int)yv[j][k], true); s[0] += gk[k] * ya.x; s[1] += gk[k] * ya.y; s[2] += gk[k] * yb.x; s[3] += gk[k] * yb.y; }
            const f32x4 x1 = {bflo(x1v[j].x), bfhi(x1v[j].x), bflo(x1v[j].y), bfhi(x1v[j].y)}, g = gv[j];
            f32x4 o; o.x = x1.x + g.x * s[0]; o.y = x1.y + g.y * s[1]; o.z = x1.z + g.z * s[2]; o.w = x1.w + g.w * s[3];
            if (l == 0) { u32x2 ob; ob.x = pk2(o.x, o.y); ob.y = pk2(o.z, o.w); *(u32x2*)(WSP(bf16_t, WS_X2) + (size_t)r * DM + c) = ob; }
            else *(f32x4*)(p.out + (size_t)r * DM + c) = o;
            xv[j] = o;
        }
        if (l == 0) {
            float ss = 0.f;
#pragma unroll
            for (int j = 0; j < 4; ++j) ss += xv[j].x * xv[j].x + xv[j].y * xv[j].y + xv[j].z * xv[j].z + xv[j].w * xv[j].w;
            ss = wave_sum_fast(ss); const float rs = rsqrtf(ss * (1.f / DM) + EPS);
            bf16_t* hrow = WSP(bf16_t, WS_H) + (size_t)r * DM;
#pragma unroll
            for (int j = 0; j < 4; ++j) {
                const int c = 4 * lane + 256 * j;
                u32x2 pk; pk.x = pk2(xv[j].x * rs * nA[j].x + nB[j].x, xv[j].y * rs * nA[j].y + nB[j].y);
                pk.y = pk2(xv[j].z * rs * nA[j].z + nB[j].z, xv[j].w * rs * nA[j].w + nB[j].w);
                *(u32x2*)(hrow + c) = pk;
            }
        }
    }
}

#define XB_TMO      128
#define XB_XCNT(j)  (256  + 64 * (j))
#define XB_XSUB(j)  (1280 + 64 * (j))
#define XB_XGEN(j)  (2304 + 64 * (j))
#define XB_TOP      3328
#define XB_TOPGEN   3392
#define XCD_BAR_WORDS 3456
#define XB_SPIN_CAP (1u << 18)
__device__ __forceinline__ unsigned xb_ld(unsigned* p)              { return __hip_atomic_load(p, __ATOMIC_RELAXED, __HIP_MEMORY_SCOPE_AGENT); }
__device__ __forceinline__ unsigned xb_add(unsigned* p, unsigned v) { return __hip_atomic_fetch_add(p, v, __ATOMIC_RELAXED, __HIP_MEMORY_SCOPE_AGENT); }
__device__ __forceinline__ unsigned xb_xcc_id() { return (unsigned)__builtin_amdgcn_s_getreg((3 << 11) | 20) & 0xFu; }
#define XB_SPIN(cond, bar) do { unsigned _sp = 0; while (cond) { __builtin_amdgcn_s_sleep(1); \
    if ((++_sp & 255u) == 0u) { if (xb_ld(&(bar)[XB_TMO])) break; if (_sp > XB_SPIN_CAP) { atomicAdd(&(bar)[XB_TMO], 1u); break; } } } } while (0)
struct XcdBarrier { unsigned* bar; unsigned x; volatile LAS unsigned* st; };
__device__ __forceinline__ XcdBarrier xcd_barrier_post(unsigned* bar, volatile LAS unsigned* st) {
    XcdBarrier b; b.bar = bar; b.x = xb_xcc_id(); b.st = st;
    if (threadIdx.x == 0) (void)xb_add(&bar[XB_XCNT(b.x)], 1u);
    return b;
}
__device__ __forceinline__ void xcd_barrier_complete(unsigned* bar, unsigned x, unsigned& nloc, unsigned& nx) {
    const unsigned G = gridDim.x * gridDim.y * gridDim.z;
    unsigned sum, cnt, mine, sp = 0u;
    for (;;) {
        sum = 0u; cnt = 0u; mine = 0u;
#pragma unroll
        for (unsigned j = 0; j < 16; ++j) { const unsigned c = xb_ld(&bar[XB_XCNT(j)]); sum += c; cnt += (c > 0u) ? 1u : 0u; mine = (j == x) ? c : mine; }
        if (sum == G) break;
        __builtin_amdgcn_s_sleep(1);
        if ((++sp & 255u) == 0u) { if (xb_ld(&bar[XB_TMO])) break; if (sp > XB_SPIN_CAP) { atomicAdd(&bar[XB_TMO], 1u); break; } }
    }
    nloc = mine > 0u ? mine : 1u; nx = cnt > 0u ? cnt : 1u;
}
__device__ __forceinline__ void xcd_barrier(const XcdBarrier& b) {
    asm volatile("s_waitcnt vmcnt(0)" ::: "memory");
    __syncthreads();
    if (threadIdx.x == 0) {
        unsigned* bar = b.bar;
        __builtin_amdgcn_s_waitcnt(0);
        unsigned nloc = b.st[0], nx = b.st[1];
        if (nloc == 0u) { xcd_barrier_complete(bar, b.x, nloc, nx); b.st[0] = nloc; b.st[1] = nx; }
        const unsigned old = xb_add(&bar[XB_XSUB(b.x)], 1u);
        const unsigned gen = old / nloc;
        if (old + 1u == (gen + 1u) * nloc) {
            __builtin_amdgcn_fence(__ATOMIC_RELEASE, "agent");
            asm volatile("s_waitcnt vmcnt(0)" ::: "memory");
            const unsigned og = xb_add(&bar[XB_TOP], 1u);
            const unsigned tg = og / nx;
            if (og + 1u == (tg + 1u) * nx) xb_add(&bar[XB_TOPGEN], 1u);
            else XB_SPIN(xb_ld(&bar[XB_TOPGEN]) == tg, bar);
            __builtin_amdgcn_fence(__ATOMIC_ACQUIRE, "agent");
            xb_add(&bar[XB_XGEN(b.x)], 1u);
            asm volatile("s_waitcnt vmcnt(0)" ::: "memory");
        } else {
            XB_SPIN(xb_ld(&bar[XB_XGEN(b.x)]) == gen, bar);
            __builtin_amdgcn_fence(__ATOMIC_ACQUIRE, "agent");
            asm volatile("s_waitcnt vmcnt(0)" ::: "memory");
        }
    }
    __syncthreads();
}

constexpr int LDS_BYTES = 163840;
constexpr int MISC_OFF = LDS_BYTES - 2048;
constexpr int NCH_L = 3072;
constexpr size_t CTL_CHUNK = 40960, CTL_DONE = 41472;
__device__ __forceinline__ void conv_item(const Params& p, unsigned char* smem, int l, int q, int wave, int lane) {
    unsigned char* tsm = smem + wave * (64 * 144);
    if (q < 16384) { const int m = l * 32 + (q >> 9), r = q & 511; transpose_item8(p.w1 + (size_t)m * 1024 * 2048, 2048, 1024, WSP(unsigned char, WS_W1) + (size_t)m * 2048 * 1024, tsm, r & 15, r >> 4, lane); }
    else { const int q2 = q - 16384, m = l * 32 + (q2 >> 8), r = q2 & 255; transpose_item8(p.w2 + (size_t)m * 1024 * 1024, 1024, 1024, WSP(unsigned char, WS_W2) + (size_t)m * 1024 * 1024, tsm, r & 15, r >> 4, lane); }
}
__device__ __forceinline__ void idle_fill(const Params& p, unsigned char* smem, const int phase, const int l) {
    const int tid = hid_tid(), lane = tid & 63, wave = tid >> 6;
    volatile int* cslot = (volatile int*)(smem + MISC_OFF + 512);
    unsigned* chunk = WSP(unsigned, WS_CTL + CTL_CHUNK + 256 * l); unsigned* done = WSP(unsigned, WS_CTL + CTL_DONE + 256 * phase);
    __syncthreads();
    if (tid == 0) {
        __hip_atomic_fetch_add(done, 1u, __ATOMIC_RELAXED, __HIP_MEMORY_SCOPE_AGENT);
        int c = -1;
        if (__hip_atomic_load(done, __ATOMIC_RELAXED, __HIP_MEMORY_SCOPE_AGENT) < gridDim.x) { const unsigned g = __hip_atomic_fetch_add(chunk, 1u, __ATOMIC_RELAXED, __HIP_MEMORY_SCOPE_AGENT); if (g < (unsigned)NCH_L) c = (int)g; }
        cslot[0] = c;
    }
    __syncthreads();
    int c = cslot[0];
    while (c >= 0) {
        __syncthreads();
        unsigned gnext = 0xffffffffu; bool more = false;
        if (tid == 0) { more = __hip_atomic_load(done, __ATOMIC_RELAXED, __HIP_MEMORY_SCOPE_AGENT) < gridDim.x; if (more) gnext = __hip_atomic_fetch_add(chunk, 1u, __ATOMIC_RELAXED, __HIP_MEMORY_SCOPE_AGENT); }
        conv_item(p, smem, l, c * 8 + wave, wave, lane);
        if (tid == 0) cslot[0] = (more && gnext < (unsigned)NCH_L) ? (int)gnext : -1;
        __syncthreads();
        c = cslot[0];
    }
}
__device__ __forceinline__ void conv_drain(const Params& p, unsigned char* smem, const int l) {
    const int tid = hid_tid(), lane = tid & 63, wave = tid >> 6;
    const int gw = blockIdx.x * 8 + wave, ngw = gridDim.x * 8;
    unsigned cst = __hip_atomic_load(WSP(unsigned, WS_CTL + CTL_CHUNK + 256 * l), __ATOMIC_RELAXED, __HIP_MEMORY_SCOPE_AGENT);
    cst = cst > (unsigned)NCH_L ? (unsigned)NCH_L : cst;
    __syncthreads();
    for (int q = (int)cst * 8 + gw; q < NCH_L * 8; q += ngw) conv_item(p, smem, l, q, wave, lane);
    __syncthreads();
}

__global__ void __launch_bounds__(512, 2) k_fwd(Params p) {
    extern __shared__ __attribute__((aligned(16))) unsigned char smem[];
    int* tinfo = (int*)(smem + MISC_OFF + 64);
    if (threadIdx.x < 4) ((unsigned*)(smem + MISC_OFF))[threadIdx.x] = 0u;
    __syncthreads();
    XcdBarrier bar = xcd_barrier_post(WSP(unsigned, WS_CTL), (volatile LAS unsigned*)(smem + MISC_OFF));
    phase_pro0(p, smem);
    __syncthreads();
    REPEAT(REP_PRO1, phase_pro1(p, smem); __syncthreads());
    xcd_barrier(bar);
#define LAYER(l) do { \
        REPEAT(REP_WIN, gemm_phase256<G_WIN>(p, l, (LAS unsigned char*)smem, tinfo)); \
        REPEAT(REP_BAR, xcd_barrier(bar)); \
        REPEAT(REP_PREP, phase_prep(p, l, smem); __syncthreads()); \
        REPEAT(REP_BAR, xcd_barrier(bar)); \
          \
        REPEAT(REP_DFT, gemm_phase256<G_DFT>(p, l, (LAS unsigned char*)smem, tinfo)); \
        if (l == 0) gemm_phase256<G_DFTC>(p, l, (LAS unsigned char*)smem, tinfo); \
        __syncthreads(); \
        REPEAT(REP_DF, phase_df_mfma(p, l, (LAS unsigned char*)smem)); \
        REPEAT(REP_NA, phase_na_mfma(p, l, (LAS unsigned char*)smem)); \
        idle_fill(p, smem, 3 + 8 * l, l); \
        REPEAT(REP_BAR, xcd_barrier(bar)); \
        REPEAT(REP_WOUT, gemm_phase256<G_WOUT>(p, l, (LAS unsigned char*)smem, tinfo)); \
        if (l == 0) idle_fill(p, smem, 4 + 8 * l, l); \
        REPEAT(REP_BAR, xcd_barrier(bar)); \
        if (REP_ROUTE > 1) { phase_route(p, l, smem, 1024); __syncthreads(); } \
        phase_route(p, l, smem, 0); \
        conv_drain(p, smem, l); \
        REPEAT(REP_BAR, xcd_barrier(bar)); \
        moe_tinfo(p, l, tinfo); \
        REPEAT(REP_MOE1, gemm_phase256<G_MOE1>(p, l, (LAS unsigned char*)smem, tinfo)); \
        REPEAT(REP_BAR, xcd_barrier(bar)); \
        REPEAT(REP_MOE2, gemm_phase256<G_MOE2>(p, l, (LAS unsigned char*)smem, tinfo)); \
        REPEAT(REP_BAR, xcd_barrier(bar)); \
        REPEAT(REP_COMB, phase_combine(p, l, tinfo)); \
        if (l == 0) xcd_barrier(bar); \
    } while (0)
    LAYER(0);
    LAYER(1);
#undef LAYER
}

extern "C" void kernel_launch(void* const* d_in, const int* in_sizes, int n_in, void* d_out, int out_size, void* d_ws, size_t ws_size, hipStream_t stream) {
    static int grid = 0;
    if (n_in != 29 || ws_size < WS_END) { fprintf(stderr, "kernel_launch: need 29 inputs and %zu bytes of workspace (got %d, %zu)\n", (size_t)WS_END, n_in, ws_size); return; }
    if (!grid) {
        int dev = 0, cus = 0, per_cu = 0;
        (void)hipGetDevice(&dev);
        (void)hipDeviceGetAttribute(&cus, hipDeviceAttributeMultiprocessorCount, dev);
        (void)hipFuncSetAttribute((const void*)k_fwd, hipFuncAttributeMaxDynamicSharedMemorySize, LDS_BYTES);
        (void)hipOccupancyMaxActiveBlocksPerMultiprocessor(&per_cu, (const void*)k_fwd, 512, LDS_BYTES);
        if (per_cu < 1) fprintf(stderr, "kernel_launch: occupancy query reports %d workgroups per CU\n", per_cu);
        grid = cus > 0 ? cus : 256;
    }
    Params p;
    const float** pp = (const float**)&p;
    for (int i = 0; i < 29; ++i) pp[i] = (const float*)d_in[i];
    p.out = (float*)d_out; p.ws = (unsigned char*)d_ws;
    (void)hipMemsetAsync((char*)d_ws + WS_CTL, 0, CTL_BYTES, stream);
    hipLaunchKernelGGL(k_fwd, dim3(grid), dim3(512), LDS_BYTES, stream, p);
}
```

```cpp
#include <hip/hip_runtime.h>
#include <cstdio>
#include <cstdint>

#define REP_PRO0 1
#define REP_TILE 1
#define REP_EPI 1
#define REP_KL8 1
#define REP_KL16 1
#define REP_ROUTE 1
#define REP_BAR 1
#define REP_PRO1 1
#define REP_TR 1
#define REP_FOLD 1
#define REP_WIN 1
#define REP_PREP 1
#define REP_DF 1
#define REP_NA 1
#define REP_DFT 1
#define REP_WOUT 1
#define REP_MOE1 1
#define REP_MOE2 1
#define REP_COMB 1
#define REPEAT(n, stmt) do { _Pragma("unroll") for (int _r = 0; _r < (n); ++_r) { stmt; } } while (0)
typedef unsigned short bf16_t;
typedef short bf16x8 __attribute__((ext_vector_type(8)));
typedef float f32x4 __attribute__((ext_vector_type(4)));
typedef float f32x16 __attribute__((ext_vector_type(16)));
typedef float f32x2 __attribute__((ext_vector_type(2)));
typedef unsigned u32x4 __attribute__((ext_vector_type(4)));
typedef unsigned u32x2 __attribute__((ext_vector_type(2)));
typedef int i32x8 __attribute__((ext_vector_type(8)));
constexpr float SW8 = 64.f, SH8 = 16.f, SA8 = 4.f, SY8 = 16.f;

constexpr int NB = 8, SEQ = 2048, DM = 1024, LC = 256;
constexpr int NX = NB * SEQ, NC = NB * LC, NT = NX + NC;
constexpr int NIN = 2304;
constexpr int NE = 32, FF = 1024, KEYS = LC + SEQ;
constexpr int MAXSLOT = 81920;
constexpr float EPS = 1e-6f;

constexpr size_t al256(size_t x) { return (x + 255) & ~(size_t)255; }
constexpr size_t WS_CTL   = 0;
constexpr size_t CTL_BYTES = 65536;
constexpr size_t CTL_CNT  = 32768;
constexpr size_t CTL_PRO0 = 49152;
constexpr size_t WS_MOD   = WS_CTL + CTL_BYTES;
constexpr size_t WS_SCAL  = al256(WS_MOD + (size_t)2 * 9 * 6144 * 4);
constexpr size_t WS_ROPE  = al256(WS_SCAL + 2 * 16 * 4);
constexpr size_t WS_WIN   = al256(WS_ROPE + 64 * 8 * 2 * 4);
constexpr size_t WS_WOUT  = al256(WS_WIN + (size_t)2 * NIN * DM * 2);
constexpr size_t WS_W1    = al256(WS_WOUT + (size_t)2 * DM * DM * 2);
constexpr size_t WS_W2    = al256(WS_W1 + (size_t)2 * NE * 2048 * DM * 2);
constexpr size_t WS_DFTM  = al256(WS_W2 + (size_t)2 * NE * DM * FF * 2);
constexpr size_t WS_DFTC  = al256(WS_DFTM + (size_t)2048 * 2048 * 2);
constexpr size_t WS_H     = al256(WS_DFTC + (size_t)256 * 256 * 2);
constexpr size_t WS_PX    = al256(WS_H + (size_t)NT * DM * 2);
constexpr size_t QKV_ONE  = (size_t)NB * 4 * KEYS * 64 * 2;
constexpr size_t WS_QA    = al256(WS_PX + (size_t)NT * NIN * 2);
constexpr size_t WS_KA    = al256(WS_QA + QKV_ONE);
constexpr size_t WS_VTA   = al256(WS_KA + QKV_ONE);
constexpr size_t WS_QD    = al256(WS_VTA + QKV_ONE);
constexpr size_t WS_KD    = al256(WS_QD + QKV_ONE);
constexpr size_t WS_VTD   = al256(WS_KD + QKV_ONE);
constexpr size_t WS_XF    = al256(WS_VTD + QKV_ONE);
constexpr size_t WS_XFC   = al256(WS_XF + (size_t)2048 * 2048 * 2);
constexpr size_t WS_YCAT  = al256(WS_XFC + (size_t)2048 * 256 * 2);
constexpr size_t WS_X1    = al256(WS_YCAT + (size_t)NT * DM * 2);
constexpr size_t WS_X2    = al256(WS_X1 + (size_t)NT * DM * 4);
constexpr size_t WS_RTE   = al256(WS_X2 + (size_t)NT * DM * 4);
constexpr size_t WS_RTP   = al256(WS_RTE + (size_t)NT * 4 * 4);
constexpr size_t WS_RTG   = al256(WS_RTP + (size_t)NT * 4 * 4);
constexpr size_t WS_LIST  = al256(WS_RTG + (size_t)NT * 4 * 4);
constexpr size_t WS_ACT   = al256(WS_LIST + (size_t)NE * NT * 4);
constexpr size_t WS_Y2    = al256(WS_ACT + (size_t)MAXSLOT * FF * 2);
constexpr size_t WS_H8    = al256(WS_Y2 + (size_t)MAXSLOT * DM * 2);
constexpr size_t WS_RWT   = al256(WS_H8 + (size_t)NT * DM);
constexpr size_t WS_END   = al256(WS_RWT + (size_t)2 * NE * DM * 2);

struct Params {
    const float *x, *c, *ctx, *c_ctx, *w_ada, *b_ada, *g1w, *g2w, *w_in, *w_out, *na_qg, *na_kg, *na_rpb, *df_qg, *df_kg,
                *lq1, *lk1, *lq2, *lk2, *subln, *pool_w, *pool_scale, *fft_w, *router_w, *router_b, *w1, *b1, *w2, *b2;
    float* out;
    unsigned char* ws;
};
typedef __attribute__((address_space(1))) unsigned char g_u8;
__device__ __forceinline__ unsigned char* ws_base(unsigned char* w) { g_u8* g = (g_u8*)w; asm volatile("" : "+s"(g)); return (unsigned char*)g; }
#define WSP(T, off) ((T*)(ws_base(p.ws) + (off)))

__device__ __forceinline__ unsigned pk2(float lo, float hi) {
    typedef __bf16 bf2 __attribute__((ext_vector_type(2)));
    bf2 r = __builtin_convertvector((f32x2){lo, hi}, bf2);
    return *(unsigned*)&r;
}
__device__ __forceinline__ unsigned pk4_fp8(float a, float b, float c, float d) { int r = 0; r = __builtin_amdgcn_cvt_pk_fp8_f32(a, b, r, false); r = __builtin_amdgcn_cvt_pk_fp8_f32(c, d, r, true); return (unsigned)r; }
__device__ __forceinline__ bf16_t f2bf(float f) { return (bf16_t)(pk2(f, 0.f) & 0xffffu); }
__device__ __forceinline__ float bflo(unsigned u) { return __uint_as_float(u << 16); }
__device__ __forceinline__ float bfhi(unsigned u) { return __uint_as_float(u & 0xffff0000u); }
__device__ __forceinline__ float bf2f(bf16_t b) { return __uint_as_float(((unsigned)b) << 16); }
__device__ __forceinline__ float wave_sum(float v) {
#pragma unroll
    for (int o = 1; o < 64; o <<= 1) v += __shfl_xor(v, o);
    return v;
}
#define DPP_F(v, ctrl) __builtin_bit_cast(float, __builtin_amdgcn_update_dpp(0, __builtin_bit_cast(int, (v)), (ctrl), 0xf, 0xf, true))
__device__ __forceinline__ float sum8_dpp(float v)  { v += DPP_F(v, 0xB1); v += DPP_F(v, 0x4E); v += DPP_F(v, 0x141); return v; }
__device__ __forceinline__ float sum16_dpp(float v) { v += DPP_F(v, 0xB1); v += DPP_F(v, 0x4E); v += DPP_F(v, 0x141); v += DPP_F(v, 0x140); return v; }
__device__ __forceinline__ float wave_sum_fast(float v) {
    v += __builtin_bit_cast(float, __builtin_amdgcn_update_dpp(0, __builtin_bit_cast(int, v), 0xB1, 0xf, 0xf, true));
    v += __builtin_bit_cast(float, __builtin_amdgcn_update_dpp(0, __builtin_bit_cast(int, v), 0x4E, 0xf, 0xf, true));
    v += __builtin_bit_cast(float, __builtin_amdgcn_update_dpp(0, __builtin_bit_cast(int, v), 0x141, 0xf, 0xf, true));
    v += __builtin_bit_cast(float, __builtin_amdgcn_update_dpp(0, __builtin_bit_cast(int, v), 0x140, 0xf, 0xf, true));
    const float a = __builtin_bit_cast(float, __builtin_amdgcn_readlane(__builtin_bit_cast(int, v), 0)), b = __builtin_bit_cast(float, __builtin_amdgcn_readlane(__builtin_bit_cast(int, v), 16));
    const float c = __builtin_bit_cast(float, __builtin_amdgcn_readlane(__builtin_bit_cast(int, v), 32)), d = __builtin_bit_cast(float, __builtin_amdgcn_readlane(__builtin_bit_cast(int, v), 48));
    return (a + b) + (c + d);
}
__device__ __forceinline__ float wave_max(float v) {
#pragma unroll
    for (int o = 1; o < 64; o <<= 1) v = fmaxf(v, __shfl_xor(v, o));
    return v;
}
__device__ __forceinline__ int hid_tid() { int t = threadIdx.x; asm volatile("" : "+v"(t)); return t; }
__device__ __forceinline__ void unpack4(u32x2 r, float (&v)[4]) { v[0] = bflo(r.x); v[1] = bfhi(r.x); v[2] = bflo(r.y); v[3] = bfhi(r.y); }

__device__ __forceinline__ void mod_row(const float* xrow, const float* gw, const float* sh, const float* sc, bf16_t* orow, int lane, f32x4 (&hv)[4]) {
    f32x4 v[4]; float ss = 0.f;
#pragma unroll
    for (int j = 0; j < 4; ++j) { v[j] = ((const f32x4*)xrow)[lane + 64 * j]; ss += v[j].x * v[j].x + v[j].y * v[j].y + v[j].z * v[j].z + v[j].w * v[j].w; }
    ss = wave_sum_fast(ss);
    const float rs = rsqrtf(ss * (1.f / DM) + EPS);
#pragma unroll
    for (int j = 0; j < 4; ++j) {
        const int c = 4 * lane + 256 * j;
        const f32x4 g = *(const f32x4*)(gw + c), s1 = *(const f32x4*)(sc + c), s0 = *(const f32x4*)(sh + c);
        f32x4 o;
        o.x = v[j].x * rs * g.x * (1.f + s1.x) + s0.x; o.y = v[j].y * rs * g.y * (1.f + s1.y) + s0.y;
        o.z = v[j].z * rs * g.z * (1.f + s1.z) + s0.z; o.w = v[j].w * rs * g.w * (1.f + s1.w) + s0.w;
        hv[j] = o;
        u32x2 pk; pk.x = pk2(o.x, o.y); pk.y = pk2(o.z, o.w);
        *(u32x2*)(orow + c) = pk;
    }
}
__device__ __forceinline__ int mod_index(int r) { return r < NX ? (r >> 11) : 8; }

__device__ __forceinline__ void phase_pro0(const Params& p, unsigned char* smem) {
    float* act = (float*)smem;
    float* red = act + 9 * 1024;
    const int tid = hid_tid(), lane = tid & 63, wave = tid >> 6;
    for (int i = tid; i < 9 * 1024; i += 512) { const int r = i >> 10, k = i & 1023; const float v = (r < 8) ? p.c[r * 1024 + k] : p.c_ctx[k]; act[i] = v / (1.f + expf(-v)); }
    __syncthreads();
    float* MOD = WSP(float, WS_MOD);
    for (int item = blockIdx.x; item < 96; item += gridDim.x) {
        const int l = item / 48, ch = item % 48, hl = lane >> 5, cl = lane & 31;
        const float* w = p.w_ada + (size_t)l * 1024 * 6144 + ch * 128 + 4 * cl;
        f32x4 acc[9];
#pragma unroll
        for (int r = 0; r < 9; ++r) acc[r] = (f32x4){0.f, 0.f, 0.f, 0.f};
        const int k0 = wave * 128 + hl;
#pragma unroll 8
        for (int i = 0; i < 64; ++i) {
            const int k = k0 + 2 * i;
            const f32x4 wv = __builtin_nontemporal_load((const f32x4*)(w + (size_t)k * 6144));
#pragma unroll
            for (int r = 0; r < 9; ++r) { const float a = act[r * 1024 + k]; acc[r].x += a * wv.x; acc[r].y += a * wv.y; acc[r].z += a * wv.z; acc[r].w += a * wv.w; }
        }
#pragma unroll
        for (int r = 0; r < 9; ++r) {
            acc[r].x += __shfl_xor(acc[r].x, 32); acc[r].y += __shfl_xor(acc[r].y, 32); acc[r].z += __shfl_xor(acc[r].z, 32); acc[r].w += __shfl_xor(acc[r].w, 32);
            if (hl == 0) *(f32x4*)(red + (wave * 9 + r) * 128 + 4 * cl) = acc[r];
        }
        __syncthreads();
        for (int i = tid; i < 9 * 128; i += 512) {
            const int r = i >> 7, cc = i & 127; float s = 0.f;
#pragma unroll
            for (int w8 = 0; w8 < 8; ++w8) s += red[(w8 * 9 + r) * 128 + cc];
            MOD[(size_t)(l * 9 + r) * 6144 + ch * 128 + cc] = s + p.b_ada[l * 6144 + ch * 128 + cc];
        }
        __syncthreads();
    }
    if (blockIdx.x == gridDim.x - 2) {
        float* RT = WSP(float, WS_ROPE);
        const int pos = tid >> 3, f = tid & 7; const float ang = (float)pos * expf(-(float)f * 1.151292546497023f);
        RT[2 * tid] = cosf(ang); RT[2 * tid + 1] = sinf(ang);
    }
    if (blockIdx.x == gridDim.x - 1 && wave == 0) {
        float* SC = WSP(float, WS_SCAL);
        for (int l = 0; l < 2; ++l) {
            float s1 = lane < 32 ? p.lq1[l * 32 + lane] * p.lk1[l * 32 + lane] : 0.f;
            float s2 = lane < 32 ? p.lq2[l * 32 + lane] * p.lk2[l * 32 + lane] : 0.f;
            s1 = wave_sum(s1); s2 = wave_sum(s2);
            const float lam_init = 0.8f - 0.6f * expf(-0.3f * (float)l);
            const float lam = expf(s1) - expf(s2) + lam_init;
            const float mq = wave_max(lane < 32 ? fabsf(p.df_qg[l * 32 + lane]) : 0.f), mk = wave_max(lane < 32 ? fabsf(p.df_kg[l * 32 + lane]) : 0.f);
            const float aq = wave_max(fabsf(p.na_qg[l * 64 + lane])), ak = wave_max(fabsf(p.na_kg[l * 64 + lane]));
            if (lane == 0) { SC[l * 16 + 0] = lam; SC[l * 16 + 1] = lam_init; SC[l * 16 + 2] = 5.656854249f * 1.44269504f * mq * mk; }
            for (int h = 0; h < 4; ++h) {
                float mb = 0.f;
                for (int i = lane; i < 15 * 31; i += 64) mb = fmaxf(mb, p.na_rpb[((size_t)(l * 4 + h)) * 465 + i]);
                mb = wave_max(mb);
                if (lane == 0) SC[l * 16 + 4 + h] = (8.f * aq * ak + mb) * 1.44269504f;
            }
        }
    }
    asm volatile("s_waitcnt vmcnt(0)" ::: "memory");
    __syncthreads();
    if (tid == 0) {
        __builtin_amdgcn_fence(__ATOMIC_RELEASE, "agent");
        asm volatile("s_waitcnt vmcnt(0)" ::: "memory");
        __hip_atomic_fetch_add(WSP(unsigned, WS_CTL + CTL_PRO0), 1u, __ATOMIC_RELAXED, __HIP_MEMORY_SCOPE_AGENT);
    }
}

__device__ __forceinline__ void transpose_item(const float* W, int ldw, int K, bf16_t* WT, unsigned char* sm, int kb, int nb, int lane) {
    const int q = lane >> 4, c4 = lane & 15;
    const float* src = W + (size_t)(64 * kb + 16 * q) * ldw + 64 * nb + 4 * c4;
    f32x4 r[16];
#pragma unroll
    for (int j = 0; j < 16; ++j) r[j] = *(const f32x4*)(src + (size_t)j * ldw);
#pragma unroll
    for (int c = 0; c < 4; ++c) {
        u32x4 o0, o1;
        o0.x = pk2(r[0][c], r[1][c]); o0.y = pk2(r[2][c], r[3][c]); o0.z = pk2(r[4][c], r[5][c]); o0.w = pk2(r[6][c], r[7][c]);
        o1.x = pk2(r[8][c], r[9][c]); o1.y = pk2(r[10][c], r[11][c]); o1.z = pk2(r[12][c], r[13][c]); o1.w = pk2(r[14][c], r[15][c]);
        unsigned char* d = sm + (4 * c4 + c) * 144 + 32 * q;
        *(u32x4*)d = o0; *(u32x4*)(d + 16) = o1;
    }
    __builtin_amdgcn_s_waitcnt(0xc07f); asm volatile("" ::: "memory");
    bf16_t* dst = WT + (size_t)(64 * nb + (lane >> 3)) * K + 64 * kb + 8 * (lane & 7);
#pragma unroll
    for (int i = 0; i < 8; ++i) { const u32x4 o = *(const u32x4*)(sm + (8 * i + (lane >> 3)) * 144 + 16 * (lane & 7)); *(u32x4*)(dst + (size_t)(8 * i) * K) = o; }
    __builtin_amdgcn_s_waitcnt(0xc07f); asm volatile("" ::: "memory");
}

__device__ __forceinline__ void transpose_item8(const float* W, int ldw, int K, unsigned char* WT, unsigned char* sm, int kb, int nb, int lane) {
    const int q = lane >> 4, c4 = lane & 15;
    const float* src = W + (size_t)(64 * kb + 16 * q) * ldw + 64 * nb + 4 * c4;
    f32x4 r[16];
#pragma unroll
    for (int j = 0; j < 16; ++j) r[j] = *(const f32x4*)(src + (size_t)j * ldw) * SW8;
#pragma unroll
    for (int c = 0; c < 4; ++c) {
        u32x4 o; o.x = pk4_fp8(r[0][c], r[1][c], r[2][c], r[3][c]); o.y = pk4_fp8(r[4][c], r[5][c], r[6][c], r[7][c]);
        o.z = pk4_fp8(r[8][c], r[9][c], r[10][c], r[11][c]); o.w = pk4_fp8(r[12][c], r[13][c], r[14][c], r[15][c]);
        *(u32x4*)(sm + (4 * c4 + c) * 80 + 16 * q) = o;
    }
    __builtin_amdgcn_s_waitcnt(0xc07f); asm volatile("" ::: "memory");
    unsigned char* dst = WT + (size_t)(64 * nb + (lane >> 2)) * K + 64 * kb + 16 * (lane & 3);
#pragma unroll
    for (int i = 0; i < 4; ++i) { const u32x4 o = *(const u32x4*)(sm + (16 * i + (lane >> 2)) * 80 + 16 * (lane & 3)); *(u32x4*)(dst + (size_t)(16 * i) * K) = o; }
    __builtin_amdgcn_s_waitcnt(0xc07f); asm volatile("" ::: "memory");
}

__device__ __forceinline__ void phase_pro1(const Params& p, unsigned char* smem) {
    const int tid = hid_tid(), lane = tid & 63, wave = tid >> 6;
    const int gw = blockIdx.x * 8 + wave, ngw = gridDim.x * 8;
    bf16_t* WIN = WSP(bf16_t, WS_WIN);
    {
        float* Mf = (float*)smem;
        float* tile = Mf + 4096 + wave * (64 * 65);
        float* trig = Mf + 4096 + 8 * (64 * 65);
        if (tid < 128) { const int i = tid & 63; const float a = (float)i * (1.f / 32.f); trig[tid] = tid < 64 ? cospif(a) : sinpif(a); }
        __syncthreads();
        for (int rep_ = 0; rep_ < REP_FOLD; ++rep_)
        for (int it = blockIdx.x; it < 96; it += gridDim.x) {
            const int kq = it & 3, g = (it >> 2) & 3, kind = (it >> 4) % 3, l = it / 48;
            for (int i = tid; i < 4096; i += 512) {
                const int cch = i >> 6, e = i & 63; float v;
                if (kind == 0) v = p.pool_w[((size_t)(l * 4 + g) * 64 + cch) * 64 + e] * p.pool_scale[l * 256 + g * 64 + e];
                else {
                    const float* fw = p.fft_w + (size_t)(l * 4 + g) * 4096 + e; const float* tb = trig + (kind == 1 ? 0 : 64);
                    float s = 0.f;
#pragma unroll 8
                    for (int m = 0; m < 64; ++m) s += tb[(m * cch) & 63] * fw[m * 64];
                    v = s * 0.125f;
                }
                Mf[i] = v;
            }
            __syncthreads();
            const int srcb = (kind == 0 ? 1536 : 1792) + 64 * g, dstb = (kind == 0 ? 1536 : (kind == 1 ? 1792 : 2048)) + 64 * g;
            {
                const int kb = 4 * kq + (wave & 3), eh = wave >> 2;
                for (int i = 0; i < 64; ++i) tile[i * 65 + lane] = p.w_in[((size_t)l * 1024 + 64 * kb + i) * 2048 + srcb + lane];
                __builtin_amdgcn_s_waitcnt(0xc07f); asm volatile("" ::: "memory");
                float acc[32];
#pragma unroll
                for (int e = 0; e < 32; ++e) acc[e] = 0.f;
                for (int cch = 0; cch < 64; ++cch) {
                    const float a = tile[lane * 65 + cch];
#pragma unroll
                    for (int e = 0; e < 32; ++e) acc[e] += a * Mf[cch * 64 + eh * 32 + e];
                }
#pragma unroll
                for (int e = 0; e < 32; ++e) WIN[((size_t)l * NIN + dstb + eh * 32 + e) * 1024 + 64 * kb + lane] = f2bf(acc[e]);
                __builtin_amdgcn_s_waitcnt(0xc07f); asm volatile("" ::: "memory");
            }
            __syncthreads();
        }
    }
    {
        unsigned char* tsm = smem + wave * (64 * 144);
        __syncthreads();
        constexpr int I_IN = 16 * 24, I_OUT = 16 * 16;
        constexpr int T0 = 2 * I_IN, T1 = T0 + 2 * I_OUT;
        for (int rep_ = 0; rep_ < REP_TR; ++rep_)
        for (int it = gw; it < T1; it += ngw) {
            if (it < T0) { const int l = it / I_IN, r = it % I_IN; transpose_item(p.w_in + (size_t)l * 1024 * 2048, 2048, 1024, WIN + (size_t)l * NIN * 1024, tsm, r % 16, r / 16, lane); }
            else { const int q = it - T0, l = q / I_OUT, r = q % I_OUT; transpose_item(p.w_out + (size_t)l * 1024 * 1024, 1024, 1024, WSP(bf16_t, WS_WOUT) + (size_t)l * 1024 * 1024, tsm, r % 16, r / 16, lane); }
        }
    }
    {
        bf16_t* DM_ = WSP(bf16_t, WS_DFTM); bf16_t* DC_ = WSP(bf16_t, WS_DFTC);
        const int gt = blockIdx.x * 512 + tid, ngt = gridDim.x * 512;
        for (int i = gt; i < 2048 * 256; i += ngt) {
            const int k = i >> 8, j0 = (i & 255) * 8; unsigned o[4];
#pragma unroll
            for (int q = 0; q < 4; ++q) { float v[2];
#pragma unroll
                for (int e = 0; e < 2; ++e) { const int j = j0 + 2 * q + e;
                    if (j <= 1024) { const int ph = (k * j) & 2047; v[e] = cospif((float)ph * (1.f / 1024.f)) * 0.02209708691f; }
                    else { const int ph = (k * (j - 1024)) & 2047; v[e] = -sinpif((float)ph * (1.f / 1024.f)) * 0.02209708691f; } }
                o[q] = pk2(v[0], v[1]); }
            *(u32x4*)(DM_ + (size_t)k * 2048 + j0) = (u32x4){o[0], o[1], o[2], o[3]};
        }
        for (int i = gt; i < 256 * 32; i += ngt) {
            const int k = i >> 5, j0 = (i & 31) * 8; unsigned o[4];
#pragma unroll
            for (int q = 0; q < 4; ++q) { float v[2];
#pragma unroll
                for (int e = 0; e < 2; ++e) { const int j = j0 + 2 * q + e;
                    if (j <= 128) { const int ph = (k * j) & 255; v[e] = cospif((float)ph * (1.f / 128.f)) * 0.0625f; }
                    else { const int ph = (k * (j - 128)) & 255; v[e] = -sinpif((float)ph * (1.f / 128.f)) * 0.0625f; } }
                o[q] = pk2(v[0], v[1]); }
            *(u32x4*)(DC_ + (size_t)k * 256 + j0) = (u32x4){o[0], o[1], o[2], o[3]};
        }
    }
    {
        bf16_t* RWT = WSP(bf16_t, WS_RWT);
        const int gt = blockIdx.x * 512 + tid, ngt = gridDim.x * 512;
        for (int i = gt; i < 2 * 32 * 128; i += ngt) {
            const int l = i >> 12, e = (i >> 7) & 31, k0 = (i & 127) * 8;
            const float* s = p.router_w + ((size_t)l * 1024 + k0) * 32 + e;
            u32x4 o; o.x = pk2(s[0], s[32]); o.y = pk2(s[64], s[96]); o.z = pk2(s[128], s[160]); o.w = pk2(s[192], s[224]);
            *(u32x4*)(RWT + ((size_t)(l * 32 + e)) * 1024 + k0) = o;
        }
    }
    {
        if (tid == 0) {
            unsigned* cnt = WSP(unsigned, WS_CTL + CTL_PRO0); unsigned sp = 0;
            while (__hip_atomic_load(cnt, __ATOMIC_RELAXED, __HIP_MEMORY_SCOPE_AGENT) < gridDim.x) { __builtin_amdgcn_s_sleep(2); if (++sp > (1u << 22)) break; }
            __builtin_amdgcn_fence(__ATOMIC_ACQUIRE, "agent");
            asm volatile("s_waitcnt vmcnt(0)" ::: "memory");
        }
        __syncthreads();
    }
    {
        const float* MOD = WSP(float, WS_MOD); bf16_t* H = WSP(bf16_t, WS_H);
        for (int r = gw; r < NT; r += ngw) {
            const float* xr = r < NX ? p.x + (size_t)r * DM : p.ctx + (size_t)(r - NX) * DM;
            const float* m = MOD + (size_t)(0 * 9 + mod_index(r)) * 6144;
            f32x4 hv[4];
            mod_row(xr, p.g1w, m, m + 1024, H + (size_t)r * DM, lane, hv);
        }
    }
}

enum { G_WIN = 0, G_DFT = 1, G_DFTC = 2, G_WOUT = 3, G_MOE1 = 4, G_MOE2 = 5 };
__device__ __forceinline__ void moe_tinfo(const Params& p, int l, int* tinfo) {
    if (threadIdx.x == 0) {
        const int* cnt = WSP(int, WS_CTL + CTL_CNT) + l * 32; int s = 0;
        for (int e = 0; e < 32; ++e) { const int c = cnt[e]; tinfo[e] = s; tinfo[33 + e] = c; s += (c + 255) >> 8; }
        tinfo[32] = s;
    }
    __syncthreads();
}

#define LAS __attribute__((address_space(3)))
namespace g8 {
constexpr int BM = 256, BK = 64, HALF = 128, HTB = HALF * BK * 2, STAGE_BYTES = 8 * HTB, NXCD = 8, WGM = 8;
__host__ __device__ __forceinline__ int lds_xor(int r) { return (((r >> 1) & 1) * 3) | (r & 4); }
__host__ __device__ __forceinline__ int lds_byte(int r, int c) { return r * 128 + ((((c >> 3) ^ lds_xor(r)) & 7) << 4); }
__host__ __device__ __forceinline__ void stage_rc(int b, int& R, int& C) { const int r = b >> 7, cp = (b >> 4) & 7; R = r; C = ((cp ^ lds_xor(r)) & 7) * 8; }
}
struct UnitD { unsigned boff; const int* gather; int arow0, nvalid, orow0, ocol0, e; };
template <int KIND> __device__ __forceinline__ void phase_geom(int l, const int* tinfo, int& nM, int& nN, int& K) {
    if (KIND == G_WIN) { nM = 72; nN = 9; K = 1024; }
    else if (KIND == G_DFT) { nM = 8; nN = 8; K = 2048; }
    else if (KIND == G_DFTC) { nM = 1; nN = 8; K = 256; }
    else if (KIND == G_WOUT) { nM = (l == 0) ? 72 : 64; nN = 4; K = 1024; }
    else if (KIND == G_MOE1) { nM = __builtin_amdgcn_readfirstlane(tinfo[32]); nN = 8; K = 1024; }
    else { nM = __builtin_amdgcn_readfirstlane(tinfo[32]); nN = 4; K = 1024; }
}
template <int KIND> __device__ __forceinline__ const bf16_t* phase_A(const Params& p) {
    if (KIND == G_WIN) return WSP(bf16_t, WS_H);
    if (KIND == G_MOE1) return (const bf16_t*)WSP(unsigned char, WS_H8);
    if (KIND == G_DFT) return WSP(bf16_t, WS_DFTM);
    if (KIND == G_DFTC) return WSP(bf16_t, WS_DFTC);
    if (KIND == G_WOUT) return WSP(bf16_t, WS_YCAT);
    return WSP(bf16_t, WS_ACT);
}
template <int KIND> __device__ __forceinline__ const void* phase_B(const Params& p, int l) {
    if (KIND == G_WIN) return WSP(bf16_t, WS_WIN) + (size_t)l * NIN * 1024;
    if (KIND == G_DFT) return WSP(bf16_t, WS_XF);
    if (KIND == G_DFTC) return WSP(bf16_t, WS_XFC);
    if (KIND == G_WOUT) return WSP(bf16_t, WS_WOUT) + (size_t)l * 1024 * 1024;
    if (KIND == G_MOE1) return WSP(unsigned char, WS_W1) + (size_t)l * NE * 2048 * 1024;
    return WSP(unsigned char, WS_W2) + (size_t)l * NE * 1024 * 1024;
}
template <int KIND> __device__ __forceinline__ void get_unit(const Params& p, int l, int pm, int pn, const int* tinfo, UnitD& u) {
    u.gather = nullptr; u.nvalid = 256; u.e = 0; u.arow0 = pm * 256; u.orow0 = pm * 256; u.ocol0 = pn * 256;
    if (KIND == G_WIN) u.boff = (unsigned)pn * 256u * 1024u * 2u;
    else if (KIND == G_DFT) u.boff = (unsigned)pn * 256u * 2048u * 2u;
    else if (KIND == G_DFTC) u.boff = (unsigned)pn * 256u * 256u * 2u;
    else if (KIND == G_WOUT) u.boff = (unsigned)pn * 256u * 1024u * 2u;
    else {
        int e = 0; while (tinfo[e + 1] <= pm) ++e;
        e = __builtin_amdgcn_readfirstlane(e); u.e = e;
        if (KIND == G_MOE1) { u.gather = WSP(int, WS_LIST) + (size_t)e * NT; u.arow0 = __builtin_amdgcn_readfirstlane((pm - tinfo[e]) * 256); u.nvalid = __builtin_amdgcn_readfirstlane(tinfo[33 + e]) - u.arow0;
                              u.boff = (unsigned)(e * 2048 + pn * 256) * 1024u; }
        else u.boff = (unsigned)(e * 1024 + pn * 256) * 1024u;
    }
}
__device__ __forceinline__ bool static_order(int i, int G, int c, int nM, int nN, int& pm, int& pn) {
    const int nwg = nM * nN; const long L = (long)i * G + c; if (L >= nwg) return false;
    int wgid = (int)L; { const int q = nwg / g8::NXCD, r = nwg % g8::NXCD, xcd = wgid % g8::NXCD, off = wgid / g8::NXCD; wgid = (xcd < r ? xcd * (q + 1) : r * (q + 1) + (xcd - r) * q) + off; }
    const int nig = g8::WGM * nN, gid = wgid / nig, fm = gid * g8::WGM, gsz = (nM - fm) < g8::WGM ? (nM - fm) : g8::WGM;
    pm = fm + ((wgid % nig) % gsz); pn = (wgid % nig) / gsz; return true;
}
template <int KIND>
__device__ __forceinline__ void gemm_phase256(const Params& p, const int l, LAS unsigned char* lds, const int* tinfo) {
    using namespace g8;
    const int tid = hid_tid(), wid = __builtin_amdgcn_readfirstlane(tid >> 6), lane = tid & 63, wr = wid >> 2, wc = wid & 3, fr = lane & 15, fq = lane >> 4;
    int nM, nN, K; phase_geom<KIND>(l, tinfo, nM, nN, K);
    constexpr bool F8 = (KIND == G_MOE1 || KIND == G_MOE2);
    constexpr int ES = F8 ? 1 : 2;
    constexpr int KREP = F8 ? REP_KL8 : REP_KL16;
    const int nt1 = K * ES / 128, nt = nt1 * KREP, G = gridDim.x, cwg = blockIdx.x;
    const __amdgpu_buffer_rsrc_t rsA = __builtin_amdgcn_make_buffer_rsrc((void*)phase_A<KIND>(p), 0, 0x7ffffff0, 0x00020000);
    const __amdgpu_buffer_rsrc_t rsB = __builtin_amdgcn_make_buffer_rsrc((void*)phase_B<KIND>(p, l), 0, 0x7ffffff0, 0x00020000);
    unsigned voffB[2];
#pragma unroll
    for (int i = 0; i < 2; ++i) { int R_, C_; stage_rc(tid * 16 + i * 8192, R_, C_);
        const int rho = R_ & 31, Rb = F8 ? 64 * (R_ >> 5) + 16 * ((rho & 15) >> 2) + 4 * (rho >> 4) + (rho & 3) : (R_ & ~31) + 8 * ((rho & 15) >> 2) + 4 * (rho >> 4) + (rho & 3);
        voffB[i] = (unsigned)(Rb * K * ES + C_ * 2); }
    const unsigned kstep = 128u, hstepB = (unsigned)((F8 ? 8 : HALF) * K * ES);
    const unsigned ldsw = (unsigned)wid * 1024u;
    int aoffL[2], boffL[2];
    { const int ra = wr * 64 + fr, rb = wc * 32 + fr;
      if (F8) { aoffL[0] = lds_byte(ra, 16 * fq); aoffL[1] = lds_byte(ra, 16 * fq + 8); boffL[0] = lds_byte(rb, 16 * fq); boffL[1] = lds_byte(rb, 16 * fq + 8); }
      else { aoffL[0] = lds_byte(ra, fq * 8); aoffL[1] = lds_byte(ra, fq * 8 + 32); boffL[0] = lds_byte(rb, fq * 8); boffL[1] = lds_byte(rb, fq * 8 + 32); } }
#define G8_SA(b, h) (((b) * 2 + (h)) * HTB)
#define G8_SB(b, h) ((4 + (b) * 2 + (h)) * HTB)
#define G8_STAGE_A(bufoff, ktb, h) do { _Pragma("unroll") for (int _i = 0; _i < 2; ++_i) \
        __builtin_amdgcn_raw_ptr_buffer_load_lds(rsA, (LAS void*)(lds + (bufoff) + ldsw + _i * 8192), 16, aoff[h][_i], (int)(ktb), 0, 0); } while (0)
#define G8_STAGE_B(bufoff, soff) do { _Pragma("unroll") for (int _i = 0; _i < 2; ++_i) \
        __builtin_amdgcn_raw_ptr_buffer_load_lds(rsB, (LAS void*)(lds + (bufoff) + ldsw + _i * 8192), 16, voffB[_i], (int)(soff), 0, 0); } while (0)
#define G8_LDA(dst, b, h) do { _Pragma("unroll") for (int m = 0; m < 4; ++m) _Pragma("unroll") for (int k = 0; k < 2; ++k) { const u32x4 _v = *(const LAS u32x4*)(lds + G8_SA(b, h) + aoffL[k] + m * 2048); dst[m][4 * k] = (int)_v.x; dst[m][4 * k + 1] = (int)_v.y; dst[m][4 * k + 2] = (int)_v.z; dst[m][4 * k + 3] = (int)_v.w; } } while (0)
#define G8_LDB(dst, b, h) do { _Pragma("unroll") for (int n = 0; n < 2; ++n) _Pragma("unroll") for (int k = 0; k < 2; ++k) { const u32x4 _v = *(const LAS u32x4*)(lds + G8_SB(b, h) + boffL[k] + n * 2048); dst[n][4 * k] = (int)_v.x; dst[n][4 * k + 1] = (int)_v.y; dst[n][4 * k + 2] = (int)_v.z; dst[n][4 * k + 3] = (int)_v.w; } } while (0)
#define G8_MMA(ai, bj, At, Bt) do { __builtin_amdgcn_s_setprio(1); _Pragma("unroll") for (int m = 0; m < 4; ++m) _Pragma("unroll") for (int n = 0; n < 2; ++n) { \
        if (F8) acc[ai][bj][m][n] = __builtin_amdgcn_mfma_scale_f32_16x16x128_f8f6f4(Bt[n], At[m], acc[ai][bj][m][n], 0, 0, 0, 0, 0, 0); \
        else { typedef int i32x4_ __attribute__((ext_vector_type(4))); \
               const i32x4_ _a0 = __builtin_shufflevector(At[m], At[m], 0, 1, 2, 3), _a1 = __builtin_shufflevector(At[m], At[m], 4, 5, 6, 7); \
               const i32x4_ _b0 = __builtin_shufflevector(Bt[n], Bt[n], 0, 1, 2, 3), _b1 = __builtin_shufflevector(Bt[n], Bt[n], 4, 5, 6, 7); \
               acc[ai][bj][m][n] = __builtin_amdgcn_mfma_f32_16x16x32_bf16(*(const bf16x8*)&_b0, *(const bf16x8*)&_a0, acc[ai][bj][m][n], 0, 0, 0); \
               acc[ai][bj][m][n] = __builtin_amdgcn_mfma_f32_16x16x32_bf16(*(const bf16x8*)&_b1, *(const bf16x8*)&_a1, acc[ai][bj][m][n], 0, 0, 0); } } \
        __builtin_amdgcn_s_setprio(0); } while (0)
#define G8_WAIT_V(n) asm volatile("s_waitcnt vmcnt(" #n ")" ::: "memory")
#define G8_WAIT_L(n) asm volatile("s_waitcnt lgkmcnt(" #n ")" ::: "memory")
#define G8_BAR __builtin_amdgcn_s_barrier()
#define G8_SCHED __builtin_amdgcn_sched_barrier(0)
#define G8_AOFF(dst, u) do { _Pragma("unroll") for (int _h = 0; _h < 2; ++_h) _Pragma("unroll") for (int _i = 0; _i < 2; ++_i) { int _R, _C; stage_rc(tid * 16 + _i * 8192, _R, _C); const int _rt = _h * 128 + _R; int _ar; \
        if (KIND == G_MOE1) _ar = (u).gather[(u).arow0 + (_rt < (u).nvalid ? _rt : -(u).arow0)]; else _ar = (u).arow0 + _rt; \
        dst[_h][_i] = (unsigned)(_ar * K * ES + _C * 2); } } while (0)
    UnitD cur, nxt; int ui = 0, pm, pn;
    if (!static_order(0, G, cwg, nM, nN, pm, pn)) return;
    get_unit<KIND>(p, l, pm, pn, tinfo, cur);
    unsigned aoff[2][2]; G8_AOFF(aoff, cur);
    f32x4 acc[2][2][4][2];
#pragma unroll
    for (int a = 0; a < 2; ++a)
#pragma unroll
        for (int b = 0; b < 2; ++b)
#pragma unroll
            for (int m = 0; m < 4; ++m)
#pragma unroll
                for (int n = 0; n < 2; ++n) acc[a][b][m][n] = (f32x4){0.f, 0.f, 0.f, 0.f};
    i32x8 At[4], B0[2], B1[2];
    unsigned cB = cur.boff;
    G8_STAGE_B(G8_SB(0, 0), cB); G8_STAGE_A(G8_SA(0, 0), 0, 0); G8_STAGE_B(G8_SB(0, 1), cB + hstepB); G8_STAGE_A(G8_SA(0, 1), 0, 1);
    if (wr == 1) G8_BAR;
    G8_WAIT_V(4); G8_BAR;
    G8_STAGE_B(G8_SB(1, 0), cB + kstep); G8_STAGE_A(G8_SA(1, 0), kstep, 0); G8_STAGE_B(G8_SB(1, 1), cB + hstepB + kstep);
    G8_WAIT_V(6); G8_BAR;
    G8_LDB(B0, 0, 0);
    for (;;) {
        const bool has_next = static_order(ui + 1, G, cwg, nM, nN, pm, pn);
        if (has_next) get_unit<KIND>(p, l, pm, pn, tinfo, nxt);
        const unsigned nB = has_next ? nxt.boff : cB;
        if ((KIND == G_MOE1 || KIND == G_MOE2) && wid == 0) {
            const float* bsrc = ((KIND == G_MOE1) ? p.b1 + (size_t)(l * NE + cur.e) * 2048 : p.b2 + (size_t)(l * NE + cur.e) * 1024) + cur.ocol0 + 4 * lane;
            __builtin_amdgcn_global_load_lds((const unsigned*)bsrc, (LAS unsigned*)(lds + STAGE_BYTES + (ui & 1) * 1024), 16, 0, 0);
            if (KIND == G_MOE1 && has_next)
                __builtin_amdgcn_global_load_lds((const unsigned*)(nxt.gather + nxt.arow0 + 4 * lane), (LAS unsigned*)(lds + STAGE_BYTES + 2048 + ((ui + 1) & 1) * 1024), 16, 0, 0);
        }
#pragma unroll 1
        for (int t = 0; t < nt; t += 2) {
            const bool last = (t == nt - 2);
            if (KREP > 1 && t == nt - nt1) {
#pragma unroll
                for (int a = 0; a < 2; ++a)
#pragma unroll
                    for (int b = 0; b < 2; ++b)
#pragma unroll
                        for (int m = 0; m < 4; ++m)
#pragma unroll
                            for (int n = 0; n < 2; ++n) acc[a][b][m][n] = (f32x4){0.f, 0.f, 0.f, 0.f};
            }
            unsigned naoff1[2];
            if (KIND == G_MOE1 && last && has_next) {
                const LAS int* itab = (const LAS int*)(lds + STAGE_BYTES + 2048 + ((ui + 1) & 1) * 1024);
#pragma unroll
                for (int _i = 0; _i < 2; ++_i) { int _R, _C; stage_rc(tid * 16 + _i * 8192, _R, _C);
                    const int _r0 = _R, _r1 = 128 + _R;
                    const int a0 = itab[_r0 < nxt.nvalid ? _r0 : 0], a1 = itab[_r1 < nxt.nvalid ? _r1 : 0];
                    aoff[0][_i] = (unsigned)(a0 * K * ES + _C * 2); naoff1[_i] = (unsigned)(a1 * K * ES + _C * 2); }
            }
            G8_LDA(At, 0, 0); G8_STAGE_A(G8_SA(1, 1), (unsigned)((t + 1) & (nt1 - 1)) * kstep, 1);
            G8_BAR; G8_WAIT_L(0); G8_MMA(0, 0, At, B0); G8_BAR; G8_SCHED;
            unsigned kt2 = (unsigned)((t + 2) & (nt1 - 1)) * kstep; unsigned b2 = cB + kt2;
            if (last) { kt2 = 0; b2 = nB; if (has_next) { if (KIND == G_MOE1) { aoff[1][0] = naoff1[0]; aoff[1][1] = naoff1[1]; } else G8_AOFF(aoff, nxt); } }
            G8_LDB(B1, 0, 1); G8_STAGE_B(G8_SB(0, 0), b2);
            G8_BAR; G8_WAIT_L(0); G8_MMA(0, 1, At, B1); G8_BAR;
            G8_LDA(At, 0, 1); G8_STAGE_A(G8_SA(0, 0), kt2, 0);
            G8_WAIT_V(10); G8_BAR; G8_WAIT_L(0); G8_MMA(1, 0, At, B0); G8_BAR; G8_SCHED;
            G8_LDB(B0, 1, 0); G8_STAGE_B(G8_SB(0, 1), b2 + hstepB);
            G8_WAIT_V(6); G8_BAR; G8_MMA(1, 1, At, B1); G8_BAR;
            G8_LDA(At, 1, 0); G8_STAGE_A(G8_SA(0, 1), kt2, 1);
            G8_BAR; G8_WAIT_L(0); G8_MMA(0, 0, At, B0); G8_BAR; G8_SCHED;
            G8_LDB(B1, 1, 1); G8_STAGE_B(G8_SB(1, 0), b2 + kstep);
            G8_BAR; G8_WAIT_L(0); G8_MMA(0, 1, At, B1); G8_BAR;
            G8_LDA(At, 1, 1); G8_STAGE_A(G8_SA(1, 0), kt2 + kstep, 0);
            G8_WAIT_V(10); G8_BAR; G8_WAIT_L(0); G8_MMA(1, 0, At, B0); G8_BAR; G8_SCHED;
            if (!last) G8_LDB(B0, 0, 0);
            G8_STAGE_B(G8_SB(1, 1), b2 + kstep + hstepB);
            G8_WAIT_V(6); G8_BAR; G8_MMA(1, 1, At, B1); G8_BAR;
        }
#if REP_EPI > 1
        int erep_n = F8 ? REP_EPI : 1; asm volatile("" : "+s"(erep_n));
#pragma unroll 1
        for (int erep_ = 0; erep_ < erep_n; ++erep_)
#endif
        {
            const int r0 = wr * 64 + fr, c0 = wc * 32 + 8 * fq;
            f32x4 cv[2][2];
            if (KIND == G_MOE1 || KIND == G_MOE2 || KIND == G_WOUT) {
                const float* cbase = WSP(float, WS_MOD) + (size_t)(l * 9 + mod_index(cur.orow0)) * 6144 + 2048;
#pragma unroll
                for (int bj = 0; bj < 2; ++bj)
#pragma unroll
                    for (int n = 0; n < 2; ++n) {
                        if (KIND == G_WOUT) cv[bj][n] = *(const f32x4*)(cbase + cur.ocol0 + bj * HALF + c0 + 4 * n);
                        else cv[bj][n] = *(const LAS f32x4*)(lds + STAGE_BYTES + (ui & 1) * 1024 + (wc * 64 + 16 * fq + 8 * bj + 4 * n) * 4);
                    }
            }
#pragma unroll
            for (int ai = 0; ai < 2; ++ai) {
                if (KIND == G_WOUT) {
                    f32x4 xv[4][2][2];
#pragma unroll
                    for (int m = 0; m < 4; ++m) {
                        const int row = cur.orow0 + ai * HALF + r0 + m * 16;
                        if (l == 0) {
                            const float* xin = row < NX ? p.x + (size_t)row * DM : p.ctx + (size_t)(row - NX) * DM;
#pragma unroll
                            for (int bj = 0; bj < 2; ++bj)
#pragma unroll
                                for (int n = 0; n < 2; ++n) xv[m][bj][n] = *(const f32x4*)(xin + cur.ocol0 + bj * HALF + c0 + 4 * n);
                        } else {
#pragma unroll
                            for (int bj = 0; bj < 2; ++bj) { const u32x4 w = *(const u32x4*)(WSP(bf16_t, WS_X2) + (size_t)row * DM + cur.ocol0 + bj * HALF + c0);
                                xv[m][bj][0] = (f32x4){bflo(w.x), bfhi(w.x), bflo(w.y), bfhi(w.y)}; xv[m][bj][1] = (f32x4){bflo(w.z), bfhi(w.z), bflo(w.w), bfhi(w.w)}; }
                        }
                    }
#pragma unroll
                    for (int m = 0; m < 4; ++m) {
                        const int row = cur.orow0 + ai * HALF + r0 + m * 16;
#pragma unroll
                        for (int bj = 0; bj < 2; ++bj) {
                            const f32x4 v0 = acc[ai][bj][m][0], v1 = acc[ai][bj][m][1], g0 = cv[bj][0], g1 = cv[bj][1], x0 = xv[m][bj][0], x1 = xv[m][bj][1];
                            u32x4 o; o.x = pk2(x0.x + g0.x * v0.x, x0.y + g0.y * v0.y); o.y = pk2(x0.z + g0.z * v0.z, x0.w + g0.w * v0.w);
                            o.z = pk2(x1.x + g1.x * v1.x, x1.y + g1.y * v1.y); o.w = pk2(x1.z + g1.z * v1.z, x1.w + g1.w * v1.w);
                            *(u32x4*)(WSP(bf16_t, WS_X1) + (size_t)row * DM + cur.ocol0 + bj * HALF + c0) = o;
                        }
                    }
                } else {
#pragma unroll
                    for (int m = 0; m < 4; ++m) {
                        const int row = cur.orow0 + ai * HALF + r0 + m * 16;
                        if (F8) {
                            const int colw = cur.ocol0 + wc * 64 + 16 * fq;
                            unsigned ow[2][2];
#pragma unroll
                            for (int bj = 0; bj < 2; ++bj) {
                                const f32x4 v0 = acc[ai][bj][m][0], v1 = acc[ai][bj][m][1];
                                if (KIND == G_MOE1) {
                                    constexpr float dq = 1.f / (SW8 * SH8);
                                    const f32x4 b0 = cv[bj][0], b1 = cv[bj][1];
                                    const float u[8] = {v0.x * dq + b0.x, v0.y * dq + b0.y, v0.z * dq + b0.z, v0.w * dq + b0.w, v1.x * dq + b1.x, v1.y * dq + b1.y, v1.z * dq + b1.z, v1.w * dq + b1.w};
                                    float o[4];
#pragma unroll
                                    for (int q = 0; q < 4; ++q) { const float g = fminf(u[2 * q], 7.f), li = fminf(fmaxf(u[2 * q + 1], -7.f), 7.f);
                                        o[q] = g * __builtin_amdgcn_rcpf(1.f + __builtin_amdgcn_exp2f(-2.45546696f * g)) * (li + 1.f) * SA8; }
                                    ow[bj][0] = pk4_fp8(o[0], o[1], o[2], o[3]); ow[bj][1] = 0u;
                                } else {
                                    constexpr float dq = SY8 / (SW8 * SA8);
                                    const f32x4 b0 = cv[bj][0] * SY8, b1 = cv[bj][1] * SY8;
#define CL8(x) fminf(fmaxf((x), -448.f), 448.f)
                                    ow[bj][0] = pk4_fp8(CL8(v0.x * dq + b0.x), CL8(v0.y * dq + b0.y), CL8(v0.z * dq + b0.z), CL8(v0.w * dq + b0.w));
                                    ow[bj][1] = pk4_fp8(CL8(v1.x * dq + b1.x), CL8(v1.y * dq + b1.y), CL8(v1.z * dq + b1.z), CL8(v1.w * dq + b1.w));
#undef CL8
                                }
                            }
                            if (KIND == G_MOE1) { u32x2 o; o.x = ow[0][0]; o.y = ow[1][0]; *(u32x2*)(WSP(unsigned char, WS_ACT) + (size_t)row * FF + (colw >> 1)) = o; }
                            else { u32x4 o; o.x = ow[0][0]; o.y = ow[0][1]; o.z = ow[1][0]; o.w = ow[1][1]; *(u32x4*)(WSP(unsigned char, WS_Y2) + (size_t)row * DM + colw) = o; }
                        } else {
#pragma unroll
                            for (int bj = 0; bj < 2; ++bj) {
                                const f32x4 v0 = acc[ai][bj][m][0], v1 = acc[ai][bj][m][1]; const int col = cur.ocol0 + bj * HALF + c0;
                                u32x4 o; o.x = pk2(v0.x, v0.y); o.y = pk2(v0.z, v0.w); o.z = pk2(v1.x, v1.y); o.w = pk2(v1.z, v1.w);
                                bf16_t* dst;
                                if (KIND == G_WIN) dst = WSP(bf16_t, WS_PX) + (size_t)row * NIN + col;
                                else if (KIND == G_DFT) dst = WSP(bf16_t, WS_YCAT) + (size_t)((col >> 8) * SEQ + row) * DM + 768 + (col & 255);
                                else dst = WSP(bf16_t, WS_YCAT) + (size_t)(NX + (col >> 8) * LC + row) * DM + 768 + (col & 255);
                                *(u32x4*)dst = o;
                            }
                        }
                    }
                }
            }
        }
        if (!has_next) break;
#pragma unroll
        for (int a = 0; a < 2; ++a)
#pragma unroll
            for (int b = 0; b < 2; ++b)
#pragma unroll
                for (int m = 0; m < 4; ++m)
#pragma unroll
                    for (int n = 0; n < 2; ++n) acc[a][b][m][n] = (f32x4){0.f, 0.f, 0.f, 0.f};
        cur = nxt; cB = nB; ++ui;
        G8_LDB(B0, 0, 0);
    }
    G8_WAIT_V(0);
    if (wr == 0) G8_BAR;
    G8_BAR;
#undef G8_SA
#undef G8_SB
#undef G8_STAGE_A
#undef G8_STAGE_B
#undef G8_LDA
#undef G8_LDB
#undef G8_MMA
#undef G8_WAIT_V
#undef G8_WAIT_L
#undef G8_BAR
#undef G8_SCHED
#undef G8_AOFF
}

__device__ __forceinline__ void wave_transpose_store(bf16_t* sm  , const u32x4 (&v)[8], bf16_t* dst, size_t dstride, int lane, int cpos) {
#pragma unroll
    for (int i = 0; i < 8; ++i) {
        const unsigned w[4] = {v[i].x, v[i].y, v[i].z, v[i].w};
#pragma unroll
        for (int q = 0; q < 4; ++q) { sm[(8 * i + 2 * q) * 72 + cpos] = (bf16_t)(w[q] & 0xffffu); sm[(8 * i + 2 * q + 1) * 72 + cpos] = (bf16_t)(w[q] >> 16); }
    }
    __builtin_amdgcn_s_waitcnt(0xc07f); asm volatile("" ::: "memory");
#pragma unroll
    for (int i = 0; i < 8; ++i) { const u32x4 o = *(const u32x4*)(sm + lane * 72 + 8 * i); *(u32x4*)(dst + (size_t)lane * dstride + 8 * i) = o; }
    __builtin_amdgcn_s_waitcnt(0xc07f); asm volatile("" ::: "memory");
}

__device__ __forceinline__ void phase_prep(const Params& p, const int l, unsigned char* smem) {
    const int tid = hid_tid(), lane = tid & 63, wave = tid >> 6;
    const int gw = blockIdx.x * 8 + wave, ngw = gridDim.x * 8;
    const bf16_t* PX = WSP(bf16_t, WS_PX); const float* ROPE = WSP(float, WS_ROPE);
    bf16_t *QA = WSP(bf16_t, WS_QA), *KA = WSP(bf16_t, WS_KA), *QD = WSP(bf16_t, WS_QD), *KD = WSP(bf16_t, WS_KD), *YC = WSP(bf16_t, WS_YCAT);
    struct RowRaw { u32x2 q[4]; u32x2 wv[16]; u32x2 cu; };
    auto row_load = [&](int r, RowRaw& R) {
        const bool isctx = r >= NX; const int t = isctx ? ((r - NX) & 255) : (r & 2047);
        const bf16_t* px = PX + (size_t)r * NIN;
        R.q[0] = *(const u32x2*)(px + 4 * lane); R.q[1] = *(const u32x2*)(px + 256 + 4 * lane); R.q[2] = *(const u32x2*)(px + 768 + 4 * lane); R.q[3] = *(const u32x2*)(px + 1024 + 4 * lane);
        if (!(l == 1 && isctx)) {
            const int g = lane >> 4, win = 2 << g, Ls = isctx ? LC : SEQ;
            int lo = t - win / 2, hi = lo + win; lo = lo < 0 ? 0 : lo; hi = hi > Ls ? Ls : hi;
            const bf16_t* base = PX + (size_t)(r - t) * NIN + 1536 + 4 * lane;
#pragma unroll
            for (int j = 0; j < 16; ++j) { const int tt = lo + j < hi ? lo + j : hi - 1; R.wv[j] = *(const u32x2*)(base + (size_t)tt * NIN); }
            R.cu = *(const u32x2*)(base + (size_t)t * NIN);
        }
    };
    RowRaw cur, nxt;
    if (gw < NT) row_load(gw, nxt);
    for (int r = gw; r < NT; r += ngw) {
        cur = nxt;
        if (r + ngw < NT) row_load(r + ngw, nxt);
        const bool isctx = r >= NX; int b, t, kidx;
        if (!isctx) { b = r >> 11; t = r & 2047; kidx = 256 + t; } else { const int rr = r - NX; b = rr >> 8; t = rr & 255; kidx = t; }
        const int h = lane >> 4, d4 = (4 * lane) & 63;
        const size_t obase = ((size_t)(b * 4 + h) * KEYS + kidx) * 64 + d4;
        float v[4];
        { unpack4(cur.q[0], v); float ss = v[0] * v[0] + v[1] * v[1] + v[2] * v[2] + v[3] * v[3];
          ss = sum16_dpp(ss);
          const float rs = rsqrtf(ss * (1.f / 64.f) + EPS) * 0.18033688f; const f32x4 g = *(const f32x4*)(p.na_qg + l * 64 + d4);
          u32x2 o; o.x = pk2(v[0] * rs * g.x, v[1] * rs * g.y); o.y = pk2(v[2] * rs * g.z, v[3] * rs * g.w); *(u32x2*)(QA + obase) = o; }
        { unpack4(cur.q[1], v); float ss = v[0] * v[0] + v[1] * v[1] + v[2] * v[2] + v[3] * v[3];
          ss = sum16_dpp(ss);
          const float rs = rsqrtf(ss * (1.f / 64.f) + EPS); const f32x4 g = *(const f32x4*)(p.na_kg + l * 64 + d4);
          u32x2 o; o.x = pk2(v[0] * rs * g.x, v[1] * rs * g.y); o.y = pk2(v[2] * rs * g.z, v[3] * rs * g.w); *(u32x2*)(KA + obase) = o; }
        const int li = lane & 7, d32 = 4 * li;
        float cs[4], sn[4];
        if (!isctx) {
            const int pos = (li & 4) ? (t & 63) : (t >> 6);
            const f32x4* rt = (const f32x4*)(ROPE + (pos * 8 + 4 * (li & 1)) * 2);
            const f32x4 r0 = rt[0], r1 = rt[1];
            cs[0] = r0.x; sn[0] = r0.y; cs[1] = r0.z; sn[1] = r0.w; cs[2] = r1.x; sn[2] = r1.y; cs[3] = r1.z; sn[3] = r1.w;
        }
#pragma unroll
        for (int which = 0; which < 2; ++which) {
            unpack4(cur.q[2 + which], v);
            float ss = v[0] * v[0] + v[1] * v[1] + v[2] * v[2] + v[3] * v[3];
            ss = sum8_dpp(ss);
            const float rs = rsqrtf(ss * (1.f / 32.f) + EPS);
            const f32x4 g = *(const f32x4*)((which ? p.df_kg : p.df_qg) + l * 32 + d32);
            float y[4] = {v[0] * rs * g.x, v[1] * rs * g.y, v[2] * rs * g.z, v[3] * rs * g.w};
            if (!isctx) {
#pragma unroll
                for (int e = 0; e < 4; ++e) { const float o = DPP_F(y[e], 0x4E); y[e] = (li & 2) ? (y[e] * cs[e] + o * sn[e]) : (y[e] * cs[e] - o * sn[e]); }
            }
            const float sc = which ? 1.f : 0.25503486f;
            u32x2 o; o.x = pk2(y[0] * sc, y[1] * sc); o.y = pk2(y[2] * sc, y[3] * sc);
            *(u32x2*)((which ? KD : QD) + obase) = o;
        }
        if (!(l == 1 && isctx)) {
            const int g = lane >> 4, win = 2 << g, Ls = isctx ? LC : SEQ;
            int lo = t - win / 2, hi = lo + win; lo = lo < 0 ? 0 : lo; hi = hi > Ls ? Ls : hi;
            float s[4] = {0.f, 0.f, 0.f, 0.f};
#pragma unroll
            for (int j = 0; j < 16; ++j) { float q[4]; unpack4(cur.wv[j], q); const float m = lo + j < hi ? 1.f : 0.f; s[0] += m * q[0]; s[1] += m * q[1]; s[2] += m * q[2]; s[3] += m * q[3]; }
            float u[4]; unpack4(cur.cu, u);
            const float inv = 1.f / (float)(hi - lo);
            u32x2 o; o.x = pk2(s[0] * inv - u[0], s[1] * inv - u[1]); o.y = pk2(s[2] * inv - u[2], s[3] * inv - u[3]);
            *(u32x2*)(YC + (size_t)r * DM + 512 + 4 * lane) = o;
        }
    }
    bf16_t* sm = (bf16_t*)smem + wave * (64 * 72);
    for (int it = gw; it < 2 * 8 * 4 * 36; it += ngw) {
        const int ch = it % 36, h = (it / 36) & 3, b = (it / 144) & 7, which = it / 1152;
        const int kidx = 64 * ch + lane; const int row = kidx < 256 ? NX + b * LC + kidx : b * SEQ + kidx - 256;
        const u32x4* src = (const u32x4*)(PX + (size_t)row * NIN + (which ? 1280 : 512) + 64 * h);
        u32x4 v[8];
#pragma unroll
        for (int i = 0; i < 8; ++i) v[i] = src[i];
        bf16_t* dst = (which ? WSP(bf16_t, WS_VTD) : WSP(bf16_t, WS_VTA)) + (size_t)(b * 4 + h) * 64 * KEYS + 64 * ch;
        wave_transpose_store(sm, v, dst, KEYS, lane, (lane & 48) | (((lane >> 2) & 1) << 3) | (((lane >> 3) & 1) << 2) | (lane & 3));
    }
    const int nC = 8 * 4 * 32 + (l == 0 ? 8 * 4 * 4 : 0);
    for (int it = gw; it < nC; it += ngw) {
        const bool cx = it >= 1024; const int q = cx ? it - 1024 : it;
        const int N = cx ? 256 : 2048, njc = N / 64;
        const int jc = q % njc, cc = (q / njc) & 3, b = q / (njc * 4);
        const int j = 64 * jc + lane; const int rowb = cx ? NX + b * LC : b * SEQ;
        int t1, t2, col; float sgn;
        if (j <= N / 2) { t1 = j; t2 = (j == 0 || j == N / 2) ? -1 : N - j; col = 1792 + 64 * cc; sgn = 1.f; }
        else { t1 = j - N / 2; t2 = N - t1; col = 2048 + 64 * cc; sgn = -1.f; }
        const u32x4* s1 = (const u32x4*)(PX + (size_t)(rowb + t1) * NIN + col);
        const u32x4* s2 = (const u32x4*)(PX + (size_t)(rowb + (t2 < 0 ? t1 : t2)) * NIN + col);
        const float w2 = t2 < 0 ? 0.f : sgn;
        u32x4 v[8];
#pragma unroll
        for (int i = 0; i < 8; ++i) {
            const u32x4 a = s1[i], bq = s2[i]; u32x4 o;
            o.x = pk2(bflo(a.x) + w2 * bflo(bq.x), bfhi(a.x) + w2 * bfhi(bq.x)); o.y = pk2(bflo(a.y) + w2 * bflo(bq.y), bfhi(a.y) + w2 * bfhi(bq.y));
            o.z = pk2(bflo(a.z) + w2 * bflo(bq.z), bfhi(a.z) + w2 * bfhi(bq.z)); o.w = pk2(bflo(a.w) + w2 * bflo(bq.w), bfhi(a.w) + w2 * bfhi(bq.w));
            v[i] = o;
        }
        bf16_t* dst = (cx ? WSP(bf16_t, WS_XFC) : WSP(bf16_t, WS_XF)) + (size_t)(b * 256 + 64 * cc) * N + 64 * jc;
        wave_transpose_store(sm, v, dst, N, lane, lane);
    }
}


__device__ __forceinline__ unsigned cvt_pk_bf16(float lo, float hi) { return pk2(lo, hi); }
__device__ __forceinline__ void phase_df_mfma(const Params& p, const int l, LAS unsigned char* lds) {
    const int tid = hid_tid(), wave = __builtin_amdgcn_readfirstlane(tid >> 6), lane = tid & 63, qn = lane & 31, hh = lane >> 5;
    const float* SC = WSP(float, WS_SCAL) + l * 16;
    const float lam = SC[0], lam_init = SC[1], negmb = -SC[2];
    const int nunits = 256 + (l == 0 ? 32 : 0);
    const int srow = tid >> 3, scq = (tid & 7) ^ ((srow >> 1) & 7);
    const unsigned ldsw = (unsigned)tid * 16u;
    f32x16 negm;
#pragma unroll
    for (int i = 0; i < 16; ++i) negm[i] = negmb;
    const int rsw = (qn >> 1) & 7;
    for (int it_ = 0;; ++it_) {
        int u;
        if (gridDim.x == 256) { if (it_ == 0) u = blockIdx.x; else { if (it_ > 1 || nunits <= 256 || blockIdx.x < 224) break; u = 256 + (255 - (int)blockIdx.x); } }
        else { u = blockIdx.x + it_ * (int)gridDim.x; if (u >= nunits) break; }
        const bool cx = u >= 256; const int qt = (u >> 3) & 7, bh = cx ? u - 256 : (u & 7) * 4 + (u >> 6), b = bh >> 2, h = bh & 3;
        const int q0 = cx ? 0 : 256 + 256 * qt, nkt = cx ? 4 : 36;
        const int orow = (cx ? NX + b * LC : b * SEQ + 256 * qt) + 32 * wave + qn;
        const char* Kg = (const char*)(WSP(bf16_t, WS_KD) + (size_t)bh * KEYS * 64) + srow * 128 + scq * 16;
        const char* Vg = (const char*)(WSP(bf16_t, WS_VTD) + (size_t)bh * 64 * KEYS) + (size_t)srow * KEYS * 2 + scq * 16;
        bf16x8 qf[2][2];
        { const bf16_t* Q = WSP(bf16_t, WS_QD) + ((size_t)bh * KEYS + q0 + 32 * wave + qn) * 64;
#pragma unroll
          for (int sub = 0; sub < 2; ++sub)
#pragma unroll
              for (int ks = 0; ks < 2; ++ks) qf[sub][ks] = *(const bf16x8*)(Q + 32 * sub + 16 * ks + 8 * hh); }
        f32x16 O1[2], O2[2]; float l1 = 0.f, l2 = 0.f;
        for (int trep_ = 0; trep_ < REP_TILE; ++trep_) {
#pragma unroll
        for (int db = 0; db < 2; ++db)
#pragma unroll
            for (int i = 0; i < 16; ++i) { O1[db][i] = 0.f; O2[db][i] = 0.f; }
        l1 = 0.f; l2 = 0.f;
        __syncthreads();
        __builtin_amdgcn_global_load_lds((const unsigned*)Kg, (LAS unsigned*)(lds + ldsw), 16, 0, 0);
        __builtin_amdgcn_global_load_lds((const unsigned*)Vg, (LAS unsigned*)(lds + 8192 + ldsw), 16, 0, 0);
        __builtin_amdgcn_global_load_lds((const unsigned*)(Kg + (size_t)64 * 128), (LAS unsigned*)(lds + 16384 + ldsw), 16, 0, 0);
        __builtin_amdgcn_global_load_lds((const unsigned*)(Vg + (size_t)64 * 2), (LAS unsigned*)(lds + 16384 + 8192 + ldsw), 16, 0, 0);
        asm volatile("s_waitcnt vmcnt(2)" ::: "memory"); __builtin_amdgcn_s_barrier();
        unsigned bo = 0u;
#pragma unroll 1
        for (int t = 0; t < nkt; ++t) {
            if (t + 2 < nkt) {
                const unsigned bn = bo == 0u ? 32768u : bo - 16384u;
                __builtin_amdgcn_global_load_lds((const unsigned*)(Kg + (size_t)(t + 2) * 64 * 128), (LAS unsigned*)(lds + bn + ldsw), 16, 0, 0);
                __builtin_amdgcn_global_load_lds((const unsigned*)(Vg + (size_t)(t + 2) * 64 * 2), (LAS unsigned*)(lds + bn + 8192 + ldsw), 16, 0, 0);
            }
#pragma unroll
            for (int kb = 0; kb < 2; ++kb) {
                const LAS unsigned char* kt = lds + bo + (32 * kb + qn) * 128;
                bf16x8 kf[2][2];
#pragma unroll
                for (int sub = 0; sub < 2; ++sub)
#pragma unroll
                    for (int ks = 0; ks < 2; ++ks) kf[sub][ks] = *(const LAS bf16x8*)(kt + (((4 * sub + 2 * ks + hh) ^ rsw) << 4));
                f32x16 S1 = __builtin_amdgcn_mfma_f32_32x32x16_bf16(kf[0][0], qf[0][0], negm, 0, 0, 0);
                S1 = __builtin_amdgcn_mfma_f32_32x32x16_bf16(kf[0][1], qf[0][1], S1, 0, 0, 0);
                f32x16 S2 = __builtin_amdgcn_mfma_f32_32x32x16_bf16(kf[1][0], qf[1][0], negm, 0, 0, 0);
                S2 = __builtin_amdgcn_mfma_f32_32x32x16_bf16(kf[1][1], qf[1][1], S2, 0, 0, 0);
                bf16x8 vf[2][2];
#pragma unroll
                for (int db = 0; db < 2; ++db)
#pragma unroll
                    for (int s = 0; s < 2; ++s) vf[db][s] = *(const LAS bf16x8*)(lds + bo + 8192 + (32 * db + qn) * 128 + (((4 * kb + 2 * s + hh) ^ rsw) << 4));
                unsigned pa[8], pb[8];
#pragma unroll
                for (int i = 0; i < 8; ++i) {
                    const float a0 = __builtin_amdgcn_exp2f(S1[2 * i]), a1 = __builtin_amdgcn_exp2f(S1[2 * i + 1]);
                    const float b0 = __builtin_amdgcn_exp2f(S2[2 * i]), b1 = __builtin_amdgcn_exp2f(S2[2 * i + 1]);
                    l1 += a0 + a1; l2 += b0 + b1;
                    pa[i] = cvt_pk_bf16(a0, a1); pb[i] = cvt_pk_bf16(b0, b1);
                }
                bf16x8 P1[2], P2[2];
#pragma unroll
                for (int s = 0; s < 2; ++s) {
                    const u32x4 wa = {pa[4 * s], pa[4 * s + 1], pa[4 * s + 2], pa[4 * s + 3]}, wb = {pb[4 * s], pb[4 * s + 1], pb[4 * s + 2], pb[4 * s + 3]};
                    P1[s] = *(const bf16x8*)&wa; P2[s] = *(const bf16x8*)&wb;
                }
#pragma unroll
                for (int db = 0; db < 2; ++db)
#pragma unroll
                    for (int s = 0; s < 2; ++s) {
                        O1[db] = __builtin_amdgcn_mfma_f32_32x32x16_bf16(vf[db][s], P1[s], O1[db], 0, 0, 0);
                        O2[db] = __builtin_amdgcn_mfma_f32_32x32x16_bf16(vf[db][s], P2[s], O2[db], 0, 0, 0);
                    }
            }
            if (t + 2 < nkt) asm volatile("s_waitcnt vmcnt(2)" ::: "memory"); else asm volatile("s_waitcnt vmcnt(0)" ::: "memory");
            __builtin_amdgcn_s_barrier();
            bo = bo >= 32768u ? 0u : bo + 16384u;
        }
        }
        l1 += __shfl_xor(l1, 32); l2 += __shfl_xor(l2, 32);
        const float i1 = 1.f / l1, i2 = lam / l2; float ss = 0.f;
#pragma unroll
        for (int db = 0; db < 2; ++db)
#pragma unroll
            for (int i = 0; i < 16; ++i) { const float o = O1[db][i] * i1 - O2[db][i] * i2; O1[db][i] = o; ss += o * o; }
        ss += __shfl_xor(ss, 32);
        const float rs = rsqrtf(ss * (1.f / 64.f) + EPS) * (1.f - lam_init);
        bf16_t* op = WSP(bf16_t, WS_YCAT) + (size_t)orow * DM + 256 + 64 * h + 4 * hh;
        const float* sl = p.subln + l * 64 + 4 * hh;
#pragma unroll
        for (int db = 0; db < 2; ++db)
#pragma unroll
            for (int i = 0; i < 4; ++i) {
                const int d = 32 * db + 8 * i; const f32x4 g = *(const f32x4*)(sl + d);
                u32x2 o; o.x = pk2(O1[db][4 * i] * rs * g.x, O1[db][4 * i + 1] * rs * g.y); o.y = pk2(O1[db][4 * i + 2] * rs * g.z, O1[db][4 * i + 3] * rs * g.w);
                *(u32x2*)(op + d) = o;
            }
    }
    __syncthreads();
}


__device__ __forceinline__ void phase_na_mfma(const Params& p, const int l, LAS unsigned char* lds) {
    const int tid = hid_tid(), wave = __builtin_amdgcn_readfirstlane(tid >> 6), lane = tid & 63, qn = lane & 31, hh = lane >> 5;
    const float* SC = WSP(float, WS_SCAL) + l * 16;
    const int nunits = 256 + (l == 0 ? 32 : 0);
    const int srow = tid >> 3, scq = (tid & 7) ^ ((srow >> 1) & 7);
    const unsigned ldsw = (unsigned)tid * 16u;
    const int rsw = (qn >> 1) & 7;
    LAS float* btab = (LAS float*)(lds + 49152);
    for (int it_ = 0;; ++it_) {
        int u;
        if (gridDim.x == 256) { if (it_ == 0) u = blockIdx.x; else { if (it_ > 1 || nunits <= 256 || blockIdx.x < 224) break; u = 256 + (255 - (int)blockIdx.x); } }
        else { u = blockIdx.x + it_ * (int)gridDim.x; if (u >= nunits) break; }
        const bool cx = u >= 256; const int bh = cx ? u - 256 : (u & 7) * 4 + (u >> 6), rg = (u >> 3) & 7, b = bh >> 2, h = bh & 3;
        __syncthreads();
        for (int i = tid; i < 15 * 32; i += 512) { const int rr = i >> 5, cc = i & 31; btab[i] = cc < 31 ? p.na_rpb[((size_t)(l * 4 + h) * 15 + rr) * 31 + cc] * 1.44269504f : -__builtin_inff(); }
        const int r = 4 * rg + (wave >> 1), qc = 32 * (wave & 1) + qn;
        const int qidx = cx ? 32 * wave + qn : 256 + 64 * r + qc;
        const int orow = cx ? NX + b * LC + 32 * wave + qn : b * SEQ + 64 * r + qc;
        bf16x8 qf[4];
        { const bf16_t* Q = WSP(bf16_t, WS_QA) + ((size_t)bh * KEYS + qidx) * 64;
#pragma unroll
          for (int ks = 0; ks < 4; ++ks) qf[ks] = *(const bf16x8*)(Q + 16 * ks + 8 * hh); }
        int cs = qc - 8; cs = cs < 0 ? 0 : (cs > 48 ? 48 : cs);
        int boff[2][16];
#pragma unroll
        for (int kb = 0; kb < 2; ++kb)
#pragma unroll
            for (int rg2 = 0; rg2 < 16; ++rg2) {
                const int kc = 32 * kb + (rg2 & 3) + 8 * (rg2 >> 2) + 4 * hh;
                int dk = kc - qc; dk = dk < -15 ? -15 : (dk > 15 ? 15 : dk);
                boff[kb][rg2] = ((unsigned)(kc - cs) < 16u) ? 4 * (dk + 15) : 4 * 31;
            }
        int rs = r - 4; rs = rs < 0 ? 0 : (rs > 24 ? 24 : rs);
        int krlo = 4 * rg - 4; krlo = krlo < 0 ? 0 : (krlo > 24 ? 24 : krlo);
        int krhi = 4 * rg - 1; krhi = (krhi < 0 ? 0 : (krhi > 24 ? 24 : krhi)) + 7;
        const int ntile = cx ? 4 : 4 + (krhi - krlo + 1);
        const float negmb = -SC[4 + h];
        f32x16 negm;
#pragma unroll
        for (int i = 0; i < 16; ++i) negm[i] = negmb;
        const char* Kg = (const char*)(WSP(bf16_t, WS_KA) + (size_t)bh * KEYS * 64) + srow * 128 + scq * 16;
        const char* Vg = (const char*)(WSP(bf16_t, WS_VTA) + (size_t)bh * 64 * KEYS) + (size_t)srow * KEYS * 2 + scq * 16;
        f32x16 O[2]; float ls = 0.f;
        for (int trep_ = 0; trep_ < REP_TILE; ++trep_) {
        if (trep_) __syncthreads();
#pragma unroll
        for (int db = 0; db < 2; ++db)
#pragma unroll
            for (int i = 0; i < 16; ++i) O[db][i] = 0.f;
        ls = 0.f;
        __builtin_amdgcn_global_load_lds((const unsigned*)Kg, (LAS unsigned*)(lds + ldsw), 16, 0, 0);
        __builtin_amdgcn_global_load_lds((const unsigned*)Vg, (LAS unsigned*)(lds + 8192 + ldsw), 16, 0, 0);
        __builtin_amdgcn_global_load_lds((const unsigned*)(Kg + (size_t)64 * 128), (LAS unsigned*)(lds + 16384 + ldsw), 16, 0, 0);
        __builtin_amdgcn_global_load_lds((const unsigned*)(Vg + (size_t)64 * 2), (LAS unsigned*)(lds + 16384 + 8192 + ldsw), 16, 0, 0);
        asm volatile("s_waitcnt vmcnt(2)" ::: "memory"); __builtin_amdgcn_s_barrier();
        unsigned bo = 0u;
#pragma unroll 1
        for (int i = 0; i < ntile; ++i) {
            if (i + 2 < ntile) {
                const int tn = (i + 2 < 4) ? i + 2 : 4 + krlo + (i + 2 - 4);
                const unsigned bn = bo == 0u ? 32768u : bo - 16384u;
                __builtin_amdgcn_global_load_lds((const unsigned*)(Kg + (size_t)tn * 64 * 128), (LAS unsigned*)(lds + bn + ldsw), 16, 0, 0);
                __builtin_amdgcn_global_load_lds((const unsigned*)(Vg + (size_t)tn * 64 * 2), (LAS unsigned*)(lds + bn + 8192 + ldsw), 16, 0, 0);
            }
            const int kr = krlo + i - 4;
            const bool local = i >= 4;
            if (!local || (kr >= rs && kr < rs + 8)) {
                const int brow = local ? (kr - r + 7) * 128 : 0;
#pragma unroll
                for (int kb = 0; kb < 2; ++kb) {
                    const LAS unsigned char* kt = lds + bo + (32 * kb + qn) * 128;
                    bf16x8 kf[4];
#pragma unroll
                    for (int ks = 0; ks < 4; ++ks) kf[ks] = *(const LAS bf16x8*)(kt + (((2 * ks + hh) ^ rsw) << 4));
                    f32x16 S = __builtin_amdgcn_mfma_f32_32x32x16_bf16(kf[0], qf[0], negm, 0, 0, 0);
#pragma unroll
                    for (int ks = 1; ks < 4; ++ks) S = __builtin_amdgcn_mfma_f32_32x32x16_bf16(kf[ks], qf[ks], S, 0, 0, 0);
                    bf16x8 vf[2][2];
#pragma unroll
                    for (int db = 0; db < 2; ++db)
#pragma unroll
                        for (int s = 0; s < 2; ++s) vf[db][s] = *(const LAS bf16x8*)(lds + bo + 8192 + (32 * db + qn) * 128 + (((4 * kb + 2 * s + hh) ^ rsw) << 4));
                    if (local) {
#pragma unroll
                        for (int rg2 = 0; rg2 < 16; ++rg2) S[rg2] += *(const LAS float*)((const LAS unsigned char*)btab + brow + boff[kb][rg2]);
                    }
                    unsigned pa[8];
#pragma unroll
                    for (int j = 0; j < 8; ++j) {
                        const float a0 = __builtin_amdgcn_exp2f(S[2 * j]), a1 = __builtin_amdgcn_exp2f(S[2 * j + 1]);
                        ls += a0 + a1; pa[j] = pk2(a0, a1);
                    }
                    bf16x8 P[2];
#pragma unroll
                    for (int s = 0; s < 2; ++s) { const u32x4 wa = {pa[4 * s], pa[4 * s + 1], pa[4 * s + 2], pa[4 * s + 3]}; P[s] = *(const bf16x8*)&wa; }
#pragma unroll
                    for (int db = 0; db < 2; ++db)
#pragma unroll
                        for (int s = 0; s < 2; ++s) O[db] = __builtin_amdgcn_mfma_f32_32x32x16_bf16(vf[db][s], P[s], O[db], 0, 0, 0);
                }
            }
            if (i + 2 < ntile) asm volatile("s_waitcnt vmcnt(2)" ::: "memory"); else asm volatile("s_waitcnt vmcnt(0)" ::: "memory");
            __builtin_amdgcn_s_barrier();
            bo = bo >= 32768u ? 0u : bo + 16384u;
        }
        }
        ls += __shfl_xor(ls, 32);
        const float il = 1.f / ls;
        bf16_t* op = WSP(bf16_t, WS_YCAT) + (size_t)orow * DM + 64 * h + 4 * hh;
#pragma unroll
        for (int db = 0; db < 2; ++db)
#pragma unroll
            for (int i = 0; i < 4; ++i) {
                u32x2 o; o.x = pk2(O[db][4 * i] * il, O[db][4 * i + 1] * il); o.y = pk2(O[db][4 * i + 2] * il, O[db][4 * i + 3] * il);
                *(u32x2*)(op + 32 * db + 8 * i) = o;
            }
    }
    __syncthreads();
}

constexpr int RB = 72;
constexpr int HSTR = 2064;
__device__ __forceinline__ void phase_route(const Params& p, const int l, unsigned char* smem, const int cnt_off) {
    unsigned char* HN = smem;
    float* LOGIT = (float*)(smem + RB * HSTR);
    int* hist = (int*)(smem + RB * HSTR + RB * 32 * 4); int* base = hist + 32; int* s_e = base + 32; int* s_lp = s_e + RB * 4; float* s_g = (float*)(s_lp + RB * 4);
    const int tid = hid_tid(), lane = tid & 63, wave = tid >> 6, fr = lane & 15, fq = lane >> 4;
    const int nrows = (l == 0) ? NT : NX;
    const float* MOD = WSP(float, WS_MOD); unsigned char* H8 = WSP(unsigned char, WS_H8); const bf16_t* X1 = WSP(bf16_t, WS_X1);
    const bf16_t* RWT = WSP(bf16_t, WS_RWT) + (size_t)l * 32 * 1024;
    int* cnt = WSP(int, WS_CTL + CTL_CNT + cnt_off) + l * 32;
    int *RTE = WSP(int, WS_RTE), *RTP = WSP(int, WS_RTP), *LIST = WSP(int, WS_LIST); float* RTG = WSP(float, WS_RTG);
    const float rb0 = p.router_b[l * 32 + fr], rb1 = p.router_b[l * 32 + 16 + fr];
    for (int r0 = blockIdx.x * RB; r0 < nrows; r0 += gridDim.x * RB) {
        __syncthreads();
        if (tid < 32) hist[tid] = 0;
        const int nr = (nrows - r0) < RB ? (nrows - r0) : RB;
        u32x2 vn[4];
        if (wave < nr) {
#pragma unroll
            for (int j = 0; j < 4; ++j) vn[j] = ((const u32x2*)(X1 + (size_t)(r0 + wave) * DM))[lane + 64 * j];
        }
        int cmi = -1; f32x4 mA[4], mB[4];
        for (int i = wave; i < nr; i += 8) {
            const int r = r0 + i;
            if (mod_index(r) != cmi) {
                cmi = mod_index(r);
                const float* m = MOD + (size_t)(l * 9 + cmi) * 6144; const float* gw = p.g2w + l * 1024;
#pragma unroll
                for (int j = 0; j < 4; ++j) { const int c = 4 * lane + 256 * j; const f32x4 g = *(const f32x4*)(gw + c), s1 = *(const f32x4*)(m + 4 * 1024 + c);
                    mA[j].x = g.x * (1.f + s1.x); mA[j].y = g.y * (1.f + s1.y); mA[j].z = g.z * (1.f + s1.z); mA[j].w = g.w * (1.f + s1.w); mB[j] = *(const f32x4*)(m + 3 * 1024 + c); }
            }
            f32x4 v[4]; float ss = 0.f;
#pragma unroll
            for (int j = 0; j < 4; ++j) { v[j] = (f32x4){bflo(vn[j].x), bfhi(vn[j].x), bflo(vn[j].y), bfhi(vn[j].y)}; ss += v[j].x * v[j].x + v[j].y * v[j].y + v[j].z * v[j].z + v[j].w * v[j].w; }
            if (i + 8 < nr) {
#pragma unroll
                for (int j = 0; j < 4; ++j) vn[j] = ((const u32x2*)(X1 + (size_t)(r + 8) * DM))[lane + 64 * j];
            }
            ss = wave_sum_fast(ss);
            const float rs = rsqrtf(ss * (1.f / DM) + EPS);
#pragma unroll
            for (int j = 0; j < 4; ++j) {
                const int c = 4 * lane + 256 * j;
                f32x4 o;
                o.x = v[j].x * rs * mA[j].x + mB[j].x; o.y = v[j].y * rs * mA[j].y + mB[j].y;
                o.z = v[j].z * rs * mA[j].z + mB[j].z; o.w = v[j].w * rs * mA[j].w + mB[j].w;
                *(unsigned*)(H8 + (size_t)r * DM + c) = pk4_fp8(fminf(fmaxf(o.x * SH8, -448.f), 448.f), fminf(fmaxf(o.y * SH8, -448.f), 448.f), fminf(fmaxf(o.z * SH8, -448.f), 448.f), fminf(fmaxf(o.w * SH8, -448.f), 448.f));
                u32x2 hb; hb.x = pk2(o.x, o.y); hb.y = pk2(o.z, o.w);
                *(u32x2*)(HN + i * HSTR + c * 2) = hb;
            }
        }
        __syncthreads();
        if (wave < 5 && 16 * wave < nr) {
            f32x4 a0 = {0.f, 0.f, 0.f, 0.f}, a1 = {0.f, 0.f, 0.f, 0.f};
            const unsigned char* arow = HN + (16 * wave + fr) * HSTR + fq * 16;
            const bf16_t* b0p = RWT + (size_t)fr * 1024 + fq * 8; const bf16_t* b1p = b0p + 16 * 1024;
#pragma unroll 8
            for (int ks = 0; ks < 32; ++ks) {
                const bf16x8 a = *(const bf16x8*)(arow + ks * 64);
                const bf16x8 b0 = *(const bf16x8*)(b0p + ks * 32), b1 = *(const bf16x8*)(b1p + ks * 32);
                a0 = __builtin_amdgcn_mfma_f32_16x16x32_bf16(a, b0, a0, 0, 0, 0);
                a1 = __builtin_amdgcn_mfma_f32_16x16x32_bf16(a, b1, a1, 0, 0, 0);
            }
#pragma unroll
            for (int q = 0; q < 4; ++q) { const int row = 16 * wave + 4 * fq + q; if (row < nr) { LOGIT[row * 32 + fr] = a0[q] + rb0; LOGIT[row * 32 + 16 + fr] = a1[q] + rb1; } }
        }
        __syncthreads();
        for (int i = wave; i < nr; i += 8) {
            const float logit = LOGIT[i * 32 + (lane & 31)];
            float tv[4]; int ti[4];
            {
                const int me = lane & 31; int rank = 0;
#pragma unroll
                for (int e = 0; e < 32; ++e) { const float ov = __builtin_bit_cast(float, __builtin_amdgcn_readlane(__builtin_bit_cast(int, logit), e)); rank += ((ov > logit) || (ov == logit && e < me)) ? 1 : 0; }
#pragma unroll
                for (int k = 0; k < 4; ++k) {
                    const unsigned long long mk = __ballot(rank == k);
                    const int srcl = __builtin_amdgcn_readfirstlane((int)__builtin_ctzll(mk));
                    ti[k] = srcl & 31; tv[k] = __builtin_bit_cast(float, __builtin_amdgcn_readlane(__builtin_bit_cast(int, logit), srcl));
                }
            }
            const float e1 = __expf(tv[1] - tv[0]), e2 = __expf(tv[2] - tv[0]), e3 = __expf(tv[3] - tv[0]); const float inv = 1.f / (1.f + e1 + e2 + e3);
            if (lane < 4) {
                const int te = lane == 0 ? ti[0] : lane == 1 ? ti[1] : lane == 2 ? ti[2] : ti[3];
                const float tg = (lane == 0 ? 1.f : lane == 1 ? e1 : lane == 2 ? e2 : e3) * inv;
                s_e[i * 4 + lane] = te; s_g[i * 4 + lane] = tg; s_lp[i * 4 + lane] = atomicAdd(&hist[te], 1);
            }
        }
        __syncthreads();
        if (tid < 32) base[tid] = hist[tid] ? atomicAdd(&cnt[tid], hist[tid]) : 0;
        __syncthreads();
        for (int i = tid; i < nr * 4; i += 512) {
            const int r = r0 + (i >> 2), e = s_e[i], pos = base[e] + s_lp[i];
            RTE[(size_t)r * 4 + (i & 3)] = e; RTP[(size_t)r * 4 + (i & 3)] = pos; RTG[(size_t)r * 4 + (i & 3)] = s_g[i];
            LIST[(size_t)e * NT + pos] = r;
        }
    }
    __syncthreads();
}

__device__ __forceinline__ void phase_combine(const Params& p, const int l, const int* tinfo) {
    const int tid = hid_tid(), lane = tid & 63, wave = tid >> 6;
    const int gw = blockIdx.x * 8 + wave, ngw = gridDim.x * 8;
    const int nrows = (l == 0) ? NT : NX;
    const float* MOD = WSP(float, WS_MOD); const bf16_t* X1 = WSP(bf16_t, WS_X1); const unsigned char* Y2 = WSP(unsigned char, WS_Y2);
    const int *RTE = WSP(int, WS_RTE), *RTP = WSP(int, WS_RTP); const float* RTG = WSP(float, WS_RTG);
    int ne[4], np_[4]; float ng[4];
    if (gw < nrows) {
#pragma unroll
        for (int k = 0; k < 4; ++k) { ne[k] = RTE[(size_t)gw * 4 + k]; np_[k] = RTP[(size_t)gw * 4 + k]; ng[k] = RTG[(size_t)gw * 4 + k]; }
    }
    int cmi = -1; f32x4 g2v[4], nA[4], nB[4];
    for (int r = gw; r < nrows; r += ngw) {
        if (mod_index(r) != cmi) {
            cmi = mod_index(r);
            const float* g2 = MOD + (size_t)(l * 9 + cmi) * 6144 + 5 * 1024; const float* m = MOD + (size_t)(1 * 9 + cmi) * 6144;
#pragma unroll
            for (int j = 0; j < 4; ++j) { const int c = 4 * lane + 256 * j; g2v[j] = *(const f32x4*)(g2 + c);
                if (l == 0) { const f32x4 g = *(const f32x4*)(p.g1w + 1024 + c), s1 = *(const f32x4*)(m + 1024 + c);
                    nA[j].x = g.x * (1.f + s1.x); nA[j].y = g.y * (1.f + s1.y); nA[j].z = g.z * (1.f + s1.z); nA[j].w = g.w * (1.f + s1.w); nB[j] = *(const f32x4*)(m + c); } }
        }
        const unsigned char* yr[4]; float gk[4];
#pragma unroll
        for (int k = 0; k < 4; ++k) { yr[k] = Y2 + ((size_t)tinfo[ne[k]] * 256 + np_[k]) * DM; gk[k] = ng[k] * (1.f / SY8); }
        unsigned yv[4][4]; u32x2 x1v[4]; f32x4 gv[4];
#pragma unroll
        for (int j = 0; j < 4; ++j) {
            const int c = 4 * lane + 256 * j;
#pragma unroll
            for (int k = 0; k < 4; ++k) yv[j][k] = *(const unsigned*)(yr[k] + c);
            x1v[j] = *(const u32x2*)(X1 + (size_t)r * DM + c); gv[j] = g2v[j];
        }
        if (r + ngw < nrows) {
#pragma unroll
            for (int k = 0; k < 4; ++k) { ne[k] = RTE[(size_t)(r + ngw) * 4 + k]; np_[k] = RTP[(size_t)(r + ngw) * 4 + k]; ng[k] = RTG[(size_t)(r + ngw) * 4 + k]; }
        }
        f32x4 xv[4];
#pragma unroll
        for (int j = 0; j < 4; ++j) {
            const int c = 4 * lane + 256 * j;
            float s[4] = {0.f, 0.f, 0.f, 0.f};
#pragma unroll
            for (int k = 0; k < 4; ++k) { const f32x2 ya = __builtin_amdgcn_cvt_pk_f32_fp8((int)yv[j][k], false), yb = __builtin_amdgcn_cvt_pk_f32_fp8((int)yv[j][k], true); s[0] += gk[k] * ya.x; s[1] += gk[k] * ya.y; s[2] += gk[k] * yb.x; s[3] += gk[k] * yb.y; }
            const f32x4 x1 = {bflo(x1v[j].x), bfhi(x1v[j].x), bflo(x1v[j].y), bfhi(x1v[j].y)}, g = gv[j];
            f32x4 o; o.x = x1.x + g.x * s[0]; o.y = x1.y + g.y * s[1]; o.z = x1.z + g.z * s[2]; o.w = x1.w + g.w * s[3];
            if (l == 0) { u32x2 ob; ob.x = pk2(o.x, o.y); ob.y = pk2(o.z, o.w); *(u32x2*)(WSP(bf16_t, WS_X2) + (size_t)r * DM + c) = ob; }
            else *(f32x4*)(p.out + (size_t)r * DM + c) = o;
            xv[j] = o;
        }
        if (l == 0) {
            float ss = 0.f;
#pragma unroll
            for (int j = 0; j < 4; ++j) ss += xv[j].x * xv[j].x + xv[j].y * xv[j].y + xv[j].z * xv[j].z + xv[j].w * xv[j].w;
            ss = wave_sum_fast(ss); const float rs = rsqrtf(ss * (1.f / DM) + EPS);
            bf16_t* hrow = WSP(bf16_t, WS_H) + (size_t)r * DM;
#pragma unroll
            for (int j = 0; j < 4; ++j) {
                const int c = 4 * lane + 256 * j;
                u32x2 pk; pk.x = pk2(xv[j].x * rs * nA[j].x + nB[j].x, xv[j].y * rs * nA[j].y + nB[j].y);
                pk.y = pk2(xv[j].z * rs * nA[j].z + nB[j].z, xv[j].w * rs * nA[j].w + nB[j].w);
                *(u32x2*)(hrow + c) = pk;
            }
        }
    }
}

#define XB_TMO      128
#define XB_XCNT(j)  (256  + 64 * (j))
#define XB_XSUB(j)  (1280 + 64 * (j))
#define XB_XGEN(j)  (2304 + 64 * (j))
#define XB_TOP      3328
#define XB_TOPGEN   3392
#define XCD_BAR_WORDS 3456
#define XB_SPIN_CAP (1u << 18)
__device__ __forceinline__ unsigned xb_ld(unsigned* p)              { return __hip_atomic_load(p, __ATOMIC_RELAXED, __HIP_MEMORY_SCOPE_AGENT); }
__device__ __forceinline__ unsigned xb_add(unsigned* p, unsigned v) { return __hip_atomic_fetch_add(p, v, __ATOMIC_RELAXED, __HIP_MEMORY_SCOPE_AGENT); }
__device__ __forceinline__ unsigned xb_xcc_id() { return (unsigned)__builtin_amdgcn_s_getreg((3 << 11) | 20) & 0xFu; }
#define XB_SPIN(cond, bar) do { unsigned _sp = 0; while (cond) { __builtin_amdgcn_s_sleep(1); \
    if ((++_sp & 255u) == 0u) { if (xb_ld(&(bar)[XB_TMO])) break; if (_sp > XB_SPIN_CAP) { atomicAdd(&(bar)[XB_TMO], 1u); break; } } } } while (0)
struct XcdBarrier { unsigned* bar; unsigned x; volatile LAS unsigned* st; };
__device__ __forceinline__ XcdBarrier xcd_barrier_post(unsigned* bar, volatile LAS unsigned* st) {
    XcdBarrier b; b.bar = bar; b.x = xb_xcc_id(); b.st = st;
    if (threadIdx.x == 0) (void)xb_add(&bar[XB_XCNT(b.x)], 1u);
    return b;
}
__device__ __forceinline__ void xcd_barrier_complete(unsigned* bar, unsigned x, unsigned& nloc, unsigned& nx) {
    const unsigned G = gridDim.x * gridDim.y * gridDim.z;
    unsigned sum, cnt, mine, sp = 0u;
    for (;;) {
        sum = 0u; cnt = 0u; mine = 0u;
#pragma unroll
        for (unsigned j = 0; j < 16; ++j) { const unsigned c = xb_ld(&bar[XB_XCNT(j)]); sum += c; cnt += (c > 0u) ? 1u : 0u; mine = (j == x) ? c : mine; }
        if (sum == G) break;
        __builtin_amdgcn_s_sleep(1);
        if ((++sp & 255u) == 0u) { if (xb_ld(&bar[XB_TMO])) break; if (sp > XB_SPIN_CAP) { atomicAdd(&bar[XB_TMO], 1u); break; } }
    }
    nloc = mine > 0u ? mine : 1u; nx = cnt > 0u ? cnt : 1u;
}
__device__ __forceinline__ void xcd_barrier(const XcdBarrier& b) {
    asm volatile("s_waitcnt vmcnt(0)" ::: "memory");
    __syncthreads();
    if (threadIdx.x == 0) {
        unsigned* bar = b.bar;
        __builtin_amdgcn_s_waitcnt(0);
        unsigned nloc = b.st[0], nx = b.st[1];
        if (nloc == 0u) { xcd_barrier_complete(bar, b.x, nloc, nx); b.st[0] = nloc; b.st[1] = nx; }
        const unsigned old = xb_add(&bar[XB_XSUB(b.x)], 1u);
        const unsigned gen = old / nloc;
        if (old + 1u == (gen + 1u) * nloc) {
            __builtin_amdgcn_fence(__ATOMIC_RELEASE, "agent");
            asm volatile("s_waitcnt vmcnt(0)" ::: "memory");
            const unsigned og = xb_add(&bar[XB_TOP], 1u);
            const unsigned tg = og / nx;
            if (og + 1u == (tg + 1u) * nx) xb_add(&bar[XB_TOPGEN], 1u);
            else XB_SPIN(xb_ld(&bar[XB_TOPGEN]) == tg, bar);
            __builtin_amdgcn_fence(__ATOMIC_ACQUIRE, "agent");
            xb_add(&bar[XB_XGEN(b.x)], 1u);
            asm volatile("s_waitcnt vmcnt(0)" ::: "memory");
        } else {
            XB_SPIN(xb_ld(&bar[XB_XGEN(b.x)]) == gen, bar);
            __builtin_amdgcn_fence(__ATOMIC_ACQUIRE, "agent");
            asm volatile("s_waitcnt vmcnt(0)" ::: "memory");
        }
    }
    __syncthreads();
}

constexpr int LDS_BYTES = 163840;
constexpr int MISC_OFF = LDS_BYTES - 2048;
constexpr int NCH_L = 3072;
constexpr size_t CTL_CHUNK = 40960, CTL_DONE = 41472;
__device__ __forceinline__ void conv_item(const Params& p, unsigned char* smem, int l, int q, int wave, int lane) {
    unsigned char* tsm = smem + wave * (64 * 144);
    if (q < 16384) { const int m = l * 32 + (q >> 9), r = q & 511; transpose_item8(p.w1 + (size_t)m * 1024 * 2048, 2048, 1024, WSP(unsigned char, WS_W1) + (size_t)m * 2048 * 1024, tsm, r & 15, r >> 4, lane); }
    else { const int q2 = q - 16384, m = l * 32 + (q2 >> 8), r = q2 & 255; transpose_item8(p.w2 + (size_t)m * 1024 * 1024, 1024, 1024, WSP(unsigned char, WS_W2) + (size_t)m * 1024 * 1024, tsm, r & 15, r >> 4, lane); }
}
__device__ __forceinline__ void idle_fill(const Params& p, unsigned char* smem, const int phase, const int l) {
    const int tid = hid_tid(), lane = tid & 63, wave = tid >> 6;
    volatile int* cslot = (volatile int*)(smem + MISC_OFF + 512);
    unsigned* chunk = WSP(unsigned, WS_CTL + CTL_CHUNK + 256 * l); unsigned* done = WSP(unsigned, WS_CTL + CTL_DONE + 256 * phase);
    __syncthreads();
    if (tid == 0) {
        __hip_atomic_fetch_add(done, 1u, __ATOMIC_RELAXED, __HIP_MEMORY_SCOPE_AGENT);
        int c = -1;
        if (__hip_atomic_load(done, __ATOMIC_RELAXED, __HIP_MEMORY_SCOPE_AGENT) < gridDim.x) { const unsigned g = __hip_atomic_fetch_add(chunk, 1u, __ATOMIC_RELAXED, __HIP_MEMORY_SCOPE_AGENT); if (g < (unsigned)NCH_L) c = (int)g; }
        cslot[0] = c;
    }
    __syncthreads();
    int c = cslot[0];
    while (c >= 0) {
        __syncthreads();
        unsigned gnext = 0xffffffffu; bool more = false;
        if (tid == 0) { more = __hip_atomic_load(done, __ATOMIC_RELAXED, __HIP_MEMORY_SCOPE_AGENT) < gridDim.x; if (more) gnext = __hip_atomic_fetch_add(chunk, 1u, __ATOMIC_RELAXED, __HIP_MEMORY_SCOPE_AGENT); }
        conv_item(p, smem, l, c * 8 + wave, wave, lane);
        if (tid == 0) cslot[0] = (more && gnext < (unsigned)NCH_L) ? (int)gnext : -1;
        __syncthreads();
        c = cslot[0];
    }
}
__device__ __forceinline__ void conv_drain(const Params& p, unsigned char* smem, const int l) {
    const int tid = hid_tid(), lane = tid & 63, wave = tid >> 6;
    const int gw = blockIdx.x * 8 + wave, ngw = gridDim.x * 8;
    unsigned cst = __hip_atomic_load(WSP(unsigned, WS_CTL + CTL_CHUNK + 256 * l), __ATOMIC_RELAXED, __HIP_MEMORY_SCOPE_AGENT);
    cst = cst > (unsigned)NCH_L ? (unsigned)NCH_L : cst;
    __syncthreads();
    for (int q = (int)cst * 8 + gw; q < NCH_L * 8; q += ngw) conv_item(p, smem, l, q, wave, lane);
    __syncthreads();
}

__global__ void __launch_bounds__(512, 2) k_fwd(Params p) {
    extern __shared__ __attribute__((aligned(16))) unsigned char smem[];
    int* tinfo = (int*)(smem + MISC_OFF + 64);
    if (threadIdx.x < 4) ((unsigned*)(smem + MISC_OFF))[threadIdx.x] = 0u;
    __syncthreads();
    XcdBarrier bar = xcd_barrier_post(WSP(unsigned, WS_CTL), (volatile LAS unsigned*)(smem + MISC_OFF));
    phase_pro0(p, smem);
    __syncthreads();
    REPEAT(REP_PRO1, phase_pro1(p, smem); __syncthreads());
    xcd_barrier(bar);
#define LAYER(l) do { \
        REPEAT(REP_WIN, gemm_phase256<G_WIN>(p, l, (LAS unsigned char*)smem, tinfo)); \
        REPEAT(REP_BAR, xcd_barrier(bar)); \
        REPEAT(REP_PREP, phase_prep(p, l, smem); __syncthreads()); \
        REPEAT(REP_BAR, xcd_barrier(bar)); \
          \
        REPEAT(REP_DFT, gemm_phase256<G_DFT>(p, l, (LAS unsigned char*)smem, tinfo)); \
        if (l == 0) gemm_phase256<G_DFTC>(p, l, (LAS unsigned char*)smem, tinfo); \
        __syncthreads(); \
        REPEAT(REP_DF, phase_df_mfma(p, l, (LAS unsigned char*)smem)); \
        REPEAT(REP_NA, phase_na_mfma(p, l, (LAS unsigned char*)smem)); \
        idle_fill(p, smem, 3 + 8 * l, l); \
        REPEAT(REP_BAR, xcd_barrier(bar)); \
        REPEAT(REP_WOUT, gemm_phase256<G_WOUT>(p, l, (LAS unsigned char*)smem, tinfo)); \
        if (l == 0) idle_fill(p, smem, 4 + 8 * l, l); \
        REPEAT(REP_BAR, xcd_barrier(bar)); \
        if (REP_ROUTE > 1) { phase_route(p, l, smem, 1024); __syncthreads(); } \
        phase_route(p, l, smem, 0); \
        conv_drain(p, smem, l); \
        REPEAT(REP_BAR, xcd_barrier(bar)); \
        moe_tinfo(p, l, tinfo); \
        REPEAT(REP_MOE1, gemm_phase256<G_MOE1>(p, l, (LAS unsigned char*)smem, tinfo)); \
        if (l == 0) idle_fill(p, smem, 5, 1);         \
        REPEAT(REP_BAR, xcd_barrier(bar)); \
        REPEAT(REP_MOE2, gemm_phase256<G_MOE2>(p, l, (LAS unsigned char*)smem, tinfo)); \
        if (l == 0) idle_fill(p, smem, 6, 1); \
        REPEAT(REP_BAR, xcd_barrier(bar)); \
        REPEAT(REP_COMB, phase_combine(p, l, tinfo)); \
        if (l == 0) xcd_barrier(bar); \
    } while (0)
    LAYER(0);
    LAYER(1);
#undef LAYER
}

extern "C" void kernel_launch(void* const* d_in, const int* in_sizes, int n_in, void* d_out, int out_size, void* d_ws, size_t ws_size, hipStream_t stream) {
    static int grid = 0;
    if (n_in != 29 || ws_size < WS_END) { fprintf(stderr, "kernel_launch: need 29 inputs and %zu bytes of workspace (got %d, %zu)\n", (size_t)WS_END, n_in, ws_size); return; }
    if (!grid) {
        int dev = 0, cus = 0, per_cu = 0;
        (void)hipGetDevice(&dev);
        (void)hipDeviceGetAttribute(&cus, hipDeviceAttributeMultiprocessorCount, dev);
        (void)hipFuncSetAttribute((const void*)k_fwd, hipFuncAttributeMaxDynamicSharedMemorySize, LDS_BYTES);
        (void)hipOccupancyMaxActiveBlocksPerMultiprocessor(&per_cu, (const void*)k_fwd, 512, LDS_BYTES);
        if (per_cu < 1) fprintf(stderr, "kernel_launch: occupancy query reports %d workgroups per CU\n", per_cu);
        grid = cus > 0 ? cus : 256;
    }
    Params p;
    const float** pp = (const float**)&p;
    for (int i = 0; i < 29; ++i) pp[i] = (const float*)d_in[i];
    p.out = (float*)d_out; p.ws = (unsigned char*)d_ws;
    (void)hipMemsetAsync((char*)d_ws + WS_CTL, 0, CTL_BYTES, stream);
    hipLaunchKernelGGL(k_fwd, dim3(grid), dim3(512), LDS_BYTES, stream, p);
}
```

```cpp
#include <hip/hip_runtime.h>
#include <cstdio>
#include <cstdint>

#define REP_PRO0 1
#define REP_TILE 1
#define REP_EPI 1
#define REP_KL8 1
#define REP_KL16 1
#define REP_ROUTE 1
#define REP_BAR 1
#define REP_PRO1 1
#define REP_TR 1
#define REP_FOLD 1
#define REP_WIN 1
#define REP_PREP 1
#define REP_DF 1
#define REP_NA 1
#define REP_DFT 1
#define REP_WOUT 1
#define REP_MOE1 1
#define REP_MOE2 1
#define REP_COMB 1
#define REPEAT(n, stmt) do { _Pragma("unroll") for (int _r = 0; _r < (n); ++_r) { stmt; } } while (0)
typedef unsigned short bf16_t;
typedef short bf16x8 __attribute__((ext_vector_type(8)));
typedef float f32x4 __attribute__((ext_vector_type(4)));
typedef float f32x16 __attribute__((ext_vector_type(16)));
typedef float f32x2 __attribute__((ext_vector_type(2)));
typedef unsigned u32x4 __attribute__((ext_vector_type(4)));
typedef unsigned u32x2 __attribute__((ext_vector_type(2)));
typedef int i32x8 __attribute__((ext_vector_type(8)));
constexpr float SW8 = 64.f, SH8 = 16.f, SA8 = 4.f, SY8 = 16.f;

constexpr int NB = 8, SEQ = 2048, DM = 1024, LC = 256;
constexpr int NX = NB * SEQ, NC = NB * LC, NT = NX + NC;
constexpr int NIN = 2304;
constexpr int NE = 32, FF = 1024, KEYS = LC + SEQ;
constexpr int MAXSLOT = 81920;
constexpr float EPS = 1e-6f;

constexpr size_t al256(size_t x) { return (x + 255) & ~(size_t)255; }
constexpr size_t WS_CTL   = 0;
constexpr size_t CTL_BYTES = 65536;
constexpr size_t CTL_CNT  = 32768;
constexpr size_t CTL_PRO0 = 49152;
constexpr size_t WS_MOD   = WS_CTL + CTL_BYTES;
constexpr size_t WS_SCAL  = al256(WS_MOD + (size_t)2 * 9 * 6144 * 4);
constexpr size_t WS_ROPE  = al256(WS_SCAL + 2 * 16 * 4);
constexpr size_t WS_WIN   = al256(WS_ROPE + 64 * 8 * 2 * 4);
constexpr size_t WS_WOUT  = al256(WS_WIN + (size_t)2 * NIN * DM * 2);
constexpr size_t WS_W1    = al256(WS_WOUT + (size_t)2 * DM * DM * 2);
constexpr size_t WS_W2    = al256(WS_W1 + (size_t)2 * NE * 2048 * DM * 2);
constexpr size_t WS_DFTM  = al256(WS_W2 + (size_t)2 * NE * DM * FF * 2);
constexpr size_t WS_DFTC  = al256(WS_DFTM + (size_t)2048 * 2048 * 2);
constexpr size_t WS_H     = al256(WS_DFTC + (size_t)256 * 256 * 2);
constexpr size_t WS_PX    = al256(WS_H + (size_t)NT * DM * 2);
constexpr size_t QKV_ONE  = (size_t)NB * 4 * KEYS * 64 * 2;
constexpr size_t WS_QA    = al256(WS_PX + (size_t)NT * NIN * 2);
constexpr size_t WS_KA    = al256(WS_QA + QKV_ONE);
constexpr size_t WS_VTA   = al256(WS_KA + QKV_ONE);
constexpr size_t WS_QD    = al256(WS_VTA + QKV_ONE);
constexpr size_t WS_KD    = al256(WS_QD + QKV_ONE);
constexpr size_t WS_VTD   = al256(WS_KD + QKV_ONE);
constexpr size_t WS_XF    = al256(WS_VTD + QKV_ONE);
constexpr size_t WS_XFC   = al256(WS_XF + (size_t)2048 * 2048 * 2);
constexpr size_t WS_YCAT  = al256(WS_XFC + (size_t)2048 * 256 * 2);
constexpr size_t WS_X1    = al256(WS_YCAT + (size_t)NT * DM * 2);
constexpr size_t WS_X2    = al256(WS_X1 + (size_t)NT * DM * 4);
constexpr size_t WS_RTE   = al256(WS_X2 + (size_t)NT * DM * 4);
constexpr size_t WS_RTP   = al256(WS_RTE + (size_t)NT * 4 * 4);
constexpr size_t WS_RTG   = al256(WS_RTP + (size_t)NT * 4 * 4);
constexpr size_t WS_LIST  = al256(WS_RTG + (size_t)NT * 4 * 4);
constexpr size_t WS_ACT   = al256(WS_LIST + (size_t)NE * NT * 4);
constexpr size_t WS_Y2    = al256(WS_ACT + (size_t)MAXSLOT * FF * 2);
constexpr size_t WS_H8    = al256(WS_Y2 + (size_t)MAXSLOT * DM * 2);
constexpr size_t WS_RWT   = al256(WS_H8 + (size_t)NT * DM);
constexpr size_t WS_END   = al256(WS_RWT + (size_t)2 * NE * DM * 2);

struct Params {
    const float *x, *c, *ctx, *c_ctx, *w_ada, *b_ada, *g1w, *g2w, *w_in, *w_out, *na_qg, *na_kg, *na_rpb, *df_qg, *df_kg,
                *lq1, *lk1, *lq2, *lk2, *subln, *pool_w, *pool_scale, *fft_w, *router_w, *router_b, *w1, *b1, *w2, *b2;
    float* out;
    unsigned char* ws;
};
typedef __attribute__((address_space(1))) unsigned char g_u8;
__device__ __forceinline__ unsigned char* ws_base(unsigned char* w) { g_u8* g = (g_u8*)w; asm volatile("" : "+s"(g)); return (unsigned char*)g; }
#define WSP(T, off) ((T*)(ws_base(p.ws) + (off)))

__device__ __forceinline__ unsigned pk2(float lo, float hi) {
    typedef __bf16 bf2 __attribute__((ext_vector_type(2)));
    bf2 r = __builtin_convertvector((f32x2){lo, hi}, bf2);
    return *(unsigned*)&r;
}
__device__ __forceinline__ unsigned pk4_fp8(float a, float b, float c, float d) { int r = 0; r = __builtin_amdgcn_cvt_pk_fp8_f32(a, b, r, false); r = __builtin_amdgcn_cvt_pk_fp8_f32(c, d, r, true); return (unsigned)r; }
__device__ __forceinline__ bf16_t f2bf(float f) { return (bf16_t)(pk2(f, 0.f) & 0xffffu); }
__device__ __forceinline__ float bflo(unsigned u) { return __uint_as_float(u << 16); }
__device__ __forceinline__ float bfhi(unsigned u) { return __uint_as_float(u & 0xffff0000u); }
__device__ __forceinline__ float bf2f(bf16_t b) { return __uint_as_float(((unsigned)b) << 16); }
__device__ __forceinline__ float wave_sum(float v) {
#pragma unroll
    for (int o = 1; o < 64; o <<= 1) v += __shfl_xor(v, o);
    return v;
}
#define DPP_F(v, ctrl) __builtin_bit_cast(float, __builtin_amdgcn_update_dpp(0, __builtin_bit_cast(int, (v)), (ctrl), 0xf, 0xf, true))
__device__ __forceinline__ float sum8_dpp(float v)  { v += DPP_F(v, 0xB1); v += DPP_F(v, 0x4E); v += DPP_F(v, 0x141); return v; }
__device__ __forceinline__ float sum16_dpp(float v) { v += DPP_F(v, 0xB1); v += DPP_F(v, 0x4E); v += DPP_F(v, 0x141); v += DPP_F(v, 0x140); return v; }
__device__ __forceinline__ float wave_sum_fast(float v) {
    v += __builtin_bit_cast(float, __builtin_amdgcn_update_dpp(0, __builtin_bit_cast(int, v), 0xB1, 0xf, 0xf, true));
    v += __builtin_bit_cast(float, __builtin_amdgcn_update_dpp(0, __builtin_bit_cast(int, v), 0x4E, 0xf, 0xf, true));
    v += __builtin_bit_cast(float, __builtin_amdgcn_update_dpp(0, __builtin_bit_cast(int, v), 0x141, 0xf, 0xf, true));
    v += __builtin_bit_cast(float, __builtin_amdgcn_update_dpp(0, __builtin_bit_cast(int, v), 0x140, 0xf, 0xf, true));
    const float a = __builtin_bit_cast(float, __builtin_amdgcn_readlane(__builtin_bit_cast(int, v), 0)), b = __builtin_bit_cast(float, __builtin_amdgcn_readlane(__builtin_bit_cast(int, v), 16));
    const float c = __builtin_bit_cast(float, __builtin_amdgcn_readlane(__builtin_bit_cast(int, v), 32)), d = __builtin_bit_cast(float, __builtin_amdgcn_readlane(__builtin_bit_cast(int, v), 48));
    return (a + b) + (c + d);
}
__device__ __forceinline__ float wave_max(float v) {
#pragma unroll
    for (int o = 1; o < 64; o <<= 1) v = fmaxf(v, __shfl_xor(v, o));
    return v;
}
__device__ __forceinline__ int hid_tid() { int t = threadIdx.x; asm volatile("" : "+v"(t)); return t; }
__device__ __forceinline__ void unpack4(u32x2 r, float (&v)[4]) { v[0] = bflo(r.x); v[1] = bfhi(r.x); v[2] = bflo(r.y); v[3] = bfhi(r.y); }

__device__ __forceinline__ float cl8(float x) { return fminf(fmaxf(x, -448.f), 448.f); }
__device__ __forceinline__ void mod_row(const float* xrow, const float* gw, const float* sh, const float* sc, unsigned char* orow, int lane, f32x4 (&hv)[4]) {
    f32x4 v[4]; float ss = 0.f;
#pragma unroll
    for (int j = 0; j < 4; ++j) { v[j] = ((const f32x4*)xrow)[lane + 64 * j]; ss += v[j].x * v[j].x + v[j].y * v[j].y + v[j].z * v[j].z + v[j].w * v[j].w; }
    ss = wave_sum_fast(ss);
    const float rs = rsqrtf(ss * (1.f / DM) + EPS);
#pragma unroll
    for (int j = 0; j < 4; ++j) {
        const int c = 4 * lane + 256 * j;
        const f32x4 g = *(const f32x4*)(gw + c), s1 = *(const f32x4*)(sc + c), s0 = *(const f32x4*)(sh + c);
        f32x4 o;
        o.x = v[j].x * rs * g.x * (1.f + s1.x) + s0.x; o.y = v[j].y * rs * g.y * (1.f + s1.y) + s0.y;
        o.z = v[j].z * rs * g.z * (1.f + s1.z) + s0.z; o.w = v[j].w * rs * g.w * (1.f + s1.w) + s0.w;
        hv[j] = o;
        *(unsigned*)(orow + c) = pk4_fp8(cl8(o.x * SH8), cl8(o.y * SH8), cl8(o.z * SH8), cl8(o.w * SH8));
    }
}
__device__ __forceinline__ int mod_index(int r) { return r < NX ? (r >> 11) : 8; }

__device__ __forceinline__ void phase_pro0(const Params& p, unsigned char* smem) {
    float* act = (float*)smem;
    float* red = act + 9 * 1024;
    const int tid = hid_tid(), lane = tid & 63, wave = tid >> 6;
    for (int i = tid; i < 9 * 1024; i += 512) { const int r = i >> 10, k = i & 1023; const float v = (r < 8) ? p.c[r * 1024 + k] : p.c_ctx[k]; act[i] = v / (1.f + expf(-v)); }
    __syncthreads();
    float* MOD = WSP(float, WS_MOD);
    for (int item = blockIdx.x; item < 96; item += gridDim.x) {
        const int l = item / 48, ch = item % 48, hl = lane >> 5, cl = lane & 31;
        const float* w = p.w_ada + (size_t)l * 1024 * 6144 + ch * 128 + 4 * cl;
        f32x4 acc[9];
#pragma unroll
        for (int r = 0; r < 9; ++r) acc[r] = (f32x4){0.f, 0.f, 0.f, 0.f};
        const int k0 = wave * 128 + hl;
#pragma unroll 8
        for (int i = 0; i < 64; ++i) {
            const int k = k0 + 2 * i;
            const f32x4 wv = __builtin_nontemporal_load((const f32x4*)(w + (size_t)k * 6144));
#pragma unroll
            for (int r = 0; r < 9; ++r) { const float a = act[r * 1024 + k]; acc[r].x += a * wv.x; acc[r].y += a * wv.y; acc[r].z += a * wv.z; acc[r].w += a * wv.w; }
        }
#pragma unroll
        for (int r = 0; r < 9; ++r) {
            acc[r].x += __shfl_xor(acc[r].x, 32); acc[r].y += __shfl_xor(acc[r].y, 32); acc[r].z += __shfl_xor(acc[r].z, 32); acc[r].w += __shfl_xor(acc[r].w, 32);
            if (hl == 0) *(f32x4*)(red + (wave * 9 + r) * 128 + 4 * cl) = acc[r];
        }
        __syncthreads();
        for (int i = tid; i < 9 * 128; i += 512) {
            const int r = i >> 7, cc = i & 127; float s = 0.f;
#pragma unroll
            for (int w8 = 0; w8 < 8; ++w8) s += red[(w8 * 9 + r) * 128 + cc];
            MOD[(size_t)(l * 9 + r) * 6144 + ch * 128 + cc] = s + p.b_ada[l * 6144 + ch * 128 + cc];
        }
        __syncthreads();
    }
    if (blockIdx.x == gridDim.x - 2) {
        float* RT = WSP(float, WS_ROPE);
        const int pos = tid >> 3, f = tid & 7; const float ang = (float)pos * expf(-(float)f * 1.151292546497023f);
        RT[2 * tid] = cosf(ang); RT[2 * tid + 1] = sinf(ang);
    }
    if (blockIdx.x == gridDim.x - 1 && wave == 0) {
        float* SC = WSP(float, WS_SCAL);
        for (int l = 0; l < 2; ++l) {
            float s1 = lane < 32 ? p.lq1[l * 32 + lane] * p.lk1[l * 32 + lane] : 0.f;
            float s2 = lane < 32 ? p.lq2[l * 32 + lane] * p.lk2[l * 32 + lane] : 0.f;
            s1 = wave_sum(s1); s2 = wave_sum(s2);
            const float lam_init = 0.8f - 0.6f * expf(-0.3f * (float)l);
            const float lam = expf(s1) - expf(s2) + lam_init;
            const float mq = wave_max(lane < 32 ? fabsf(p.df_qg[l * 32 + lane]) : 0.f), mk = wave_max(lane < 32 ? fabsf(p.df_kg[l * 32 + lane]) : 0.f);
            const float aq = wave_max(fabsf(p.na_qg[l * 64 + lane])), ak = wave_max(fabsf(p.na_kg[l * 64 + lane]));
            if (lane == 0) { SC[l * 16 + 0] = lam; SC[l * 16 + 1] = lam_init; SC[l * 16 + 2] = 5.656854249f * 1.44269504f * mq * mk; }
            for (int h = 0; h < 4; ++h) {
                float mb = 0.f;
                for (int i = lane; i < 15 * 31; i += 64) mb = fmaxf(mb, p.na_rpb[((size_t)(l * 4 + h)) * 465 + i]);
                mb = wave_max(mb);
                if (lane == 0) SC[l * 16 + 4 + h] = (8.f * aq * ak + mb) * 1.44269504f;
            }
        }
    }
    asm volatile("s_waitcnt vmcnt(0)" ::: "memory");
    __syncthreads();
    if (tid == 0) {
        __builtin_amdgcn_fence(__ATOMIC_RELEASE, "agent");
        asm volatile("s_waitcnt vmcnt(0)" ::: "memory");
        __hip_atomic_fetch_add(WSP(unsigned, WS_CTL + CTL_PRO0), 1u, __ATOMIC_RELAXED, __HIP_MEMORY_SCOPE_AGENT);
    }
}

__device__ __forceinline__ void transpose_item(const float* W, int ldw, int K, bf16_t* WT, unsigned char* sm, int kb, int nb, int lane) {
    const int q = lane >> 4, c4 = lane & 15;
    const float* src = W + (size_t)(64 * kb + 16 * q) * ldw + 64 * nb + 4 * c4;
    f32x4 r[16];
#pragma unroll
    for (int j = 0; j < 16; ++j) r[j] = *(const f32x4*)(src + (size_t)j * ldw);
#pragma unroll
    for (int c = 0; c < 4; ++c) {
        u32x4 o0, o1;
        o0.x = pk2(r[0][c], r[1][c]); o0.y = pk2(r[2][c], r[3][c]); o0.z = pk2(r[4][c], r[5][c]); o0.w = pk2(r[6][c], r[7][c]);
        o1.x = pk2(r[8][c], r[9][c]); o1.y = pk2(r[10][c], r[11][c]); o1.z = pk2(r[12][c], r[13][c]); o1.w = pk2(r[14][c], r[15][c]);
        unsigned char* d = sm + (4 * c4 + c) * 144 + 32 * q;
        *(u32x4*)d = o0; *(u32x4*)(d + 16) = o1;
    }
    __builtin_amdgcn_s_waitcnt(0xc07f); asm volatile("" ::: "memory");
    bf16_t* dst = WT + (size_t)(64 * nb + (lane >> 3)) * K + 64 * kb + 8 * (lane & 7);
#pragma unroll
    for (int i = 0; i < 8; ++i) { const u32x4 o = *(const u32x4*)(sm + (8 * i + (lane >> 3)) * 144 + 16 * (lane & 7)); *(u32x4*)(dst + (size_t)(8 * i) * K) = o; }
    __builtin_amdgcn_s_waitcnt(0xc07f); asm volatile("" ::: "memory");
}

__device__ __forceinline__ void transpose_item8(const float* W, int ldw, int K, unsigned char* WT, unsigned char* sm, int kb, int nb, int lane) {
    const int q = lane >> 4, c4 = lane & 15;
    const float* src = W + (size_t)(64 * kb + 16 * q) * ldw + 64 * nb + 4 * c4;
    f32x4 r[16];
#pragma unroll
    for (int j = 0; j < 16; ++j) r[j] = *(const f32x4*)(src + (size_t)j * ldw) * SW8;
#pragma unroll
    for (int c = 0; c < 4; ++c) {
        u32x4 o; o.x = pk4_fp8(r[0][c], r[1][c], r[2][c], r[3][c]); o.y = pk4_fp8(r[4][c], r[5][c], r[6][c], r[7][c]);
        o.z = pk4_fp8(r[8][c], r[9][c], r[10][c], r[11][c]); o.w = pk4_fp8(r[12][c], r[13][c], r[14][c], r[15][c]);
        *(u32x4*)(sm + (4 * c4 + c) * 80 + 16 * q) = o;
    }
    __builtin_amdgcn_s_waitcnt(0xc07f); asm volatile("" ::: "memory");
    unsigned char* dst = WT + (size_t)(64 * nb + (lane >> 2)) * K + 64 * kb + 16 * (lane & 3);
#pragma unroll
    for (int i = 0; i < 4; ++i) { const u32x4 o = *(const u32x4*)(sm + (16 * i + (lane >> 2)) * 80 + 16 * (lane & 3)); *(u32x4*)(dst + (size_t)(16 * i) * K) = o; }
    __builtin_amdgcn_s_waitcnt(0xc07f); asm volatile("" ::: "memory");
}

__device__ __forceinline__ void phase_pro1(const Params& p, unsigned char* smem) {
    const int tid = hid_tid(), lane = tid & 63, wave = tid >> 6;
    const int gw = blockIdx.x * 8 + wave, ngw = gridDim.x * 8;
    unsigned char* WIN = WSP(unsigned char, WS_WIN);
    {
        float* Mf = (float*)smem;
        float* tile = Mf + 4096 + wave * (64 * 65);
        float* trig = Mf + 4096 + 8 * (64 * 65);
        if (tid < 128) { const int i = tid & 63; const float a = (float)i * (1.f / 32.f); trig[tid] = tid < 64 ? cospif(a) : sinpif(a); }
        __syncthreads();
        for (int rep_ = 0; rep_ < REP_FOLD; ++rep_)
        for (int it = blockIdx.x; it < 96; it += gridDim.x) {
            const int kq = it & 3, g = (it >> 2) & 3, kind = (it >> 4) % 3, l = it / 48;
            for (int i = tid; i < 4096; i += 512) {
                const int cch = i >> 6, e = i & 63; float v;
                if (kind == 0) v = p.pool_w[((size_t)(l * 4 + g) * 64 + cch) * 64 + e] * p.pool_scale[l * 256 + g * 64 + e];
                else {
                    const float* fw = p.fft_w + (size_t)(l * 4 + g) * 4096 + e; const float* tb = trig + (kind == 1 ? 0 : 64);
                    float s = 0.f;
#pragma unroll 8
                    for (int m = 0; m < 64; ++m) s += tb[(m * cch) & 63] * fw[m * 64];
                    v = s * 0.125f;
                }
                Mf[i] = v;
            }
            __syncthreads();
            const int srcb = (kind == 0 ? 1536 : 1792) + 64 * g, dstb = (kind == 0 ? 1536 : (kind == 1 ? 1792 : 2048)) + 64 * g;
            {
                const int kb = 4 * kq + (wave & 3), eh = wave >> 2;
                for (int i = 0; i < 64; ++i) tile[i * 65 + lane] = p.w_in[((size_t)l * 1024 + 64 * kb + i) * 2048 + srcb + lane];
                __builtin_amdgcn_s_waitcnt(0xc07f); asm volatile("" ::: "memory");
                float acc[32];
#pragma unroll
                for (int e = 0; e < 32; ++e) acc[e] = 0.f;
                for (int cch = 0; cch < 64; ++cch) {
                    const float a = tile[lane * 65 + cch];
#pragma unroll
                    for (int e = 0; e < 32; ++e) acc[e] += a * Mf[cch * 64 + eh * 32 + e];
                }
#pragma unroll
                for (int e = 0; e < 32; ++e) WIN[((size_t)l * NIN + dstb + eh * 32 + e) * 1024 + 64 * kb + lane] = (unsigned char)(__builtin_amdgcn_cvt_pk_fp8_f32(cl8(acc[e] * SW8), 0.f, 0, false) & 0xff);
                __builtin_amdgcn_s_waitcnt(0xc07f); asm volatile("" ::: "memory");
            }
            __syncthreads();
        }
    }
    {
        unsigned char* tsm = smem + wave * (64 * 144);
        __syncthreads();
        constexpr int I_IN = 16 * 24, I_OUT = 16 * 16;
        constexpr int T0 = 2 * I_IN, T1 = T0 + 2 * I_OUT;
        for (int rep_ = 0; rep_ < REP_TR; ++rep_)
        for (int it = gw; it < T1; it += ngw) {
            if (it < T0) { const int l = it / I_IN, r = it % I_IN; transpose_item8(p.w_in + (size_t)l * 1024 * 2048, 2048, 1024, WIN + (size_t)l * NIN * 1024, tsm, r % 16, r / 16, lane); }
            else { const int q = it - T0, l = q / I_OUT, r = q % I_OUT; transpose_item(p.w_out + (size_t)l * 1024 * 1024, 1024, 1024, WSP(bf16_t, WS_WOUT) + (size_t)l * 1024 * 1024, tsm, r % 16, r / 16, lane); }
        }
    }
    {
        bf16_t* DM_ = WSP(bf16_t, WS_DFTM); bf16_t* DC_ = WSP(bf16_t, WS_DFTC);
        const int gt = blockIdx.x * 512 + tid, ngt = gridDim.x * 512;
        for (int i = gt; i < 2048 * 256; i += ngt) {
            const int k = i >> 8, j0 = (i & 255) * 8; unsigned o[4];
#pragma unroll
            for (int q = 0; q < 4; ++q) { float v[2];
#pragma unroll
                for (int e = 0; e < 2; ++e) { const int j = j0 + 2 * q + e;
                    if (j <= 1024) { const int ph = (k * j) & 2047; v[e] = cospif((float)ph * (1.f / 1024.f)) * 0.02209708691f; }
                    else { const int ph = (k * (j - 1024)) & 2047; v[e] = -sinpif((float)ph * (1.f / 1024.f)) * 0.02209708691f; } }
                o[q] = pk2(v[0], v[1]); }
            *(u32x4*)(DM_ + (size_t)k * 2048 + j0) = (u32x4){o[0], o[1], o[2], o[3]};
        }
        for (int i = gt; i < 256 * 32; i += ngt) {
            const int k = i >> 5, j0 = (i & 31) * 8; unsigned o[4];
#pragma unroll
            for (int q = 0; q < 4; ++q) { float v[2];
#pragma unroll
                for (int e = 0; e < 2; ++e) { const int j = j0 + 2 * q + e;
                    if (j <= 128) { const int ph = (k * j) & 255; v[e] = cospif((float)ph * (1.f / 128.f)) * 0.0625f; }
                    else { const int ph = (k * (j - 128)) & 255; v[e] = -sinpif((float)ph * (1.f / 128.f)) * 0.0625f; } }
                o[q] = pk2(v[0], v[1]); }
            *(u32x4*)(DC_ + (size_t)k * 256 + j0) = (u32x4){o[0], o[1], o[2], o[3]};
        }
    }
    {
        bf16_t* RWT = WSP(bf16_t, WS_RWT);
        const int gt = blockIdx.x * 512 + tid, ngt = gridDim.x * 512;
        for (int i = gt; i < 2 * 32 * 128; i += ngt) {
            const int l = i >> 12, e = (i >> 7) & 31, k0 = (i & 127) * 8;
            const float* s = p.router_w + ((size_t)l * 1024 + k0) * 32 + e;
            u32x4 o; o.x = pk2(s[0], s[32]); o.y = pk2(s[64], s[96]); o.z = pk2(s[128], s[160]); o.w = pk2(s[192], s[224]);
            *(u32x4*)(RWT + ((size_t)(l * 32 + e)) * 1024 + k0) = o;
        }
    }
    {
        if (tid == 0) {
            unsigned* cnt = WSP(unsigned, WS_CTL + CTL_PRO0); unsigned sp = 0;
            while (__hip_atomic_load(cnt, __ATOMIC_RELAXED, __HIP_MEMORY_SCOPE_AGENT) < gridDim.x) { __builtin_amdgcn_s_sleep(2); if (++sp > (1u << 22)) break; }
            __builtin_amdgcn_fence(__ATOMIC_ACQUIRE, "agent");
            asm volatile("s_waitcnt vmcnt(0)" ::: "memory");
        }
        __syncthreads();
    }
    {
        const float* MOD = WSP(float, WS_MOD); unsigned char* H = WSP(unsigned char, WS_H);
        for (int r = gw; r < NT; r += ngw) {
            const float* xr = r < NX ? p.x + (size_t)r * DM : p.ctx + (size_t)(r - NX) * DM;
            const float* m = MOD + (size_t)(0 * 9 + mod_index(r)) * 6144;
            f32x4 hv[4];
            mod_row(xr, p.g1w, m, m + 1024, H + (size_t)r * DM, lane, hv);
        }
    }
}

enum { G_WIN = 0, G_DFT = 1, G_DFTC = 2, G_WOUT = 3, G_MOE1 = 4, G_MOE2 = 5 };
__device__ __forceinline__ void moe_tinfo(const Params& p, int l, int* tinfo) {
    if (threadIdx.x == 0) {
        const int* cnt = WSP(int, WS_CTL + CTL_CNT) + l * 32; int s = 0;
        for (int e = 0; e < 32; ++e) { const int c = cnt[e]; tinfo[e] = s; tinfo[33 + e] = c; s += (c + 255) >> 8; }
        tinfo[32] = s;
    }
    __syncthreads();
}

#define LAS __attribute__((address_space(3)))
namespace g8 {
constexpr int BM = 256, BK = 64, HALF = 128, HTB = HALF * BK * 2, STAGE_BYTES = 8 * HTB, NXCD = 8, WGM = 8;
__host__ __device__ __forceinline__ int lds_xor(int r) { return (((r >> 1) & 1) * 3) | (r & 4); }
__host__ __device__ __forceinline__ int lds_byte(int r, int c) { return r * 128 + ((((c >> 3) ^ lds_xor(r)) & 7) << 4); }
__host__ __device__ __forceinline__ void stage_rc(int b, int& R, int& C) { const int r = b >> 7, cp = (b >> 4) & 7; R = r; C = ((cp ^ lds_xor(r)) & 7) * 8; }
}
struct UnitD { unsigned boff; const int* gather; int arow0, nvalid, orow0, ocol0, e; };
template <int KIND> __device__ __forceinline__ void phase_geom(int l, const int* tinfo, int& nM, int& nN, int& K) {
    if (KIND == G_WIN) { nM = 72; nN = 9; K = 1024; }
    else if (KIND == G_DFT) { nM = 8; nN = 8; K = 2048; }
    else if (KIND == G_DFTC) { nM = 1; nN = 8; K = 256; }
    else if (KIND == G_WOUT) { nM = (l == 0) ? 72 : 64; nN = 4; K = 1024; }
    else if (KIND == G_MOE1) { nM = __builtin_amdgcn_readfirstlane(tinfo[32]); nN = 8; K = 1024; }
    else { nM = __builtin_amdgcn_readfirstlane(tinfo[32]); nN = 4; K = 1024; }
}
template <int KIND> __device__ __forceinline__ const bf16_t* phase_A(const Params& p) {
    if (KIND == G_WIN) return (const bf16_t*)WSP(unsigned char, WS_H);
    if (KIND == G_MOE1) return (const bf16_t*)WSP(unsigned char, WS_H8);
    if (KIND == G_DFT) return WSP(bf16_t, WS_DFTM);
    if (KIND == G_DFTC) return WSP(bf16_t, WS_DFTC);
    if (KIND == G_WOUT) return WSP(bf16_t, WS_YCAT);
    return WSP(bf16_t, WS_ACT);
}
template <int KIND> __device__ __forceinline__ const void* phase_B(const Params& p, int l) {
    if (KIND == G_WIN) return WSP(unsigned char, WS_WIN) + (size_t)l * NIN * 1024;
    if (KIND == G_DFT) return WSP(bf16_t, WS_XF);
    if (KIND == G_DFTC) return WSP(bf16_t, WS_XFC);
    if (KIND == G_WOUT) return WSP(bf16_t, WS_WOUT) + (size_t)l * 1024 * 1024;
    if (KIND == G_MOE1) return WSP(unsigned char, WS_W1) + (size_t)l * NE * 2048 * 1024;
    return WSP(unsigned char, WS_W2) + (size_t)l * NE * 1024 * 1024;
}
template <int KIND> __device__ __forceinline__ void get_unit(const Params& p, int l, int pm, int pn, const int* tinfo, UnitD& u) {
    u.gather = nullptr; u.nvalid = 256; u.e = 0; u.arow0 = pm * 256; u.orow0 = pm * 256; u.ocol0 = pn * 256;
    if (KIND == G_WIN) u.boff = (unsigned)pn * 256u * 1024u;
    else if (KIND == G_DFT) u.boff = (unsigned)pn * 256u * 2048u * 2u;
    else if (KIND == G_DFTC) u.boff = (unsigned)pn * 256u * 256u * 2u;
    else if (KIND == G_WOUT) u.boff = (unsigned)pn * 256u * 1024u * 2u;
    else {
        int e = 0; while (tinfo[e + 1] <= pm) ++e;
        e = __builtin_amdgcn_readfirstlane(e); u.e = e;
        if (KIND == G_MOE1) { u.gather = WSP(int, WS_LIST) + (size_t)e * NT; u.arow0 = __builtin_amdgcn_readfirstlane((pm - tinfo[e]) * 256); u.nvalid = __builtin_amdgcn_readfirstlane(tinfo[33 + e]) - u.arow0;
                              u.boff = (unsigned)(e * 2048 + pn * 256) * 1024u; }
        else u.boff = (unsigned)(e * 1024 + pn * 256) * 1024u;
    }
}
__device__ __forceinline__ bool static_order(int i, int G, int c, int nM, int nN, int& pm, int& pn) {
    const int nwg = nM * nN; const long L = (long)i * G + c; if (L >= nwg) return false;
    int wgid = (int)L; { const int q = nwg / g8::NXCD, r = nwg % g8::NXCD, xcd = wgid % g8::NXCD, off = wgid / g8::NXCD; wgid = (xcd < r ? xcd * (q + 1) : r * (q + 1) + (xcd - r) * q) + off; }
    const int nig = g8::WGM * nN, gid = wgid / nig, fm = gid * g8::WGM, gsz = (nM - fm) < g8::WGM ? (nM - fm) : g8::WGM;
    pm = fm + ((wgid % nig) % gsz); pn = (wgid % nig) / gsz; return true;
}
template <int KIND>
__device__ __forceinline__ void gemm_phase256(const Params& p, const int l, LAS unsigned char* lds, const int* tinfo) {
    using namespace g8;
    const int tid = hid_tid(), wid = __builtin_amdgcn_readfirstlane(tid >> 6), lane = tid & 63, wr = wid >> 2, wc = wid & 3, fr = lane & 15, fq = lane >> 4;
    int nM, nN, K; phase_geom<KIND>(l, tinfo, nM, nN, K);
    constexpr bool F8 = (KIND == G_MOE1 || KIND == G_MOE2 || KIND == G_WIN);
    constexpr int ES = F8 ? 1 : 2;
    constexpr int KREP = F8 ? REP_KL8 : REP_KL16;
    const int nt1 = K * ES / 128, nt = nt1 * KREP, G = gridDim.x, cwg = blockIdx.x;
    const __amdgpu_buffer_rsrc_t rsA = __builtin_amdgcn_make_buffer_rsrc((void*)phase_A<KIND>(p), 0, 0x7ffffff0, 0x00020000);
    const __amdgpu_buffer_rsrc_t rsB = __builtin_amdgcn_make_buffer_rsrc((void*)phase_B<KIND>(p, l), 0, 0x7ffffff0, 0x00020000);
    unsigned voffB[2];
#pragma unroll
    for (int i = 0; i < 2; ++i) { int R_, C_; stage_rc(tid * 16 + i * 8192, R_, C_);
        const int rho = R_ & 31, Rb = F8 ? 64 * (R_ >> 5) + 16 * ((rho & 15) >> 2) + 4 * (rho >> 4) + (rho & 3) : (R_ & ~31) + 8 * ((rho & 15) >> 2) + 4 * (rho >> 4) + (rho & 3);
        voffB[i] = (unsigned)(Rb * K * ES + C_ * 2); }
    const unsigned kstep = 128u, hstepB = (unsigned)((F8 ? 8 : HALF) * K * ES);
    const unsigned ldsw = (unsigned)wid * 1024u;
    int aoffL[2], boffL[2];
    { const int ra = wr * 64 + fr, rb = wc * 32 + fr;
      if (F8) { aoffL[0] = lds_byte(ra, 16 * fq); aoffL[1] = lds_byte(ra, 16 * fq + 8); boffL[0] = lds_byte(rb, 16 * fq); boffL[1] = lds_byte(rb, 16 * fq + 8); }
      else { aoffL[0] = lds_byte(ra, fq * 8); aoffL[1] = lds_byte(ra, fq * 8 + 32); boffL[0] = lds_byte(rb, fq * 8); boffL[1] = lds_byte(rb, fq * 8 + 32); } }
#define G8_SA(b, h) (((b) * 2 + (h)) * HTB)
#define G8_SB(b, h) ((4 + (b) * 2 + (h)) * HTB)
#define G8_STAGE_A(bufoff, ktb, h) do { _Pragma("unroll") for (int _i = 0; _i < 2; ++_i) \
        __builtin_amdgcn_raw_ptr_buffer_load_lds(rsA, (LAS void*)(lds + (bufoff) + ldsw + _i * 8192), 16, aoff[h][_i], (int)(ktb), 0, 0); } while (0)
#define G8_STAGE_B(bufoff, soff) do { _Pragma("unroll") for (int _i = 0; _i < 2; ++_i) \
        __builtin_amdgcn_raw_ptr_buffer_load_lds(rsB, (LAS void*)(lds + (bufoff) + ldsw + _i * 8192), 16, voffB[_i], (int)(soff), 0, 0); } while (0)
#define G8_LDA(dst, b, h) do { _Pragma("unroll") for (int m = 0; m < 4; ++m) _Pragma("unroll") for (int k = 0; k < 2; ++k) { const u32x4 _v = *(const LAS u32x4*)(lds + G8_SA(b, h) + aoffL[k] + m * 2048); dst[m][4 * k] = (int)_v.x; dst[m][4 * k + 1] = (int)_v.y; dst[m][4 * k + 2] = (int)_v.z; dst[m][4 * k + 3] = (int)_v.w; } } while (0)
#define G8_LDB(dst, b, h) do { _Pragma("unroll") for (int n = 0; n < 2; ++n) _Pragma("unroll") for (int k = 0; k < 2; ++k) { const u32x4 _v = *(const LAS u32x4*)(lds + G8_SB(b, h) + boffL[k] + n * 2048); dst[n][4 * k] = (int)_v.x; dst[n][4 * k + 1] = (int)_v.y; dst[n][4 * k + 2] = (int)_v.z; dst[n][4 * k + 3] = (int)_v.w; } } while (0)
#define G8_MMA(ai, bj, At, Bt) do { __builtin_amdgcn_s_setprio(1); _Pragma("unroll") for (int m = 0; m < 4; ++m) _Pragma("unroll") for (int n = 0; n < 2; ++n) { \
        if (F8) acc[ai][bj][m][n] = __builtin_amdgcn_mfma_scale_f32_16x16x128_f8f6f4(Bt[n], At[m], acc[ai][bj][m][n], 0, 0, 0, 0, 0, 0); \
        else { typedef int i32x4_ __attribute__((ext_vector_type(4))); \
               const i32x4_ _a0 = __builtin_shufflevector(At[m], At[m], 0, 1, 2, 3), _a1 = __builtin_shufflevector(At[m], At[m], 4, 5, 6, 7); \
               const i32x4_ _b0 = __builtin_shufflevector(Bt[n], Bt[n], 0, 1, 2, 3), _b1 = __builtin_shufflevector(Bt[n], Bt[n], 4, 5, 6, 7); \
               acc[ai][bj][m][n] = __builtin_amdgcn_mfma_f32_16x16x32_bf16(*(const bf16x8*)&_b0, *(const bf16x8*)&_a0, acc[ai][bj][m][n], 0, 0, 0); \
               acc[ai][bj][m][n] = __builtin_amdgcn_mfma_f32_16x16x32_bf16(*(const bf16x8*)&_b1, *(const bf16x8*)&_a1, acc[ai][bj][m][n], 0, 0, 0); } } \
        __builtin_amdgcn_s_setprio(0); } while (0)
#define G8_WAIT_V(n) asm volatile("s_waitcnt vmcnt(" #n ")" ::: "memory")
#define G8_WAIT_L(n) asm volatile("s_waitcnt lgkmcnt(" #n ")" ::: "memory")
#define G8_BAR __builtin_amdgcn_s_barrier()
#define G8_SCHED __builtin_amdgcn_sched_barrier(0)
#define G8_AOFF(dst, u) do { _Pragma("unroll") for (int _h = 0; _h < 2; ++_h) _Pragma("unroll") for (int _i = 0; _i < 2; ++_i) { int _R, _C; stage_rc(tid * 16 + _i * 8192, _R, _C); const int _rt = _h * 128 + _R; int _ar; \
        if (KIND == G_MOE1) _ar = (u).gather[(u).arow0 + (_rt < (u).nvalid ? _rt : -(u).arow0)]; else _ar = (u).arow0 + _rt; \
        dst[_h][_i] = (unsigned)(_ar * K * ES + _C * 2); } } while (0)
    UnitD cur, nxt; int ui = 0, pm, pn;
    if (!static_order(0, G, cwg, nM, nN, pm, pn)) return;
    get_unit<KIND>(p, l, pm, pn, tinfo, cur);
    unsigned aoff[2][2]; G8_AOFF(aoff, cur);
    f32x4 acc[2][2][4][2];
#pragma unroll
    for (int a = 0; a < 2; ++a)
#pragma unroll
        for (int b = 0; b < 2; ++b)
#pragma unroll
            for (int m = 0; m < 4; ++m)
#pragma unroll
                for (int n = 0; n < 2; ++n) acc[a][b][m][n] = (f32x4){0.f, 0.f, 0.f, 0.f};
    i32x8 At[4], B0[2], B1[2];
    unsigned cB = cur.boff;
    G8_STAGE_B(G8_SB(0, 0), cB); G8_STAGE_A(G8_SA(0, 0), 0, 0); G8_STAGE_B(G8_SB(0, 1), cB + hstepB); G8_STAGE_A(G8_SA(0, 1), 0, 1);
    if (wr == 1) G8_BAR;
    G8_WAIT_V(4); G8_BAR;
    G8_STAGE_B(G8_SB(1, 0), cB + kstep); G8_STAGE_A(G8_SA(1, 0), kstep, 0); G8_STAGE_B(G8_SB(1, 1), cB + hstepB + kstep);
    G8_WAIT_V(6); G8_BAR;
    G8_LDB(B0, 0, 0);
    for (;;) {
        const bool has_next = static_order(ui + 1, G, cwg, nM, nN, pm, pn);
        if (has_next) get_unit<KIND>(p, l, pm, pn, tinfo, nxt);
        const unsigned nB = has_next ? nxt.boff : cB;
        if ((KIND == G_MOE1 || KIND == G_MOE2) && wid == 0) {
            const float* bsrc = ((KIND == G_MOE1) ? p.b1 + (size_t)(l * NE + cur.e) * 2048 : p.b2 + (size_t)(l * NE + cur.e) * 1024) + cur.ocol0 + 4 * lane;
            __builtin_amdgcn_global_load_lds((const unsigned*)bsrc, (LAS unsigned*)(lds + STAGE_BYTES + (ui & 1) * 1024), 16, 0, 0);
            if (KIND == G_MOE1 && has_next)
                __builtin_amdgcn_global_load_lds((const unsigned*)(nxt.gather + nxt.arow0 + 4 * lane), (LAS unsigned*)(lds + STAGE_BYTES + 2048 + ((ui + 1) & 1) * 1024), 16, 0, 0);
        }
#pragma unroll 1
        for (int t = 0; t < nt; t += 2) {
            const bool last = (t == nt - 2);
            if (KREP > 1 && t == nt - nt1) {
#pragma unroll
                for (int a = 0; a < 2; ++a)
#pragma unroll
                    for (int b = 0; b < 2; ++b)
#pragma unroll
                        for (int m = 0; m < 4; ++m)
#pragma unroll
                            for (int n = 0; n < 2; ++n) acc[a][b][m][n] = (f32x4){0.f, 0.f, 0.f, 0.f};
            }
            unsigned naoff1[2];
            if (KIND == G_MOE1 && last && has_next) {
                const LAS int* itab = (const LAS int*)(lds + STAGE_BYTES + 2048 + ((ui + 1) & 1) * 1024);
#pragma unroll
                for (int _i = 0; _i < 2; ++_i) { int _R, _C; stage_rc(tid * 16 + _i * 8192, _R, _C);
                    const int _r0 = _R, _r1 = 128 + _R;
                    const int a0 = itab[_r0 < nxt.nvalid ? _r0 : 0], a1 = itab[_r1 < nxt.nvalid ? _r1 : 0];
                    aoff[0][_i] = (unsigned)(a0 * K * ES + _C * 2); naoff1[_i] = (unsigned)(a1 * K * ES + _C * 2); }
            }
            G8_LDA(At, 0, 0); G8_STAGE_A(G8_SA(1, 1), (unsigned)((t + 1) & (nt1 - 1)) * kstep, 1);
            G8_BAR; G8_WAIT_L(0); G8_MMA(0, 0, At, B0); G8_BAR; G8_SCHED;
            unsigned kt2 = (unsigned)((t + 2) & (nt1 - 1)) * kstep; unsigned b2 = cB + kt2;
            if (last) { kt2 = 0; b2 = nB; if (has_next) { if (KIND == G_MOE1) { aoff[1][0] = naoff1[0]; aoff[1][1] = naoff1[1]; } else G8_AOFF(aoff, nxt); } }
            G8_LDB(B1, 0, 1); G8_STAGE_B(G8_SB(0, 0), b2);
            G8_BAR; G8_WAIT_L(0); G8_MMA(0, 1, At, B1); G8_BAR;
            G8_LDA(At, 0, 1); G8_STAGE_A(G8_SA(0, 0), kt2, 0);
            G8_WAIT_V(10); G8_BAR; G8_WAIT_L(0); G8_MMA(1, 0, At, B0); G8_BAR; G8_SCHED;
            G8_LDB(B0, 1, 0); G8_STAGE_B(G8_SB(0, 1), b2 + hstepB);
            G8_WAIT_V(6); G8_BAR; G8_MMA(1, 1, At, B1); G8_BAR;
            G8_LDA(At, 1, 0); G8_STAGE_A(G8_SA(0, 1), kt2, 1);
            G8_BAR; G8_WAIT_L(0); G8_MMA(0, 0, At, B0); G8_BAR; G8_SCHED;
            G8_LDB(B1, 1, 1); G8_STAGE_B(G8_SB(1, 0), b2 + kstep);
            G8_BAR; G8_WAIT_L(0); G8_MMA(0, 1, At, B1); G8_BAR;
            G8_LDA(At, 1, 1); G8_STAGE_A(G8_SA(1, 0), kt2 + kstep, 0);
            G8_WAIT_V(10); G8_BAR; G8_WAIT_L(0); G8_MMA(1, 0, At, B0); G8_BAR; G8_SCHED;
            if (!last) G8_LDB(B0, 0, 0);
            G8_STAGE_B(G8_SB(1, 1), b2 + kstep + hstepB);
            G8_WAIT_V(6); G8_BAR; G8_MMA(1, 1, At, B1); G8_BAR;
        }
#if REP_EPI > 1
        int erep_n = F8 ? REP_EPI : 1; asm volatile("" : "+s"(erep_n));
#pragma unroll 1
        for (int erep_ = 0; erep_ < erep_n; ++erep_)
#endif
        {
            const int r0 = wr * 64 + fr, c0 = wc * 32 + 8 * fq;
            f32x4 cv[2][2];
            if (KIND == G_MOE1 || KIND == G_MOE2 || KIND == G_WOUT) {
                const float* cbase = WSP(float, WS_MOD) + (size_t)(l * 9 + mod_index(cur.orow0)) * 6144 + 2048;
#pragma unroll
                for (int bj = 0; bj < 2; ++bj)
#pragma unroll
                    for (int n = 0; n < 2; ++n) {
                        if (KIND == G_WOUT) cv[bj][n] = *(const f32x4*)(cbase + cur.ocol0 + bj * HALF + c0 + 4 * n);
                        else cv[bj][n] = *(const LAS f32x4*)(lds + STAGE_BYTES + (ui & 1) * 1024 + (wc * 64 + 16 * fq + 8 * bj + 4 * n) * 4);
                    }
            }
#pragma unroll
            for (int ai = 0; ai < 2; ++ai) {
                if (KIND == G_WOUT) {
                    f32x4 xv[4][2][2];
#pragma unroll
                    for (int m = 0; m < 4; ++m) {
                        const int row = cur.orow0 + ai * HALF + r0 + m * 16;
                        if (l == 0) {
                            const float* xin = row < NX ? p.x + (size_t)row * DM : p.ctx + (size_t)(row - NX) * DM;
#pragma unroll
                            for (int bj = 0; bj < 2; ++bj)
#pragma unroll
                                for (int n = 0; n < 2; ++n) xv[m][bj][n] = *(const f32x4*)(xin + cur.ocol0 + bj * HALF + c0 + 4 * n);
                        } else {
#pragma unroll
                            for (int bj = 0; bj < 2; ++bj) { const u32x4 w = *(const u32x4*)(WSP(bf16_t, WS_X2) + (size_t)row * DM + cur.ocol0 + bj * HALF + c0);
                                xv[m][bj][0] = (f32x4){bflo(w.x), bfhi(w.x), bflo(w.y), bfhi(w.y)}; xv[m][bj][1] = (f32x4){bflo(w.z), bfhi(w.z), bflo(w.w), bfhi(w.w)}; }
                        }
                    }
#pragma unroll
                    for (int m = 0; m < 4; ++m) {
                        const int row = cur.orow0 + ai * HALF + r0 + m * 16;
#pragma unroll
                        for (int bj = 0; bj < 2; ++bj) {
                            const f32x4 v0 = acc[ai][bj][m][0], v1 = acc[ai][bj][m][1], g0 = cv[bj][0], g1 = cv[bj][1], x0 = xv[m][bj][0], x1 = xv[m][bj][1];
                            u32x4 o; o.x = pk2(x0.x + g0.x * v0.x, x0.y + g0.y * v0.y); o.y = pk2(x0.z + g0.z * v0.z, x0.w + g0.w * v0.w);
                            o.z = pk2(x1.x + g1.x * v1.x, x1.y + g1.y * v1.y); o.w = pk2(x1.z + g1.z * v1.z, x1.w + g1.w * v1.w);
                            *(u32x4*)(WSP(bf16_t, WS_X1) + (size_t)row * DM + cur.ocol0 + bj * HALF + c0) = o;
                        }
                    }
                } else {
#pragma unroll
                    for (int m = 0; m < 4; ++m) {
                        const int row = cur.orow0 + ai * HALF + r0 + m * 16;
                        if (F8) {
                            const int colw = cur.ocol0 + wc * 64 + 16 * fq;
                            unsigned ow[2][2] = {{0u, 0u}, {0u, 0u}};
#pragma unroll
                            for (int bj = 0; bj < 2; ++bj) {
                                const f32x4 v0 = acc[ai][bj][m][0], v1 = acc[ai][bj][m][1];
                                if (KIND == G_WIN) {
                                } else if (KIND == G_MOE1) {
                                    constexpr float dq = 1.f / (SW8 * SH8);
                                    const f32x4 b0 = cv[bj][0], b1 = cv[bj][1];
                                    const float u[8] = {v0.x * dq + b0.x, v0.y * dq + b0.y, v0.z * dq + b0.z, v0.w * dq + b0.w, v1.x * dq + b1.x, v1.y * dq + b1.y, v1.z * dq + b1.z, v1.w * dq + b1.w};
                                    float o[4];
#pragma unroll
                                    for (int q = 0; q < 4; ++q) { const float g = fminf(u[2 * q], 7.f), li = fminf(fmaxf(u[2 * q + 1], -7.f), 7.f);
                                        o[q] = g * __builtin_amdgcn_rcpf(1.f + __builtin_amdgcn_exp2f(-2.45546696f * g)) * (li + 1.f) * SA8; }
                                    ow[bj][0] = pk4_fp8(o[0], o[1], o[2], o[3]); ow[bj][1] = 0u;
                                } else {
                                    constexpr float dq = SY8 / (SW8 * SA8);
                                    const f32x4 b0 = cv[bj][0] * SY8, b1 = cv[bj][1] * SY8;
#define CL8(x) fminf(fmaxf((x), -448.f), 448.f)
                                    ow[bj][0] = pk4_fp8(CL8(v0.x * dq + b0.x), CL8(v0.y * dq + b0.y), CL8(v0.z * dq + b0.z), CL8(v0.w * dq + b0.w));
                                    ow[bj][1] = pk4_fp8(CL8(v1.x * dq + b1.x), CL8(v1.y * dq + b1.y), CL8(v1.z * dq + b1.z), CL8(v1.w * dq + b1.w));
#undef CL8
                                }
                            }
                            if (KIND == G_WIN) {
                                constexpr float dq = 1.f / (SW8 * SH8);
                                const f32x4 a0 = acc[ai][0][m][0] * dq, a1 = acc[ai][0][m][1] * dq, a2 = acc[ai][1][m][0] * dq, a3 = acc[ai][1][m][1] * dq;
                                u32x4 o0, o1; o0.x = pk2(a0.x, a0.y); o0.y = pk2(a0.z, a0.w); o0.z = pk2(a1.x, a1.y); o0.w = pk2(a1.z, a1.w);
                                o1.x = pk2(a2.x, a2.y); o1.y = pk2(a2.z, a2.w); o1.z = pk2(a3.x, a3.y); o1.w = pk2(a3.z, a3.w);
                                bf16_t* dst = WSP(bf16_t, WS_PX) + (size_t)row * NIN + colw;
                                *(u32x4*)dst = o0; *(u32x4*)(dst + 8) = o1;
                            } else
                            if (KIND == G_MOE1) { u32x2 o; o.x = ow[0][0]; o.y = ow[1][0]; *(u32x2*)(WSP(unsigned char, WS_ACT) + (size_t)row * FF + (colw >> 1)) = o; }
                            else { u32x4 o; o.x = ow[0][0]; o.y = ow[0][1]; o.z = ow[1][0]; o.w = ow[1][1]; *(u32x4*)(WSP(unsigned char, WS_Y2) + (size_t)row * DM + colw) = o; }
                        } else {
#pragma unroll
                            for (int bj = 0; bj < 2; ++bj) {
                                const f32x4 v0 = acc[ai][bj][m][0], v1 = acc[ai][bj][m][1]; const int col = cur.ocol0 + bj * HALF + c0;
                                u32x4 o; o.x = pk2(v0.x, v0.y); o.y = pk2(v0.z, v0.w); o.z = pk2(v1.x, v1.y); o.w = pk2(v1.z, v1.w);
                                bf16_t* dst;
                                if (KIND == G_WIN) dst = WSP(bf16_t, WS_PX) + (size_t)row * NIN + col;
                                else if (KIND == G_DFT) dst = WSP(bf16_t, WS_YCAT) + (size_t)((col >> 8) * SEQ + row) * DM + 768 + (col & 255);
                                else dst = WSP(bf16_t, WS_YCAT) + (size_t)(NX + (col >> 8) * LC + row) * DM + 768 + (col & 255);
                                *(u32x4*)dst = o;
                            }
                        }
                    }
                }
            }
        }
        if (!has_next) break;
#pragma unroll
        for (int a = 0; a < 2; ++a)
#pragma unroll
            for (int b = 0; b < 2; ++b)
#pragma unroll
                for (int m = 0; m < 4; ++m)
#pragma unroll
                    for (int n = 0; n < 2; ++n) acc[a][b][m][n] = (f32x4){0.f, 0.f, 0.f, 0.f};
        cur = nxt; cB = nB; ++ui;
        G8_LDB(B0, 0, 0);
    }
    G8_WAIT_V(0);
    if (wr == 0) G8_BAR;
    G8_BAR;
#undef G8_SA
#undef G8_SB
#undef G8_STAGE_A
#undef G8_STAGE_B
#undef G8_LDA
#undef G8_LDB
#undef G8_MMA
#undef G8_WAIT_V
#undef G8_WAIT_L
#undef G8_BAR
#undef G8_SCHED
#undef G8_AOFF
}

__device__ __forceinline__ void wave_transpose_store(bf16_t* sm  , const u32x4 (&v)[8], bf16_t* dst, size_t dstride, int lane, int cpos) {
#pragma unroll
    for (int i = 0; i < 8; ++i) {
        const unsigned w[4] = {v[i].x, v[i].y, v[i].z, v[i].w};
#pragma unroll
        for (int q = 0; q < 4; ++q) { sm[(8 * i + 2 * q) * 72 + cpos] = (bf16_t)(w[q] & 0xffffu); sm[(8 * i + 2 * q + 1) * 72 + cpos] = (bf16_t)(w[q] >> 16); }
    }
    __builtin_amdgcn_s_waitcnt(0xc07f); asm volatile("" ::: "memory");
#pragma unroll
    for (int i = 0; i < 8; ++i) { const u32x4 o = *(const u32x4*)(sm + lane * 72 + 8 * i); *(u32x4*)(dst + (size_t)lane * dstride + 8 * i) = o; }
    __builtin_amdgcn_s_waitcnt(0xc07f); asm volatile("" ::: "memory");
}

__device__ __forceinline__ void phase_prep(const Params& p, const int l, unsigned char* smem) {
    const int tid = hid_tid(), lane = tid & 63, wave = tid >> 6;
    const int gw = blockIdx.x * 8 + wave, ngw = gridDim.x * 8;
    const bf16_t* PX = WSP(bf16_t, WS_PX); const float* ROPE = WSP(float, WS_ROPE);
    bf16_t *QA = WSP(bf16_t, WS_QA), *KA = WSP(bf16_t, WS_KA), *QD = WSP(bf16_t, WS_QD), *KD = WSP(bf16_t, WS_KD), *YC = WSP(bf16_t, WS_YCAT);
    struct RowRaw { u32x2 q[4]; u32x2 wv[16]; u32x2 cu; };
    auto row_load = [&](int r, RowRaw& R) {
        const bool isctx = r >= NX; const int t = isctx ? ((r - NX) & 255) : (r & 2047);
        const bf16_t* px = PX + (size_t)r * NIN;
        R.q[0] = *(const u32x2*)(px + 4 * lane); R.q[1] = *(const u32x2*)(px + 256 + 4 * lane); R.q[2] = *(const u32x2*)(px + 768 + 4 * lane); R.q[3] = *(const u32x2*)(px + 1024 + 4 * lane);
        if (!(l == 1 && isctx)) {
            const int g = lane >> 4, win = 2 << g, Ls = isctx ? LC : SEQ;
            int lo = t - win / 2, hi = lo + win; lo = lo < 0 ? 0 : lo; hi = hi > Ls ? Ls : hi;
            const bf16_t* base = PX + (size_t)(r - t) * NIN + 1536 + 4 * lane;
#pragma unroll
            for (int j = 0; j < 16; ++j) { const int tt = lo + j < hi ? lo + j : hi - 1; R.wv[j] = *(const u32x2*)(base + (size_t)tt * NIN); }
            R.cu = *(const u32x2*)(base + (size_t)t * NIN);
        }
    };
    RowRaw cur, nxt;
    if (gw < NT) row_load(gw, nxt);
    for (int r = gw; r < NT; r += ngw) {
        cur = nxt;
        if (r + ngw < NT) row_load(r + ngw, nxt);
        const bool isctx = r >= NX; int b, t, kidx;
        if (!isctx) { b = r >> 11; t = r & 2047; kidx = 256 + t; } else { const int rr = r - NX; b = rr >> 8; t = rr & 255; kidx = t; }
        const int h = lane >> 4, d4 = (4 * lane) & 63;
        const size_t obase = ((size_t)(b * 4 + h) * KEYS + kidx) * 64 + d4;
        float v[4];
        { unpack4(cur.q[0], v); float ss = v[0] * v[0] + v[1] * v[1] + v[2] * v[2] + v[3] * v[3];
          ss = sum16_dpp(ss);
          const float rs = rsqrtf(ss * (1.f / 64.f) + EPS) * 0.18033688f; const f32x4 g = *(const f32x4*)(p.na_qg + l * 64 + d4);
          u32x2 o; o.x = pk2(v[0] * rs * g.x, v[1] * rs * g.y); o.y = pk2(v[2] * rs * g.z, v[3] * rs * g.w); *(u32x2*)(QA + obase) = o; }
        { unpack4(cur.q[1], v); float ss = v[0] * v[0] + v[1] * v[1] + v[2] * v[2] + v[3] * v[3];
          ss = sum16_dpp(ss);
          const float rs = rsqrtf(ss * (1.f / 64.f) + EPS); const f32x4 g = *(const f32x4*)(p.na_kg + l * 64 + d4);
          u32x2 o; o.x = pk2(v[0] * rs * g.x, v[1] * rs * g.y); o.y = pk2(v[2] * rs * g.z, v[3] * rs * g.w); *(u32x2*)(KA + obase) = o; }
        const int li = lane & 7, d32 = 4 * li;
        float cs[4], sn[4];
        if (!isctx) {
            const int pos = (li & 4) ? (t & 63) : (t >> 6);
            const f32x4* rt = (const f32x4*)(ROPE + (pos * 8 + 4 * (li & 1)) * 2);
            const f32x4 r0 = rt[0], r1 = rt[1];
            cs[0] = r0.x; sn[0] = r0.y; cs[1] = r0.z; sn[1] = r0.w; cs[2] = r1.x; sn[2] = r1.y; cs[3] = r1.z; sn[3] = r1.w;
        }
#pragma unroll
        for (int which = 0; which < 2; ++which) {
            unpack4(cur.q[2 + which], v);
            float ss = v[0] * v[0] + v[1] * v[1] + v[2] * v[2] + v[3] * v[3];
            ss = sum8_dpp(ss);
            const float rs = rsqrtf(ss * (1.f / 32.f) + EPS);
            const f32x4 g = *(const f32x4*)((which ? p.df_kg : p.df_qg) + l * 32 + d32);
            float y[4] = {v[0] * rs * g.x, v[1] * rs * g.y, v[2] * rs * g.z, v[3] * rs * g.w};
            if (!isctx) {
#pragma unroll
                for (int e = 0; e < 4; ++e) { const float o = DPP_F(y[e], 0x4E); y[e] = (li & 2) ? (y[e] * cs[e] + o * sn[e]) : (y[e] * cs[e] - o * sn[e]); }
            }
            const float sc = which ? 1.f : 0.25503486f;
            u32x2 o; o.x = pk2(y[0] * sc, y[1] * sc); o.y = pk2(y[2] * sc, y[3] * sc);
            *(u32x2*)((which ? KD : QD) + obase) = o;
        }
        if (!(l == 1 && isctx)) {
            const int g = lane >> 4, win = 2 << g, Ls = isctx ? LC : SEQ;
            int lo = t - win / 2, hi = lo + win; lo = lo < 0 ? 0 : lo; hi = hi > Ls ? Ls : hi;
            float s[4] = {0.f, 0.f, 0.f, 0.f};
#pragma unroll
            for (int j = 0; j < 16; ++j) { float q[4]; unpack4(cur.wv[j], q); const float m = lo + j < hi ? 1.f : 0.f; s[0] += m * q[0]; s[1] += m * q[1]; s[2] += m * q[2]; s[3] += m * q[3]; }
            float u[4]; unpack4(cur.cu, u);
            const float inv = 1.f / (float)(hi - lo);
            u32x2 o; o.x = pk2(s[0] * inv - u[0], s[1] * inv - u[1]); o.y = pk2(s[2] * inv - u[2], s[3] * inv - u[3]);
            *(u32x2*)(YC + (size_t)r * DM + 512 + 4 * lane) = o;
        }
    }
    bf16_t* sm = (bf16_t*)smem + wave * (64 * 72);
    for (int it = gw; it < 2 * 8 * 4 * 36; it += ngw) {
        const int ch = it % 36, h = (it / 36) & 3, b = (it / 144) & 7, which = it / 1152;
        const int kidx = 64 * ch + lane; const int row = kidx < 256 ? NX + b * LC + kidx : b * SEQ + kidx - 256;
        const u32x4* src = (const u32x4*)(PX + (size_t)row * NIN + (which ? 1280 : 512) + 64 * h);
        u32x4 v[8];
#pragma unroll
        for (int i = 0; i < 8; ++i) v[i] = src[i];
        bf16_t* dst = (which ? WSP(bf16_t, WS_VTD) : WSP(bf16_t, WS_VTA)) + (size_t)(b * 4 + h) * 64 * KEYS + 64 * ch;
        wave_transpose_store(sm, v, dst, KEYS, lane, (lane & 48) | (((lane >> 2) & 1) << 3) | (((lane >> 3) & 1) << 2) | (lane & 3));
    }
    const int nC = 8 * 4 * 32 + (l == 0 ? 8 * 4 * 4 : 0);
    for (int it = gw; it < nC; it += ngw) {
        const bool cx = it >= 1024; const int q = cx ? it - 1024 : it;
        const int N = cx ? 256 : 2048, njc = N / 64;
        const int jc = q % njc, cc = (q / njc) & 3, b = q / (njc * 4);
        const int j = 64 * jc + lane; const int rowb = cx ? NX + b * LC : b * SEQ;
        int t1, t2, col; float sgn;
        if (j <= N / 2) { t1 = j; t2 = (j == 0 || j == N / 2) ? -1 : N - j; col = 1792 + 64 * cc; sgn = 1.f; }
        else { t1 = j - N / 2; t2 = N - t1; col = 2048 + 64 * cc; sgn = -1.f; }
        const u32x4* s1 = (const u32x4*)(PX + (size_t)(rowb + t1) * NIN + col);
        const u32x4* s2 = (const u32x4*)(PX + (size_t)(rowb + (t2 < 0 ? t1 : t2)) * NIN + col);
        const float w2 = t2 < 0 ? 0.f : sgn;
        u32x4 v[8];
#pragma unroll
        for (int i = 0; i < 8; ++i) {
            const u32x4 a = s1[i], bq = s2[i]; u32x4 o;
            o.x = pk2(bflo(a.x) + w2 * bflo(bq.x), bfhi(a.x) + w2 * bfhi(bq.x)); o.y = pk2(bflo(a.y) + w2 * bflo(bq.y), bfhi(a.y) + w2 * bfhi(bq.y));
            o.z = pk2(bflo(a.z) + w2 * bflo(bq.z), bfhi(a.z) + w2 * bfhi(bq.z)); o.w = pk2(bflo(a.w) + w2 * bflo(bq.w), bfhi(a.w) + w2 * bfhi(bq.w));
            v[i] = o;
        }
        bf16_t* dst = (cx ? WSP(bf16_t, WS_XFC) : WSP(bf16_t, WS_XF)) + (size_t)(b * 256 + 64 * cc) * N + 64 * jc;
        wave_transpose_store(sm, v, dst, N, lane, lane);
    }
}


__device__ __forceinline__ unsigned cvt_pk_bf16(float lo, float hi) { return pk2(lo, hi); }
__device__ __forceinline__ void phase_df_mfma(const Params& p, const int l, LAS unsigned char* lds) {
    const int tid = hid_tid(), wave = __builtin_amdgcn_readfirstlane(tid >> 6), lane = tid & 63, qn = lane & 31, hh = lane >> 5;
    const float* SC = WSP(float, WS_SCAL) + l * 16;
    const float lam = SC[0], lam_init = SC[1], negmb = -SC[2];
    const int nunits = 256 + (l == 0 ? 32 : 0);
    const int srow = tid >> 3, scq = (tid & 7) ^ ((srow >> 1) & 7);
    const unsigned ldsw = (unsigned)tid * 16u;
    f32x16 negm;
#pragma unroll
    for (int i = 0; i < 16; ++i) negm[i] = negmb;
    const int rsw = (qn >> 1) & 7;
    for (int it_ = 0;; ++it_) {
        int u;
        if (gridDim.x == 256) { if (it_ == 0) u = blockIdx.x; else { if (it_ > 1 || nunits <= 256 || blockIdx.x < 224) break; u = 256 + (255 - (int)blockIdx.x); } }
        else { u = blockIdx.x + it_ * (int)gridDim.x; if (u >= nunits) break; }
        const bool cx = u >= 256; const int qt = (u >> 3) & 7, bh = cx ? u - 256 : (u & 7) * 4 + (u >> 6), b = bh >> 2, h = bh & 3;
        const int q0 = cx ? 0 : 256 + 256 * qt, nkt = cx ? 4 : 36;
        const int orow = (cx ? NX + b * LC : b * SEQ + 256 * qt) + 32 * wave + qn;
        const char* Kg = (const char*)(WSP(bf16_t, WS_KD) + (size_t)bh * KEYS * 64) + srow * 128 + scq * 16;
        const char* Vg = (const char*)(WSP(bf16_t, WS_VTD) + (size_t)bh * 64 * KEYS) + (size_t)srow * KEYS * 2 + scq * 16;
        bf16x8 qf[2][2];
        { const bf16_t* Q = WSP(bf16_t, WS_QD) + ((size_t)bh * KEYS + q0 + 32 * wave + qn) * 64;
#pragma unroll
          for (int sub = 0; sub < 2; ++sub)
#pragma unroll
              for (int ks = 0; ks < 2; ++ks) qf[sub][ks] = *(const bf16x8*)(Q + 32 * sub + 16 * ks + 8 * hh); }
        f32x16 O1[2], O2[2]; float l1 = 0.f, l2 = 0.f;
        for (int trep_ = 0; trep_ < REP_TILE; ++trep_) {
#pragma unroll
        for (int db = 0; db < 2; ++db)
#pragma unroll
            for (int i = 0; i < 16; ++i) { O1[db][i] = 0.f; O2[db][i] = 0.f; }
        l1 = 0.f; l2 = 0.f;
        __syncthreads();
        __builtin_amdgcn_global_load_lds((const unsigned*)Kg, (LAS unsigned*)(lds + ldsw), 16, 0, 0);
        __builtin_amdgcn_global_load_lds((const unsigned*)Vg, (LAS unsigned*)(lds + 8192 + ldsw), 16, 0, 0);
        __builtin_amdgcn_global_load_lds((const unsigned*)(Kg + (size_t)64 * 128), (LAS unsigned*)(lds + 16384 + ldsw), 16, 0, 0);
        __builtin_amdgcn_global_load_lds((const unsigned*)(Vg + (size_t)64 * 2), (LAS unsigned*)(lds + 16384 + 8192 + ldsw), 16, 0, 0);
        asm volatile("s_waitcnt vmcnt(2)" ::: "memory"); __builtin_amdgcn_s_barrier();
        unsigned bo = 0u;
#pragma unroll 1
        for (int t = 0; t < nkt; ++t) {
            if (t + 2 < nkt) {
                const unsigned bn = bo == 0u ? 32768u : bo - 16384u;
                __builtin_amdgcn_global_load_lds((const unsigned*)(Kg + (size_t)(t + 2) * 64 * 128), (LAS unsigned*)(lds + bn + ldsw), 16, 0, 0);
                __builtin_amdgcn_global_load_lds((const unsigned*)(Vg + (size_t)(t + 2) * 64 * 2), (LAS unsigned*)(lds + bn + 8192 + ldsw), 16, 0, 0);
            }
#pragma unroll
            for (int kb = 0; kb < 2; ++kb) {
                const LAS unsigned char* kt = lds + bo + (32 * kb + qn) * 128;
                bf16x8 kf[2][2];
#pragma unroll
                for (int sub = 0; sub < 2; ++sub)
#pragma unroll
                    for (int ks = 0; ks < 2; ++ks) kf[sub][ks] = *(const LAS bf16x8*)(kt + (((4 * sub + 2 * ks + hh) ^ rsw) << 4));
                f32x16 S1 = __builtin_amdgcn_mfma_f32_32x32x16_bf16(kf[0][0], qf[0][0], negm, 0, 0, 0);
                S1 = __builtin_amdgcn_mfma_f32_32x32x16_bf16(kf[0][1], qf[0][1], S1, 0, 0, 0);
                f32x16 S2 = __builtin_amdgcn_mfma_f32_32x32x16_bf16(kf[1][0], qf[1][0], negm, 0, 0, 0);
                S2 = __builtin_amdgcn_mfma_f32_32x32x16_bf16(kf[1][1], qf[1][1], S2, 0, 0, 0);
                bf16x8 vf[2][2];
#pragma unroll
                for (int db = 0; db < 2; ++db)
#pragma unroll
                    for (int s = 0; s < 2; ++s) vf[db][s] = *(const LAS bf16x8*)(lds + bo + 8192 + (32 * db + qn) * 128 + (((4 * kb + 2 * s + hh) ^ rsw) << 4));
                unsigned pa[8], pb[8];
#pragma unroll
                for (int i = 0; i < 8; ++i) {
                    const float a0 = __builtin_amdgcn_exp2f(S1[2 * i]), a1 = __builtin_amdgcn_exp2f(S1[2 * i + 1]);
                    const float b0 = __builtin_amdgcn_exp2f(S2[2 * i]), b1 = __builtin_amdgcn_exp2f(S2[2 * i + 1]);
                    l1 += a0 + a1; l2 += b0 + b1;
                    pa[i] = cvt_pk_bf16(a0, a1); pb[i] = cvt_pk_bf16(b0, b1);
                }
                bf16x8 P1[2], P2[2];
#pragma unroll
                for (int s = 0; s < 2; ++s) {
                    const u32x4 wa = {pa[4 * s], pa[4 * s + 1], pa[4 * s + 2], pa[4 * s + 3]}, wb = {pb[4 * s], pb[4 * s + 1], pb[4 * s + 2], pb[4 * s + 3]};
                    P1[s] = *(const bf16x8*)&wa; P2[s] = *(const bf16x8*)&wb;
                }
#pragma unroll
                for (int db = 0; db < 2; ++db)
#pragma unroll
                    for (int s = 0; s < 2; ++s) {
                        O1[db] = __builtin_amdgcn_mfma_f32_32x32x16_bf16(vf[db][s], P1[s], O1[db], 0, 0, 0);
                        O2[db] = __builtin_amdgcn_mfma_f32_32x32x16_bf16(vf[db][s], P2[s], O2[db], 0, 0, 0);
                    }
            }
            if (t + 2 < nkt) asm volatile("s_waitcnt vmcnt(2)" ::: "memory"); else asm volatile("s_waitcnt vmcnt(0)" ::: "memory");
            __builtin_amdgcn_s_barrier();
            bo = bo >= 32768u ? 0u : bo + 16384u;
        }
        }
        l1 += __shfl_xor(l1, 32); l2 += __shfl_xor(l2, 32);
        const float i1 = 1.f / l1, i2 = lam / l2; float ss = 0.f;
#pragma unroll
        for (int db = 0; db < 2; ++db)
#pragma unroll
            for (int i = 0; i < 16; ++i) { const float o = O1[db][i] * i1 - O2[db][i] * i2; O1[db][i] = o; ss += o * o; }
        ss += __shfl_xor(ss, 32);
        const float rs = rsqrtf(ss * (1.f / 64.f) + EPS) * (1.f - lam_init);
        bf16_t* op = WSP(bf16_t, WS_YCAT) + (size_t)orow * DM + 256 + 64 * h + 4 * hh;
        const float* sl = p.subln + l * 64 + 4 * hh;
#pragma unroll
        for (int db = 0; db < 2; ++db)
#pragma unroll
            for (int i = 0; i < 4; ++i) {
                const int d = 32 * db + 8 * i; const f32x4 g = *(const f32x4*)(sl + d);
                u32x2 o; o.x = pk2(O1[db][4 * i] * rs * g.x, O1[db][4 * i + 1] * rs * g.y); o.y = pk2(O1[db][4 * i + 2] * rs * g.z, O1[db][4 * i + 3] * rs * g.w);
                *(u32x2*)(op + d) = o;
            }
    }
    __syncthreads();
}


__device__ __forceinline__ void phase_na_mfma(const Params& p, const int l, LAS unsigned char* lds) {
    const int tid = hid_tid(), wave = __builtin_amdgcn_readfirstlane(tid >> 6), lane = tid & 63, qn = lane & 31, hh = lane >> 5;
    const float* SC = WSP(float, WS_SCAL) + l * 16;
    const int nunits = 256 + (l == 0 ? 32 : 0);
    const int srow = tid >> 3, scq = (tid & 7) ^ ((srow >> 1) & 7);
    const unsigned ldsw = (unsigned)tid * 16u;
    const int rsw = (qn >> 1) & 7;
    LAS float* btab = (LAS float*)(lds + 49152);
    for (int it_ = 0;; ++it_) {
        int u;
        if (gridDim.x == 256) { if (it_ == 0) u = blockIdx.x; else { if (it_ > 1 || nunits <= 256 || blockIdx.x < 224) break; u = 256 + (255 - (int)blockIdx.x); } }
        else { u = blockIdx.x + it_ * (int)gridDim.x; if (u >= nunits) break; }
        const bool cx = u >= 256; const int bh = cx ? u - 256 : (u & 7) * 4 + (u >> 6), rg = (u >> 3) & 7, b = bh >> 2, h = bh & 3;
        __syncthreads();
        for (int i = tid; i < 15 * 32; i += 512) { const int rr = i >> 5, cc = i & 31; btab[i] = cc < 31 ? p.na_rpb[((size_t)(l * 4 + h) * 15 + rr) * 31 + cc] * 1.44269504f : -__builtin_inff(); }
        const int r = 4 * rg + (wave >> 1), qc = 32 * (wave & 1) + qn;
        const int qidx = cx ? 32 * wave + qn : 256 + 64 * r + qc;
        const int orow = cx ? NX + b * LC + 32 * wave + qn : b * SEQ + 64 * r + qc;
        bf16x8 qf[4];
        { const bf16_t* Q = WSP(bf16_t, WS_QA) + ((size_t)bh * KEYS + qidx) * 64;
#pragma unroll
          for (int ks = 0; ks < 4; ++ks) qf[ks] = *(const bf16x8*)(Q + 16 * ks + 8 * hh); }
        int cs = qc - 8; cs = cs < 0 ? 0 : (cs > 48 ? 48 : cs);
        int boff[2][16];
#pragma unroll
        for (int kb = 0; kb < 2; ++kb)
#pragma unroll
            for (int rg2 = 0; rg2 < 16; ++rg2) {
                const int kc = 32 * kb + (rg2 & 3) + 8 * (rg2 >> 2) + 4 * hh;
                int dk = kc - qc; dk = dk < -15 ? -15 : (dk > 15 ? 15 : dk);
                boff[kb][rg2] = ((unsigned)(kc - cs) < 16u) ? 4 * (dk + 15) : 4 * 31;
            }
        int rs = r - 4; rs = rs < 0 ? 0 : (rs > 24 ? 24 : rs);
        int krlo = 4 * rg - 4; krlo = krlo < 0 ? 0 : (krlo > 24 ? 24 : krlo);
        int krhi = 4 * rg - 1; krhi = (krhi < 0 ? 0 : (krhi > 24 ? 24 : krhi)) + 7;
        const int ntile = cx ? 4 : 4 + (krhi - krlo + 1);
        const float negmb = -SC[4 + h];
        f32x16 negm;
#pragma unroll
        for (int i = 0; i < 16; ++i) negm[i] = negmb;
        const char* Kg = (const char*)(WSP(bf16_t, WS_KA) + (size_t)bh * KEYS * 64) + srow * 128 + scq * 16;
        const char* Vg = (const char*)(WSP(bf16_t, WS_VTA) + (size_t)bh * 64 * KEYS) + (size_t)srow * KEYS * 2 + scq * 16;
        f32x16 O[2]; float ls = 0.f;
        for (int trep_ = 0; trep_ < REP_TILE; ++trep_) {
        if (trep_) __syncthreads();
#pragma unroll
        for (int db = 0; db < 2; ++db)
#pragma unroll
            for (int i = 0; i < 16; ++i) O[db][i] = 0.f;
        ls = 0.f;
        __builtin_amdgcn_global_load_lds((const unsigned*)Kg, (LAS unsigned*)(lds + ldsw), 16, 0, 0);
        __builtin_amdgcn_global_load_lds((const unsigned*)Vg, (LAS unsigned*)(lds + 8192 + ldsw), 16, 0, 0);
        __builtin_amdgcn_global_load_lds((const unsigned*)(Kg + (size_t)64 * 128), (LAS unsigned*)(lds + 16384 + ldsw), 16, 0, 0);
        __builtin_amdgcn_global_load_lds((const unsigned*)(Vg + (size_t)64 * 2), (LAS unsigned*)(lds + 16384 + 8192 + ldsw), 16, 0, 0);
        asm volatile("s_waitcnt vmcnt(2)" ::: "memory"); __builtin_amdgcn_s_barrier();
        unsigned bo = 0u;
#pragma unroll 1
        for (int i = 0; i < ntile; ++i) {
            if (i + 2 < ntile) {
                const int tn = (i + 2 < 4) ? i + 2 : 4 + krlo + (i + 2 - 4);
                const unsigned bn = bo == 0u ? 32768u : bo - 16384u;
                __builtin_amdgcn_global_load_lds((const unsigned*)(Kg + (size_t)tn * 64 * 128), (LAS unsigned*)(lds + bn + ldsw), 16, 0, 0);
                __builtin_amdgcn_global_load_lds((const unsigned*)(Vg + (size_t)tn * 64 * 2), (LAS unsigned*)(lds + bn + 8192 + ldsw), 16, 0, 0);
            }
            const int kr = krlo + i - 4;
            const bool local = i >= 4;
            if (!local || (kr >= rs && kr < rs + 8)) {
                const int brow = local ? (kr - r + 7) * 128 : 0;
#pragma unroll
                for (int kb = 0; kb < 2; ++kb) {
                    const LAS unsigned char* kt = lds + bo + (32 * kb + qn) * 128;
                    bf16x8 kf[4];
#pragma unroll
                    for (int ks = 0; ks < 4; ++ks) kf[ks] = *(const LAS bf16x8*)(kt + (((2 * ks + hh) ^ rsw) << 4));
                    f32x16 S = __builtin_amdgcn_mfma_f32_32x32x16_bf16(kf[0], qf[0], negm, 0, 0, 0);
#pragma unroll
                    for (int ks = 1; ks < 4; ++ks) S = __builtin_amdgcn_mfma_f32_32x32x16_bf16(kf[ks], qf[ks], S, 0, 0, 0);
                    bf16x8 vf[2][2];
#pragma unroll
                    for (int db = 0; db < 2; ++db)
#pragma unroll
                        for (int s = 0; s < 2; ++s) vf[db][s] = *(const LAS bf16x8*)(lds + bo + 8192 + (32 * db + qn) * 128 + (((4 * kb + 2 * s + hh) ^ rsw) << 4));
                    if (local) {
#pragma unroll
                        for (int rg2 = 0; rg2 < 16; ++rg2) S[rg2] += *(const LAS float*)((const LAS unsigned char*)btab + brow + boff[kb][rg2]);
                    }
                    unsigned pa[8];
#pragma unroll
                    for (int j = 0; j < 8; ++j) {
                        const float a0 = __builtin_amdgcn_exp2f(S[2 * j]), a1 = __builtin_amdgcn_exp2f(S[2 * j + 1]);
                        ls += a0 + a1; pa[j] = pk2(a0, a1);
                    }
                    bf16x8 P[2];
#pragma unroll
                    for (int s = 0; s < 2; ++s) { const u32x4 wa = {pa[4 * s], pa[4 * s + 1], pa[4 * s + 2], pa[4 * s + 3]}; P[s] = *(const bf16x8*)&wa; }
#pragma unroll
                    for (int db = 0; db < 2; ++db)
#pragma unroll
                        for (int s = 0; s < 2; ++s) O[db] = __builtin_amdgcn_mfma_f32_32x32x16_bf16(vf[db][s], P[s], O[db], 0, 0, 0);
                }
            }
            if (i + 2 < ntile) asm volatile("s_waitcnt vmcnt(2)" ::: "memory"); else asm volatile("s_waitcnt vmcnt(0)" ::: "memory");
            __builtin_amdgcn_s_barrier();
            bo = bo >= 32768u ? 0u : bo + 16384u;
        }
        }
        ls += __shfl_xor(ls, 32);
        const float il = 1.f / ls;
        bf16_t* op = WSP(bf16_t, WS_YCAT) + (size_t)orow * DM + 64 * h + 4 * hh;
#pragma unroll
        for (int db = 0; db < 2; ++db)
#pragma unroll
            for (int i = 0; i < 4; ++i) {
                u32x2 o; o.x = pk2(O[db][4 * i] * il, O[db][4 * i + 1] * il); o.y = pk2(O[db][4 * i + 2] * il, O[db][4 * i + 3] * il);
                *(u32x2*)(op + 32 * db + 8 * i) = o;
            }
    }
    __syncthreads();
}

constexpr int RB = 72;
constexpr int HSTR = 2064;
__device__ __forceinline__ void phase_route(const Params& p, const int l, unsigned char* smem, const int cnt_off) {
    unsigned char* HN = smem;
    float* LOGIT = (float*)(smem + RB * HSTR);
    int* hist = (int*)(smem + RB * HSTR + RB * 32 * 4); int* base = hist + 32; int* s_e = base + 32; int* s_lp = s_e + RB * 4; float* s_g = (float*)(s_lp + RB * 4);
    const int tid = hid_tid(), lane = tid & 63, wave = tid >> 6, fr = lane & 15, fq = lane >> 4;
    const int nrows = (l == 0) ? NT : NX;
    const float* MOD = WSP(float, WS_MOD); unsigned char* H8 = WSP(unsigned char, WS_H8); const bf16_t* X1 = WSP(bf16_t, WS_X1);
    const bf16_t* RWT = WSP(bf16_t, WS_RWT) + (size_t)l * 32 * 1024;
    int* cnt = WSP(int, WS_CTL + CTL_CNT + cnt_off) + l * 32;
    int *RTE = WSP(int, WS_RTE), *RTP = WSP(int, WS_RTP), *LIST = WSP(int, WS_LIST); float* RTG = WSP(float, WS_RTG);
    const float rb0 = p.router_b[l * 32 + fr], rb1 = p.router_b[l * 32 + 16 + fr];
    for (int r0 = blockIdx.x * RB; r0 < nrows; r0 += gridDim.x * RB) {
        __syncthreads();
        if (tid < 32) hist[tid] = 0;
        const int nr = (nrows - r0) < RB ? (nrows - r0) : RB;
        u32x2 vn[4];
        if (wave < nr) {
#pragma unroll
            for (int j = 0; j < 4; ++j) vn[j] = ((const u32x2*)(X1 + (size_t)(r0 + wave) * DM))[lane + 64 * j];
        }
        int cmi = -1; f32x4 mA[4], mB[4];
        for (int i = wave; i < nr; i += 8) {
            const int r = r0 + i;
            if (mod_index(r) != cmi) {
                cmi = mod_index(r);
                const float* m = MOD + (size_t)(l * 9 + cmi) * 6144; const float* gw = p.g2w + l * 1024;
#pragma unroll
                for (int j = 0; j < 4; ++j) { const int c = 4 * lane + 256 * j; const f32x4 g = *(const f32x4*)(gw + c), s1 = *(const f32x4*)(m + 4 * 1024 + c);
                    mA[j].x = g.x * (1.f + s1.x); mA[j].y = g.y * (1.f + s1.y); mA[j].z = g.z * (1.f + s1.z); mA[j].w = g.w * (1.f + s1.w); mB[j] = *(const f32x4*)(m + 3 * 1024 + c); }
            }
            f32x4 v[4]; float ss = 0.f;
#pragma unroll
            for (int j = 0; j < 4; ++j) { v[j] = (f32x4){bflo(vn[j].x), bfhi(vn[j].x), bflo(vn[j].y), bfhi(vn[j].y)}; ss += v[j].x * v[j].x + v[j].y * v[j].y + v[j].z * v[j].z + v[j].w * v[j].w; }
            if (i + 8 < nr) {
#pragma unroll
                for (int j = 0; j < 4; ++j) vn[j] = ((const u32x2*)(X1 + (size_t)(r + 8) * DM))[lane + 64 * j];
            }
            ss = wave_sum_fast(ss);
            const float rs = rsqrtf(ss * (1.f / DM) + EPS);
#pragma unroll
            for (int j = 0; j < 4; ++j) {
                const int c = 4 * lane + 256 * j;
                f32x4 o;
                o.x = v[j].x * rs * mA[j].x + mB[j].x; o.y = v[j].y * rs * mA[j].y + mB[j].y;
                o.z = v[j].z * rs * mA[j].z + mB[j].z; o.w = v[j].w * rs * mA[j].w + mB[j].w;
                *(unsigned*)(H8 + (size_t)r * DM + c) = pk4_fp8(fminf(fmaxf(o.x * SH8, -448.f), 448.f), fminf(fmaxf(o.y * SH8, -448.f), 448.f), fminf(fmaxf(o.z * SH8, -448.f), 448.f), fminf(fmaxf(o.w * SH8, -448.f), 448.f));
                u32x2 hb; hb.x = pk2(o.x, o.y); hb.y = pk2(o.z, o.w);
                *(u32x2*)(HN + i * HSTR + c * 2) = hb;
            }
        }
        __syncthreads();
        if (wave < 5 && 16 * wave < nr) {
            f32x4 a0 = {0.f, 0.f, 0.f, 0.f}, a1 = {0.f, 0.f, 0.f, 0.f};
            const unsigned char* arow = HN + (16 * wave + fr) * HSTR + fq * 16;
            const bf16_t* b0p = RWT + (size_t)fr * 1024 + fq * 8; const bf16_t* b1p = b0p + 16 * 1024;
#pragma unroll 8
            for (int ks = 0; ks < 32; ++ks) {
                const bf16x8 a = *(const bf16x8*)(arow + ks * 64);
                const bf16x8 b0 = *(const bf16x8*)(b0p + ks * 32), b1 = *(const bf16x8*)(b1p + ks * 32);
                a0 = __builtin_amdgcn_mfma_f32_16x16x32_bf16(a, b0, a0, 0, 0, 0);
                a1 = __builtin_amdgcn_mfma_f32_16x16x32_bf16(a, b1, a1, 0, 0, 0);
            }
#pragma unroll
            for (int q = 0; q < 4; ++q) { const int row = 16 * wave + 4 * fq + q; if (row < nr) { LOGIT[row * 32 + fr] = a0[q] + rb0; LOGIT[row * 32 + 16 + fr] = a1[q] + rb1; } }
        }
        __syncthreads();
        for (int i = wave; i < nr; i += 8) {
            const float logit = LOGIT[i * 32 + (lane & 31)];
            float tv[4]; int ti[4];
            {
                const int me = lane & 31; int rank = 0;
#pragma unroll
                for (int e = 0; e < 32; ++e) { const float ov = __builtin_bit_cast(float, __builtin_amdgcn_readlane(__builtin_bit_cast(int, logit), e)); rank += ((ov > logit) || (ov == logit && e < me)) ? 1 : 0; }
#pragma unroll
                for (int k = 0; k < 4; ++k) {
                    const unsigned long long mk = __ballot(rank == k);
                    const int srcl = __builtin_amdgcn_readfirstlane((int)__builtin_ctzll(mk));
                    ti[k] = srcl & 31; tv[k] = __builtin_bit_cast(float, __builtin_amdgcn_readlane(__builtin_bit_cast(int, logit), srcl));
                }
            }
            const float e1 = __expf(tv[1] - tv[0]), e2 = __expf(tv[2] - tv[0]), e3 = __expf(tv[3] - tv[0]); const float inv = 1.f / (1.f + e1 + e2 + e3);
            if (lane < 4) {
                const int te = lane == 0 ? ti[0] : lane == 1 ? ti[1] : lane == 2 ? ti[2] : ti[3];
                const float tg = (lane == 0 ? 1.f : lane == 1 ? e1 : lane == 2 ? e2 : e3) * inv;
                s_e[i * 4 + lane] = te; s_g[i * 4 + lane] = tg; s_lp[i * 4 + lane] = atomicAdd(&hist[te], 1);
            }
        }
        __syncthreads();
        if (tid < 32) base[tid] = hist[tid] ? atomicAdd(&cnt[tid], hist[tid]) : 0;
        __syncthreads();
        for (int i = tid; i < nr * 4; i += 512) {
            const int r = r0 + (i >> 2), e = s_e[i], pos = base[e] + s_lp[i];
            RTE[(size_t)r * 4 + (i & 3)] = e; RTP[(size_t)r * 4 + (i & 3)] = pos; RTG[(size_t)r * 4 + (i & 3)] = s_g[i];
            LIST[(size_t)e * NT + pos] = r;
        }
    }
    __syncthreads();
}

__device__ __forceinline__ void phase_combine(const Params& p, const int l, const int* tinfo) {
    const int tid = hid_tid(), lane = tid & 63, wave = tid >> 6;
    const int gw = blockIdx.x * 8 + wave, ngw = gridDim.x * 8;
    const int nrows = (l == 0) ? NT : NX;
    const float* MOD = WSP(float, WS_MOD); const bf16_t* X1 = WSP(bf16_t, WS_X1); const unsigned char* Y2 = WSP(unsigned char, WS_Y2);
    const int *RTE = WSP(int, WS_RTE), *RTP = WSP(int, WS_RTP); const float* RTG = WSP(float, WS_RTG);
    int ne[4], np_[4]; float ng[4];
    if (gw < nrows) {
#pragma unroll
        for (int k = 0; k < 4; ++k) { ne[k] = RTE[(size_t)gw * 4 + k]; np_[k] = RTP[(size_t)gw * 4 + k]; ng[k] = RTG[(size_t)gw * 4 + k]; }
    }
    int cmi = -1; f32x4 g2v[4], nA[4], nB[4];
    for (int r = gw; r < nrows; r += ngw) {
        if (mod_index(r) != cmi) {
            cmi = mod_index(r);
            const float* g2 = MOD + (size_t)(l * 9 + cmi) * 6144 + 5 * 1024; const float* m = MOD + (size_t)(1 * 9 + cmi) * 6144;
#pragma unroll
            for (int j = 0; j < 4; ++j) { const int c = 4 * lane + 256 * j; g2v[j] = *(const f32x4*)(g2 + c);
                if (l == 0) { const f32x4 g = *(const f32x4*)(p.g1w + 1024 + c), s1 = *(const f32x4*)(m + 1024 + c);
                    nA[j].x = g.x * (1.f + s1.x); nA[j].y = g.y * (1.f + s1.y); nA[j].z = g.z * (1.f + s1.z); nA[j].w = g.w * (1.f + s1.w); nB[j] = *(const f32x4*)(m + c); } }
        }
        const unsigned char* yr[4]; float gk[4];
#pragma unroll
        for (int k = 0; k < 4; ++k) { yr[k] = Y2 + ((size_t)tinfo[ne[k]] * 256 + np_[k]) * DM; gk[k] = ng[k] * (1.f / SY8); }
        unsigned yv[4][4]; u32x2 x1v[4]; f32x4 gv[4];
#pragma unroll
        for (int j = 0; j < 4; ++j) {
            const int c = 4 * lane + 256 * j;
#pragma unroll
            for (int k = 0; k < 4; ++k) yv[j][k] = *(const unsigned*)(yr[k] + c);
            x1v[j] = *(const u32x2*)(X1 + (size_t)r * DM + c); gv[j] = g2v[j];
        }
        if (r + ngw < nrows) {
#pragma unroll
            for (int k = 0; k < 4; ++k) { ne[k] = RTE[(size_t)(r + ngw) * 4 + k]; np_[k] = RTP[(size_t)(r + ngw) * 4 + k]; ng[k] = RTG[(size_t)(r + ngw) * 4 + k]; }
        }
        f32x4 xv[4];
#pragma unroll
        for (int j = 0; j < 4; ++j) {
            const int c = 4 * lane + 256 * j;
            float s[4] = {0.f, 0.f, 0.f, 0.f};
#pragma unroll
            for (int k = 0; k < 4; ++k) { const f32x2 ya = __builtin_amdgcn_cvt_pk_f32_fp8((int)yv[j][k], false), yb = __builtin_amdgcn_cvt_pk_f32_fp8((int)yv[j][k], true); s[0] += gk[k] * ya.x; s[1] += gk[k] * ya.y; s[2] += gk[k] * yb.x; s[3] += gk[k] * yb.y; }
            const f32x4 x1 = {bflo(x1v[j].x), bfhi(x1v[j].x), bflo(x1v[j].y), bfhi(x1v[j].y)}, g = gv[j];
            f32x4 o; o.x = x1.x + g.x * s[0]; o.y = x1.y + g.y * s[1]; o.z = x1.z + g.z * s[2]; o.w = x1.w + g.w * s[3];
            if (l == 0) { u32x2 ob; ob.x = pk2(o.x, o.y); ob.y = pk2(o.z, o.w); *(u32x2*)(WSP(bf16_t, WS_X2) + (size_t)r * DM + c) = ob; }
            else *(f32x4*)(p.out + (size_t)r * DM + c) = o;
            xv[j] = o;
        }
        if (l == 0) {
            float ss = 0.f;
#pragma unroll
            for (int j = 0; j < 4; ++j) ss += xv[j].x * xv[j].x + xv[j].y * xv[j].y + xv[j].z * xv[j].z + xv[j].w * xv[j].w;
            ss = wave_sum_fast(ss); const float rs = rsqrtf(ss * (1.f / DM) + EPS);
            unsigned char* hrow = WSP(unsigned char, WS_H) + (size_t)r * DM;
#pragma unroll
            for (int j = 0; j < 4; ++j) {
                const int c = 4 * lane + 256 * j;
                *(unsigned*)(hrow + c) = pk4_fp8(cl8((xv[j].x * rs * nA[j].x + nB[j].x) * SH8), cl8((xv[j].y * rs * nA[j].y + nB[j].y) * SH8),
                                                 cl8((xv[j].z * rs * nA[j].z + nB[j].z) * SH8), cl8((xv[j].w * rs * nA[j].w + nB[j].w) * SH8));
            }
        }
    }
}

#define XB_TMO      128
#define XB_XCNT(j)  (256  + 64 * (j))
#define XB_XSUB(j)  (1280 + 64 * (j))
#define XB_XGEN(j)  (2304 + 64 * (j))
#define XB_TOP      3328
#define XB_TOPGEN   3392
#define XCD_BAR_WORDS 3456
#define XB_SPIN_CAP (1u << 18)
__device__ __forceinline__ unsigned xb_ld(unsigned* p)              { return __hip_atomic_load(p, __ATOMIC_RELAXED, __HIP_MEMORY_SCOPE_AGENT); }
__device__ __forceinline__ unsigned xb_add(unsigned* p, unsigned v) { return __hip_atomic_fetch_add(p, v, __ATOMIC_RELAXED, __HIP_MEMORY_SCOPE_AGENT); }
__device__ __forceinline__ unsigned xb_xcc_id() { return (unsigned)__builtin_amdgcn_s_getreg((3 << 11) | 20) & 0xFu; }
#define XB_SPIN(cond, bar) do { unsigned _sp = 0; while (cond) { __builtin_amdgcn_s_sleep(1); \
    if ((++_sp & 255u) == 0u) { if (xb_ld(&(bar)[XB_TMO])) break; if (_sp > XB_SPIN_CAP) { atomicAdd(&(bar)[XB_TMO], 1u); break; } } } } while (0)
struct XcdBarrier { unsigned* bar; unsigned x; volatile LAS unsigned* st; };
__device__ __forceinline__ XcdBarrier xcd_barrier_post(unsigned* bar, volatile LAS unsigned* st) {
    XcdBarrier b; b.bar = bar; b.x = xb_xcc_id(); b.st = st;
    if (threadIdx.x == 0) (void)xb_add(&bar[XB_XCNT(b.x)], 1u);
    return b;
}
__device__ __forceinline__ void xcd_barrier_complete(unsigned* bar, unsigned x, unsigned& nloc, unsigned& nx) {
    const unsigned G = gridDim.x * gridDim.y * gridDim.z;
    unsigned sum, cnt, mine, sp = 0u;
    for (;;) {
        sum = 0u; cnt = 0u; mine = 0u;
#pragma unroll
        for (unsigned j = 0; j < 16; ++j) { const unsigned c = xb_ld(&bar[XB_XCNT(j)]); sum += c; cnt += (c > 0u) ? 1u : 0u; mine = (j == x) ? c : mine; }
        if (sum == G) break;
        __builtin_amdgcn_s_sleep(1);
        if ((++sp & 255u) == 0u) { if (xb_ld(&bar[XB_TMO])) break; if (sp > XB_SPIN_CAP) { atomicAdd(&bar[XB_TMO], 1u); break; } }
    }
    nloc = mine > 0u ? mine : 1u; nx = cnt > 0u ? cnt : 1u;
}
__device__ __forceinline__ void xcd_barrier(const XcdBarrier& b) {
    asm volatile("s_waitcnt vmcnt(0)" ::: "memory");
    __syncthreads();
    if (threadIdx.x == 0) {
        unsigned* bar = b.bar;
        __builtin_amdgcn_s_waitcnt(0);
        unsigned nloc = b.st[0], nx = b.st[1];
        if (nloc == 0u) { xcd_barrier_complete(bar, b.x, nloc, nx); b.st[0] = nloc; b.st[1] = nx; }
        const unsigned old = xb_add(&bar[XB_XSUB(b.x)], 1u);
        const unsigned gen = old / nloc;
        if (old + 1u == (gen + 1u) * nloc) {
            __builtin_amdgcn_fence(__ATOMIC_RELEASE, "agent");
            asm volatile("s_waitcnt vmcnt(0)" ::: "memory");
            const unsigned og = xb_add(&bar[XB_TOP], 1u);
            const unsigned tg = og / nx;
            if (og + 1u == (tg + 1u) * nx) xb_add(&bar[XB_TOPGEN], 1u);
            else XB_SPIN(xb_ld(&bar[XB_TOPGEN]) == tg, bar);
            __builtin_amdgcn_fence(__ATOMIC_ACQUIRE, "agent");
            xb_add(&bar[XB_XGEN(b.x)], 1u);
            asm volatile("s_waitcnt vmcnt(0)" ::: "memory");
        } else {
            XB_SPIN(xb_ld(&bar[XB_XGEN(b.x)]) == gen, bar);
            __builtin_amdgcn_fence(__ATOMIC_ACQUIRE, "agent");
            asm volatile("s_waitcnt vmcnt(0)" ::: "memory");
        }
    }
    __syncthreads();
}

constexpr int LDS_BYTES = 163840;
constexpr int MISC_OFF = LDS_BYTES - 2048;
constexpr int NCH_L = 3072;
constexpr size_t CTL_CHUNK = 40960, CTL_DONE = 41472;
__device__ __forceinline__ void conv_item(const Params& p, unsigned char* smem, int l, int q, int wave, int lane) {
    unsigned char* tsm = smem + wave * (64 * 144);
    if (q < 16384) { const int m = l * 32 + (q >> 9), r = q & 511; transpose_item8(p.w1 + (size_t)m * 1024 * 2048, 2048, 1024, WSP(unsigned char, WS_W1) + (size_t)m * 2048 * 1024, tsm, r & 15, r >> 4, lane); }
    else { const int q2 = q - 16384, m = l * 32 + (q2 >> 8), r = q2 & 255; transpose_item8(p.w2 + (size_t)m * 1024 * 1024, 1024, 1024, WSP(unsigned char, WS_W2) + (size_t)m * 1024 * 1024, tsm, r & 15, r >> 4, lane); }
}
__device__ __forceinline__ void idle_fill(const Params& p, unsigned char* smem, const int phase, const int l) {
    const int tid = hid_tid(), lane = tid & 63, wave = tid >> 6;
    volatile int* cslot = (volatile int*)(smem + MISC_OFF + 512);
    unsigned* chunk = WSP(unsigned, WS_CTL + CTL_CHUNK + 256 * l); unsigned* done = WSP(unsigned, WS_CTL + CTL_DONE + 256 * phase);
    __syncthreads();
    if (tid == 0) {
        __hip_atomic_fetch_add(done, 1u, __ATOMIC_RELAXED, __HIP_MEMORY_SCOPE_AGENT);
        int c = -1;
        if (__hip_atomic_load(done, __ATOMIC_RELAXED, __HIP_MEMORY_SCOPE_AGENT) < gridDim.x) { const unsigned g = __hip_atomic_fetch_add(chunk, 1u, __ATOMIC_RELAXED, __HIP_MEMORY_SCOPE_AGENT); if (g < (unsigned)NCH_L) c = (int)g; }
        cslot[0] = c;
    }
    __syncthreads();
    int c = cslot[0];
    while (c >= 0) {
        __syncthreads();
        unsigned gnext = 0xffffffffu; bool more = false;
        if (tid == 0) { more = __hip_atomic_load(done, __ATOMIC_RELAXED, __HIP_MEMORY_SCOPE_AGENT) < gridDim.x; if (more) gnext = __hip_atomic_fetch_add(chunk, 1u, __ATOMIC_RELAXED, __HIP_MEMORY_SCOPE_AGENT); }
        conv_item(p, smem, l, c * 8 + wave, wave, lane);
        if (tid == 0) cslot[0] = (more && gnext < (unsigned)NCH_L) ? (int)gnext : -1;
        __syncthreads();
        c = cslot[0];
    }
}
__device__ __forceinline__ void conv_drain(const Params& p, unsigned char* smem, const int l) {
    const int tid = hid_tid(), lane = tid & 63, wave = tid >> 6;
    const int gw = blockIdx.x * 8 + wave, ngw = gridDim.x * 8;
    unsigned cst = __hip_atomic_load(WSP(unsigned, WS_CTL + CTL_CHUNK + 256 * l), __ATOMIC_RELAXED, __HIP_MEMORY_SCOPE_AGENT);
    cst = cst > (unsigned)NCH_L ? (unsigned)NCH_L : cst;
    __syncthreads();
    for (int q = (int)cst * 8 + gw; q < NCH_L * 8; q += ngw) conv_item(p, smem, l, q, wave, lane);
    __syncthreads();
}

__global__ void __launch_bounds__(512, 2) k_fwd(Params p) {
    extern __shared__ __attribute__((aligned(16))) unsigned char smem[];
    int* tinfo = (int*)(smem + MISC_OFF + 64);
    if (threadIdx.x < 4) ((unsigned*)(smem + MISC_OFF))[threadIdx.x] = 0u;
    __syncthreads();
    XcdBarrier bar = xcd_barrier_post(WSP(unsigned, WS_CTL), (volatile LAS unsigned*)(smem + MISC_OFF));
    phase_pro0(p, smem);
    __syncthreads();
    REPEAT(REP_PRO1, phase_pro1(p, smem); __syncthreads());
    xcd_barrier(bar);
#define LAYER(l) do { \
        REPEAT(REP_WIN, gemm_phase256<G_WIN>(p, l, (LAS unsigned char*)smem, tinfo)); \
        REPEAT(REP_BAR, xcd_barrier(bar)); \
        REPEAT(REP_PREP, phase_prep(p, l, smem); __syncthreads()); \
        REPEAT(REP_BAR, xcd_barrier(bar)); \
          \
        REPEAT(REP_DFT, gemm_phase256<G_DFT>(p, l, (LAS unsigned char*)smem, tinfo)); \
        if (l == 0) gemm_phase256<G_DFTC>(p, l, (LAS unsigned char*)smem, tinfo); \
        __syncthreads(); \
        REPEAT(REP_DF, phase_df_mfma(p, l, (LAS unsigned char*)smem)); \
        REPEAT(REP_NA, phase_na_mfma(p, l, (LAS unsigned char*)smem)); \
        idle_fill(p, smem, 3 + 8 * l, l); \
        REPEAT(REP_BAR, xcd_barrier(bar)); \
        REPEAT(REP_WOUT, gemm_phase256<G_WOUT>(p, l, (LAS unsigned char*)smem, tinfo)); \
        if (l == 0) idle_fill(p, smem, 4 + 8 * l, l); \
        REPEAT(REP_BAR, xcd_barrier(bar)); \
        if (REP_ROUTE > 1) { phase_route(p, l, smem, 1024); __syncthreads(); } \
        phase_route(p, l, smem, 0); \
        conv_drain(p, smem, l); \
        REPEAT(REP_BAR, xcd_barrier(bar)); \
        moe_tinfo(p, l, tinfo); \
        REPEAT(REP_MOE1, gemm_phase256<G_MOE1>(p, l, (LAS unsigned char*)smem, tinfo)); \
        if (l == 0) idle_fill(p, smem, 5, 1);         \
        REPEAT(REP_BAR, xcd_barrier(bar)); \
        REPEAT(REP_MOE2, gemm_phase256<G_MOE2>(p, l, (LAS unsigned char*)smem, tinfo)); \
        if (l == 0) idle_fill(p, smem, 6, 1); \
        REPEAT(REP_BAR, xcd_barrier(bar)); \
        REPEAT(REP_COMB, phase_combine(p, l, tinfo)); \
        if (l == 0) xcd_barrier(bar); \
    } while (0)
    LAYER(0);
    LAYER(1);
#undef LAYER
}

extern "C" void kernel_launch(void* const* d_in, const int* in_sizes, int n_in, void* d_out, int out_size, void* d_ws, size_t ws_size, hipStream_t stream) {
    static int grid = 0;
    if (n_in != 29 || ws_size < WS_END) { fprintf(stderr, "kernel_launch: need 29 inputs and %zu bytes of workspace (got %d, %zu)\n", (size_t)WS_END, n_in, ws_size); return; }
    if (!grid) {
        int dev = 0, cus = 0, per_cu = 0;
        (void)hipGetDevice(&dev);
        (void)hipDeviceGetAttribute(&cus, hipDeviceAttributeMultiprocessorCount, dev);
        (void)hipFuncSetAttribute((const void*)k_fwd, hipFuncAttributeMaxDynamicSharedMemorySize, LDS_BYTES);
        (void)hipOccupancyMaxActiveBlocksPerMultiprocessor(&per_cu, (const void*)k_fwd, 512, LDS_BYTES);
        if (per_cu < 1) fprintf(stderr, "kernel_launch: occupancy query reports %d workgroups per CU\n", per_cu);
        grid = cus > 0 ? cus : 256;
    }
    Params p;
    const float** pp = (const float**)&p;
    for (int i = 0; i < 29; ++i) pp[i] = (const float*)d_in[i];
    p.out = (float*)d_out; p.ws = (unsigned char*)d_ws;
    (void)hipMemsetAsync((char*)d_ws + WS_CTL, 0, CTL_BYTES, stream);
    hipLaunchKernelGGL(k_fwd, dim3(grid), dim3(512), LDS_BYTES, stream, p);
}
```

```cpp
#include <hip/hip_runtime.h>
#include <cstdio>
#include <cstdint>

#define REP_PRO0 1
#define REP_TILE 1
#define REP_EPI 1
#define REP_KL8 1
#define REP_KL16 1
#define REP_ROUTE 1
#define REP_BAR 1
#define REP_PRO1 1
#define REP_TR 1
#define REP_FOLD 1
#define REP_WIN 1
#define REP_PREP 1
#define REP_DF 1
#define REP_NA 1
#define REP_DFT 1
#define REP_WOUT 1
#define REP_MOE1 1
#define REP_MOE2 1
#define REP_COMB 1
#define REPEAT(n, stmt) do { _Pragma("unroll") for (int _r = 0; _r < (n); ++_r) { stmt; } } while (0)
typedef unsigned short bf16_t;
typedef short bf16x8 __attribute__((ext_vector_type(8)));
typedef float f32x4 __attribute__((ext_vector_type(4)));
typedef float f32x16 __attribute__((ext_vector_type(16)));
typedef float f32x2 __attribute__((ext_vector_type(2)));
typedef unsigned u32x4 __attribute__((ext_vector_type(4)));
typedef unsigned u32x2 __attribute__((ext_vector_type(2)));
typedef int i32x8 __attribute__((ext_vector_type(8)));
constexpr float SW8 = 64.f, SH8 = 16.f, SA8 = 4.f, SY8 = 16.f;

constexpr int NB = 8, SEQ = 2048, DM = 1024, LC = 256;
constexpr int NX = NB * SEQ, NC = NB * LC, NT = NX + NC;
constexpr int NIN = 2304;
constexpr int NE = 32, FF = 1024, KEYS = LC + SEQ;
constexpr int MAXSLOT = 81920;
constexpr float EPS = 1e-6f;

constexpr size_t al256(size_t x) { return (x + 255) & ~(size_t)255; }
constexpr size_t WS_CTL   = 0;
constexpr size_t CTL_BYTES = 65536;
constexpr size_t CTL_CNT  = 32768;
constexpr size_t CTL_PRO0 = 49152;
constexpr size_t WS_MOD   = WS_CTL + CTL_BYTES;
constexpr size_t WS_SCAL  = al256(WS_MOD + (size_t)2 * 9 * 6144 * 4);
constexpr size_t WS_ROPE  = al256(WS_SCAL + 2 * 16 * 4);
constexpr size_t WS_WIN   = al256(WS_ROPE + 64 * 8 * 2 * 4);
constexpr size_t WS_WOUT  = al256(WS_WIN + (size_t)2 * NIN * DM * 2);
constexpr size_t WS_W1    = al256(WS_WOUT + (size_t)2 * DM * DM * 2);
constexpr size_t WS_W2    = al256(WS_W1 + (size_t)2 * NE * 2048 * DM * 2);
constexpr size_t WS_DFTM  = al256(WS_W2 + (size_t)2 * NE * DM * FF * 2);
constexpr size_t WS_DFTC  = al256(WS_DFTM + (size_t)2048 * 2048 * 2);
constexpr size_t WS_H     = al256(WS_DFTC + (size_t)256 * 256 * 2);
constexpr size_t WS_PX    = al256(WS_H + (size_t)NT * DM * 2);
constexpr size_t QKV_ONE  = (size_t)NB * 4 * KEYS * 64 * 2;
constexpr size_t WS_QA    = al256(WS_PX + (size_t)NT * NIN * 2);
constexpr size_t WS_KA    = al256(WS_QA + QKV_ONE);
constexpr size_t WS_VTA   = al256(WS_KA + QKV_ONE);
constexpr size_t WS_QD    = al256(WS_VTA + QKV_ONE);
constexpr size_t WS_KD    = al256(WS_QD + QKV_ONE);
constexpr size_t WS_VTD   = al256(WS_KD + QKV_ONE);
constexpr size_t WS_XF    = al256(WS_VTD + QKV_ONE);
constexpr size_t WS_XFC   = al256(WS_XF + (size_t)2048 * 2048 * 2);
constexpr size_t WS_YCAT  = al256(WS_XFC + (size_t)2048 * 256 * 2);
constexpr size_t WS_X1    = al256(WS_YCAT + (size_t)NT * DM * 2);
constexpr size_t WS_X2    = al256(WS_X1 + (size_t)NT * DM * 4);
constexpr size_t WS_RTE   = al256(WS_X2 + (size_t)NT * DM * 4);
constexpr size_t WS_RTP   = al256(WS_RTE + (size_t)NT * 4 * 4);
constexpr size_t WS_RTG   = al256(WS_RTP + (size_t)NT * 4 * 4);
constexpr size_t WS_LIST  = al256(WS_RTG + (size_t)NT * 4 * 4);
constexpr size_t WS_ACT   = al256(WS_LIST + (size_t)NE * NT * 4);
constexpr size_t WS_Y2    = al256(WS_ACT + (size_t)MAXSLOT * FF * 2);
constexpr size_t WS_H8    = al256(WS_Y2 + (size_t)MAXSLOT * DM * 2);
constexpr size_t WS_RWT   = al256(WS_H8 + (size_t)NT * DM);
constexpr size_t WS_END   = al256(WS_RWT + (size_t)2 * NE * DM * 2);

struct Params {
    const float *x, *c, *ctx, *c_ctx, *w_ada, *b_ada, *g1w, *g2w, *w_in, *w_out, *na_qg, *na_kg, *na_rpb, *df_qg, *df_kg,
                *lq1, *lk1, *lq2, *lk2, *subln, *pool_w, *pool_scale, *fft_w, *router_w, *router_b, *w1, *b1, *w2, *b2;
    float* out;
    unsigned char* ws;
};
typedef __attribute__((address_space(1))) unsigned char g_u8;
__device__ __forceinline__ unsigned char* ws_base(unsigned char* w) { g_u8* g = (g_u8*)w; asm volatile("" : "+s"(g)); return (unsigned char*)g; }
#define WSP(T, off) ((T*)(ws_base(p.ws) + (off)))

__device__ __forceinline__ unsigned pk2(float lo, float hi) {
    typedef __bf16 bf2 __attribute__((ext_vector_type(2)));
    bf2 r = __builtin_convertvector((f32x2){lo, hi}, bf2);
    return *(unsigned*)&r;
}
__device__ __forceinline__ unsigned pk4_fp8(float a, float b, float c, float d) { int r = 0; r = __builtin_amdgcn_cvt_pk_fp8_f32(a, b, r, false); r = __builtin_amdgcn_cvt_pk_fp8_f32(c, d, r, true); return (unsigned)r; }
__device__ __forceinline__ bf16_t f2bf(float f) { return (bf16_t)(pk2(f, 0.f) & 0xffffu); }
__device__ __forceinline__ float bflo(unsigned u) { return __uint_as_float(u << 16); }
__device__ __forceinline__ float bfhi(unsigned u) { return __uint_as_float(u & 0xffff0000u); }
__device__ __forceinline__ float bf2f(bf16_t b) { return __uint_as_float(((unsigned)b) << 16); }
__device__ __forceinline__ float wave_sum(float v) {
#pragma unroll
    for (int o = 1; o < 64; o <<= 1) v += __shfl_xor(v, o);
    return v;
}
#define DPP_F(v, ctrl) __builtin_bit_cast(float, __builtin_amdgcn_update_dpp(0, __builtin_bit_cast(int, (v)), (ctrl), 0xf, 0xf, true))
__device__ __forceinline__ float sum8_dpp(float v)  { v += DPP_F(v, 0xB1); v += DPP_F(v, 0x4E); v += DPP_F(v, 0x141); return v; }
__device__ __forceinline__ float sum16_dpp(float v) { v += DPP_F(v, 0xB1); v += DPP_F(v, 0x4E); v += DPP_F(v, 0x141); v += DPP_F(v, 0x140); return v; }
__device__ __forceinline__ float wave_sum_fast(float v) {
    v += __builtin_bit_cast(float, __builtin_amdgcn_update_dpp(0, __builtin_bit_cast(int, v), 0xB1, 0xf, 0xf, true));
    v += __builtin_bit_cast(float, __builtin_amdgcn_update_dpp(0, __builtin_bit_cast(int, v), 0x4E, 0xf, 0xf, true));
    v += __builtin_bit_cast(float, __builtin_amdgcn_update_dpp(0, __builtin_bit_cast(int, v), 0x141, 0xf, 0xf, true));
    v += __builtin_bit_cast(float, __builtin_amdgcn_update_dpp(0, __builtin_bit_cast(int, v), 0x140, 0xf, 0xf, true));
    const float a = __builtin_bit_cast(float, __builtin_amdgcn_readlane(__builtin_bit_cast(int, v), 0)), b = __builtin_bit_cast(float, __builtin_amdgcn_readlane(__builtin_bit_cast(int, v), 16));
    const float c = __builtin_bit_cast(float, __builtin_amdgcn_readlane(__builtin_bit_cast(int, v), 32)), d = __builtin_bit_cast(float, __builtin_amdgcn_readlane(__builtin_bit_cast(int, v), 48));
    return (a + b) + (c + d);
}
__device__ __forceinline__ float wave_max(float v) {
#pragma unroll
    for (int o = 1; o < 64; o <<= 1) v = fmaxf(v, __shfl_xor(v, o));
    return v;
}
__device__ __forceinline__ int hid_tid() { int t = threadIdx.x; asm volatile("" : "+v"(t)); return t; }
__device__ __forceinline__ void unpack4(u32x2 r, float (&v)[4]) { v[0] = bflo(r.x); v[1] = bfhi(r.x); v[2] = bflo(r.y); v[3] = bfhi(r.y); }

__device__ __forceinline__ float cl8(float x) { return fminf(fmaxf(x, -448.f), 448.f); }
__device__ __forceinline__ void mod_row(const float* xrow, const float* gw, const float* sh, const float* sc, unsigned char* orow, int lane, f32x4 (&hv)[4]) {
    f32x4 v[4]; float ss = 0.f;
#pragma unroll
    for (int j = 0; j < 4; ++j) { v[j] = ((const f32x4*)xrow)[lane + 64 * j]; ss += v[j].x * v[j].x + v[j].y * v[j].y + v[j].z * v[j].z + v[j].w * v[j].w; }
    ss = wave_sum_fast(ss);
    const float rs = rsqrtf(ss * (1.f / DM) + EPS);
#pragma unroll
    for (int j = 0; j < 4; ++j) {
        const int c = 4 * lane + 256 * j;
        const f32x4 g = *(const f32x4*)(gw + c), s1 = *(const f32x4*)(sc + c), s0 = *(const f32x4*)(sh + c);
        f32x4 o;
        o.x = v[j].x * rs * g.x * (1.f + s1.x) + s0.x; o.y = v[j].y * rs * g.y * (1.f + s1.y) + s0.y;
        o.z = v[j].z * rs * g.z * (1.f + s1.z) + s0.z; o.w = v[j].w * rs * g.w * (1.f + s1.w) + s0.w;
        hv[j] = o;
        *(unsigned*)(orow + c) = pk4_fp8(cl8(o.x * SH8), cl8(o.y * SH8), cl8(o.z * SH8), cl8(o.w * SH8));
    }
}
__device__ __forceinline__ int mod_index(int r) { return r < NX ? (r >> 11) : 8; }

__device__ __forceinline__ void phase_pro0(const Params& p, unsigned char* smem) {
    float* act = (float*)smem;
    float* red = act + 9 * 1024;
    const int tid = hid_tid(), lane = tid & 63, wave = tid >> 6;
    for (int i = tid; i < 9 * 1024; i += 512) { const int r = i >> 10, k = i & 1023; const float v = (r < 8) ? p.c[r * 1024 + k] : p.c_ctx[k]; act[i] = v / (1.f + expf(-v)); }
    __syncthreads();
    float* MOD = WSP(float, WS_MOD);
    for (int item = blockIdx.x; item < 96; item += gridDim.x) {
        const int l = item / 48, ch = item % 48, hl = lane >> 5, cl = lane & 31;
        const float* w = p.w_ada + (size_t)l * 1024 * 6144 + ch * 128 + 4 * cl;
        f32x4 acc[9];
#pragma unroll
        for (int r = 0; r < 9; ++r) acc[r] = (f32x4){0.f, 0.f, 0.f, 0.f};
        const int k0 = wave * 128 + hl;
#pragma unroll 8
        for (int i = 0; i < 64; ++i) {
            const int k = k0 + 2 * i;
            const f32x4 wv = __builtin_nontemporal_load((const f32x4*)(w + (size_t)k * 6144));
#pragma unroll
            for (int r = 0; r < 9; ++r) { const float a = act[r * 1024 + k]; acc[r].x += a * wv.x; acc[r].y += a * wv.y; acc[r].z += a * wv.z; acc[r].w += a * wv.w; }
        }
#pragma unroll
        for (int r = 0; r < 9; ++r) {
            acc[r].x += __shfl_xor(acc[r].x, 32); acc[r].y += __shfl_xor(acc[r].y, 32); acc[r].z += __shfl_xor(acc[r].z, 32); acc[r].w += __shfl_xor(acc[r].w, 32);
            if (hl == 0) *(f32x4*)(red + (wave * 9 + r) * 128 + 4 * cl) = acc[r];
        }
        __syncthreads();
        for (int i = tid; i < 9 * 128; i += 512) {
            const int r = i >> 7, cc = i & 127; float s = 0.f;
#pragma unroll
            for (int w8 = 0; w8 < 8; ++w8) s += red[(w8 * 9 + r) * 128 + cc];
            MOD[(size_t)(l * 9 + r) * 6144 + ch * 128 + cc] = s + p.b_ada[l * 6144 + ch * 128 + cc];
        }
        __syncthreads();
    }
    if (blockIdx.x == gridDim.x - 2) {
        float* RT = WSP(float, WS_ROPE);
        const int pos = tid >> 3, f = tid & 7; const float ang = (float)pos * expf(-(float)f * 1.151292546497023f);
        RT[2 * tid] = cosf(ang); RT[2 * tid + 1] = sinf(ang);
    }
    if (blockIdx.x == gridDim.x - 1 && wave == 0) {
        float* SC = WSP(float, WS_SCAL);
        for (int l = 0; l < 2; ++l) {
            float s1 = lane < 32 ? p.lq1[l * 32 + lane] * p.lk1[l * 32 + lane] : 0.f;
            float s2 = lane < 32 ? p.lq2[l * 32 + lane] * p.lk2[l * 32 + lane] : 0.f;
            s1 = wave_sum(s1); s2 = wave_sum(s2);
            const float lam_init = 0.8f - 0.6f * expf(-0.3f * (float)l);
            const float lam = expf(s1) - expf(s2) + lam_init;
            const float mq = wave_max(lane < 32 ? fabsf(p.df_qg[l * 32 + lane]) : 0.f), mk = wave_max(lane < 32 ? fabsf(p.df_kg[l * 32 + lane]) : 0.f);
            const float aq = wave_max(fabsf(p.na_qg[l * 64 + lane])), ak = wave_max(fabsf(p.na_kg[l * 64 + lane]));
            if (lane == 0) { SC[l * 16 + 0] = lam; SC[l * 16 + 1] = lam_init; SC[l * 16 + 2] = 5.656854249f * 1.44269504f * mq * mk; }
            for (int h = 0; h < 4; ++h) {
                float mb = 0.f;
                for (int i = lane; i < 15 * 31; i += 64) mb = fmaxf(mb, p.na_rpb[((size_t)(l * 4 + h)) * 465 + i]);
                mb = wave_max(mb);
                if (lane == 0) SC[l * 16 + 4 + h] = (8.f * aq * ak + mb) * 1.44269504f;
            }
        }
    }
    asm volatile("s_waitcnt vmcnt(0)" ::: "memory");
    __syncthreads();
    if (tid == 0) {
        __builtin_amdgcn_fence(__ATOMIC_RELEASE, "agent");
        asm volatile("s_waitcnt vmcnt(0)" ::: "memory");
        __hip_atomic_fetch_add(WSP(unsigned, WS_CTL + CTL_PRO0), 1u, __ATOMIC_RELAXED, __HIP_MEMORY_SCOPE_AGENT);
    }
}

__device__ __forceinline__ void transpose_item(const float* W, int ldw, int K, bf16_t* WT, unsigned char* sm, int kb, int nb, int lane) {
    const int q = lane >> 4, c4 = lane & 15;
    const float* src = W + (size_t)(64 * kb + 16 * q) * ldw + 64 * nb + 4 * c4;
    f32x4 r[16];
#pragma unroll
    for (int j = 0; j < 16; ++j) r[j] = *(const f32x4*)(src + (size_t)j * ldw);
#pragma unroll
    for (int c = 0; c < 4; ++c) {
        u32x4 o0, o1;
        o0.x = pk2(r[0][c], r[1][c]); o0.y = pk2(r[2][c], r[3][c]); o0.z = pk2(r[4][c], r[5][c]); o0.w = pk2(r[6][c], r[7][c]);
        o1.x = pk2(r[8][c], r[9][c]); o1.y = pk2(r[10][c], r[11][c]); o1.z = pk2(r[12][c], r[13][c]); o1.w = pk2(r[14][c], r[15][c]);
        unsigned char* d = sm + (4 * c4 + c) * 144 + 32 * q;
        *(u32x4*)d = o0; *(u32x4*)(d + 16) = o1;
    }
    __builtin_amdgcn_s_waitcnt(0xc07f); asm volatile("" ::: "memory");
    bf16_t* dst = WT + (size_t)(64 * nb + (lane >> 3)) * K + 64 * kb + 8 * (lane & 7);
#pragma unroll
    for (int i = 0; i < 8; ++i) { const u32x4 o = *(const u32x4*)(sm + (8 * i + (lane >> 3)) * 144 + 16 * (lane & 7)); *(u32x4*)(dst + (size_t)(8 * i) * K) = o; }
    __builtin_amdgcn_s_waitcnt(0xc07f); asm volatile("" ::: "memory");
}

__device__ __forceinline__ void transpose_item8(const float* W, int ldw, int K, unsigned char* WT, unsigned char* sm, int kb, int nb, int lane) {
    const int q = lane >> 4, c4 = lane & 15;
    const float* src = W + (size_t)(64 * kb + 16 * q) * ldw + 64 * nb + 4 * c4;
    f32x4 r[16];
#pragma unroll
    for (int j = 0; j < 16; ++j) r[j] = *(const f32x4*)(src + (size_t)j * ldw) * SW8;
#pragma unroll
    for (int c = 0; c < 4; ++c) {
        u32x4 o; o.x = pk4_fp8(r[0][c], r[1][c], r[2][c], r[3][c]); o.y = pk4_fp8(r[4][c], r[5][c], r[6][c], r[7][c]);
        o.z = pk4_fp8(r[8][c], r[9][c], r[10][c], r[11][c]); o.w = pk4_fp8(r[12][c], r[13][c], r[14][c], r[15][c]);
        *(u32x4*)(sm + (4 * c4 + c) * 80 + 16 * q) = o;
    }
    __builtin_amdgcn_s_waitcnt(0xc07f); asm volatile("" ::: "memory");
    unsigned char* dst = WT + (size_t)(64 * nb + (lane >> 2)) * K + 64 * kb + 16 * (lane & 3);
#pragma unroll
    for (int i = 0; i < 4; ++i) { const u32x4 o = *(const u32x4*)(sm + (16 * i + (lane >> 2)) * 80 + 16 * (lane & 3)); *(u32x4*)(dst + (size_t)(16 * i) * K) = o; }
    __builtin_amdgcn_s_waitcnt(0xc07f); asm volatile("" ::: "memory");
}

__device__ __forceinline__ void phase_pro1(const Params& p, unsigned char* smem) {
    const int tid = hid_tid(), lane = tid & 63, wave = tid >> 6;
    const int gw = blockIdx.x * 8 + wave, ngw = gridDim.x * 8;
    unsigned char* WIN = WSP(unsigned char, WS_WIN);
    {
        float* Mf = (float*)smem;
        float* tile = Mf + 4096 + wave * (64 * 65);
        float* trig = Mf + 4096 + 8 * (64 * 65);
        if (tid < 128) { const int i = tid & 63; const float a = (float)i * (1.f / 32.f); trig[tid] = tid < 64 ? cospif(a) : sinpif(a); }
        __syncthreads();
        for (int rep_ = 0; rep_ < REP_FOLD; ++rep_)
        for (int it = blockIdx.x; it < 96; it += gridDim.x) {
            const int kq = it & 3, g = (it >> 2) & 3, kind = (it >> 4) % 3, l = it / 48;
            for (int i = tid; i < 4096; i += 512) {
                const int cch = i >> 6, e = i & 63; float v;
                if (kind == 0) v = p.pool_w[((size_t)(l * 4 + g) * 64 + cch) * 64 + e] * p.pool_scale[l * 256 + g * 64 + e];
                else {
                    const float* fw = p.fft_w + (size_t)(l * 4 + g) * 4096 + e; const float* tb = trig + (kind == 1 ? 0 : 64);
                    float s = 0.f;
#pragma unroll 8
                    for (int m = 0; m < 64; ++m) s += tb[(m * cch) & 63] * fw[m * 64];
                    v = s * 0.125f;
                }
                Mf[i] = v;
            }
            __syncthreads();
            const int srcb = (kind == 0 ? 1536 : 1792) + 64 * g, dstb = (kind == 0 ? 1536 : (kind == 1 ? 1792 : 2048)) + 64 * g;
            {
                const int kb = 4 * kq + (wave & 3), eh = wave >> 2;
                for (int i = 0; i < 64; ++i) tile[i * 65 + lane] = p.w_in[((size_t)l * 1024 + 64 * kb + i) * 2048 + srcb + lane];
                __builtin_amdgcn_s_waitcnt(0xc07f); asm volatile("" ::: "memory");
                float acc[32];
#pragma unroll
                for (int e = 0; e < 32; ++e) acc[e] = 0.f;
                for (int cch = 0; cch < 64; ++cch) {
                    const float a = tile[lane * 65 + cch];
#pragma unroll
                    for (int e = 0; e < 32; ++e) acc[e] += a * Mf[cch * 64 + eh * 32 + e];
                }
#pragma unroll
                for (int e = 0; e < 32; ++e) WIN[((size_t)l * NIN + dstb + eh * 32 + e) * 1024 + 64 * kb + lane] = (unsigned char)(__builtin_amdgcn_cvt_pk_fp8_f32(cl8(acc[e] * SW8), 0.f, 0, false) & 0xff);
                __builtin_amdgcn_s_waitcnt(0xc07f); asm volatile("" ::: "memory");
            }
            __syncthreads();
        }
    }
    {
        unsigned char* tsm = smem + wave * (64 * 144);
        __syncthreads();
        constexpr int I_IN = 16 * 24, I_OUT = 16 * 16;
        constexpr int T0 = 2 * I_IN, T1 = T0 + 2 * I_OUT;
        for (int rep_ = 0; rep_ < REP_TR; ++rep_)
        for (int it = gw; it < T1; it += ngw) {
            if (it < T0) { const int l = it / I_IN, r = it % I_IN; transpose_item8(p.w_in + (size_t)l * 1024 * 2048, 2048, 1024, WIN + (size_t)l * NIN * 1024, tsm, r % 16, r / 16, lane); }
            else { const int q = it - T0, l = q / I_OUT, r = q % I_OUT; transpose_item(p.w_out + (size_t)l * 1024 * 1024, 1024, 1024, WSP(bf16_t, WS_WOUT) + (size_t)l * 1024 * 1024, tsm, r % 16, r / 16, lane); }
        }
    }
    {
        bf16_t* DM_ = WSP(bf16_t, WS_DFTM); bf16_t* DC_ = WSP(bf16_t, WS_DFTC);
        const int gt = blockIdx.x * 512 + tid, ngt = gridDim.x * 512;
        for (int i = gt; i < 2048 * 256; i += ngt) {
            const int k = i >> 8, j0 = (i & 255) * 8; unsigned o[4];
#pragma unroll
            for (int q = 0; q < 4; ++q) { float v[2];
#pragma unroll
                for (int e = 0; e < 2; ++e) { const int j = j0 + 2 * q + e;
                    if (j <= 1024) { const int ph = (k * j) & 2047; v[e] = cospif((float)ph * (1.f / 1024.f)) * 0.02209708691f; }
                    else { const int ph = (k * (j - 1024)) & 2047; v[e] = -sinpif((float)ph * (1.f / 1024.f)) * 0.02209708691f; } }
                o[q] = pk2(v[0], v[1]); }
            *(u32x4*)(DM_ + (size_t)k * 2048 + j0) = (u32x4){o[0], o[1], o[2], o[3]};
        }
        for (int i = gt; i < 256 * 32; i += ngt) {
            const int k = i >> 5, j0 = (i & 31) * 8; unsigned o[4];
#pragma unroll
            for (int q = 0; q < 4; ++q) { float v[2];
#pragma unroll
                for (int e = 0; e < 2; ++e) { const int j = j0 + 2 * q + e;
                    if (j <= 128) { const int ph = (k * j) & 255; v[e] = cospif((float)ph * (1.f / 128.f)) * 0.0625f; }
                    else { const int ph = (k * (j - 128)) & 255; v[e] = -sinpif((float)ph * (1.f / 128.f)) * 0.0625f; } }
                o[q] = pk2(v[0], v[1]); }
            *(u32x4*)(DC_ + (size_t)k * 256 + j0) = (u32x4){o[0], o[1], o[2], o[3]};
        }
    }
    {
        bf16_t* RWT = WSP(bf16_t, WS_RWT);
        const int gt = blockIdx.x * 512 + tid, ngt = gridDim.x * 512;
        for (int i = gt; i < 2 * 32 * 128; i += ngt) {
            const int l = i >> 12, e = (i >> 7) & 31, k0 = (i & 127) * 8;
            const float* s = p.router_w + ((size_t)l * 1024 + k0) * 32 + e;
            u32x4 o; o.x = pk2(s[0], s[32]); o.y = pk2(s[64], s[96]); o.z = pk2(s[128], s[160]); o.w = pk2(s[192], s[224]);
            *(u32x4*)(RWT + ((size_t)(l * 32 + e)) * 1024 + k0) = o;
        }
    }
    {
        if (tid == 0) {
            unsigned* cnt = WSP(unsigned, WS_CTL + CTL_PRO0); unsigned sp = 0;
            while (__hip_atomic_load(cnt, __ATOMIC_RELAXED, __HIP_MEMORY_SCOPE_AGENT) < gridDim.x) { __builtin_amdgcn_s_sleep(2); if (++sp > (1u << 22)) break; }
            __builtin_amdgcn_fence(__ATOMIC_ACQUIRE, "agent");
            asm volatile("s_waitcnt vmcnt(0)" ::: "memory");
        }
        __syncthreads();
    }
    {
        const float* MOD = WSP(float, WS_MOD); unsigned char* H = WSP(unsigned char, WS_H);
        for (int r = gw; r < NT; r += ngw) {
            const float* xr = r < NX ? p.x + (size_t)r * DM : p.ctx + (size_t)(r - NX) * DM;
            const float* m = MOD + (size_t)(0 * 9 + mod_index(r)) * 6144;
            f32x4 hv[4];
            mod_row(xr, p.g1w, m, m + 1024, H + (size_t)r * DM, lane, hv);
        }
    }
}

enum { G_WIN = 0, G_DFT = 1, G_DFTC = 2, G_WOUT = 3, G_MOE1 = 4, G_MOE2 = 5 };
__device__ __forceinline__ void moe_tinfo(const Params& p, int l, int* tinfo) {
    if (threadIdx.x == 0) {
        const int* cnt = WSP(int, WS_CTL + CTL_CNT) + l * 32; int s = 0;
        for (int e = 0; e < 32; ++e) { const int c = cnt[e]; tinfo[e] = s; tinfo[33 + e] = c; s += (c + 255) >> 8; }
        tinfo[32] = s;
    }
    __syncthreads();
}

#define LAS __attribute__((address_space(3)))
namespace g8 {
constexpr int BM = 256, BK = 64, HALF = 128, HTB = HALF * BK * 2, STAGE_BYTES = 8 * HTB, NXCD = 8, WGM = 8;
__host__ __device__ __forceinline__ int lds_xor(int r) { return (((r >> 1) & 1) * 3) | (r & 4); }
__host__ __device__ __forceinline__ int lds_byte(int r, int c) { return r * 128 + ((((c >> 3) ^ lds_xor(r)) & 7) << 4); }
__host__ __device__ __forceinline__ void stage_rc(int b, int& R, int& C) { const int r = b >> 7, cp = (b >> 4) & 7; R = r; C = ((cp ^ lds_xor(r)) & 7) * 8; }
}
struct UnitD { unsigned boff; const int* gather; int arow0, nvalid, orow0, ocol0, e; };
template <int KIND> __device__ __forceinline__ void phase_geom(int l, const int* tinfo, int& nM, int& nN, int& K) {
    if (KIND == G_WIN) { nM = 72; nN = 9; K = 1024; }
    else if (KIND == G_DFT) { nM = 8; nN = 8; K = 2048; }
    else if (KIND == G_DFTC) { nM = 1; nN = 8; K = 256; }
    else if (KIND == G_WOUT) { nM = (l == 0) ? 72 : 64; nN = 4; K = 1024; }
    else if (KIND == G_MOE1) { nM = __builtin_amdgcn_readfirstlane(tinfo[32]); nN = 8; K = 1024; }
    else { nM = __builtin_amdgcn_readfirstlane(tinfo[32]); nN = 4; K = 1024; }
}
template <int KIND> __device__ __forceinline__ const bf16_t* phase_A(const Params& p) {
    if (KIND == G_WIN) return (const bf16_t*)WSP(unsigned char, WS_H);
    if (KIND == G_MOE1) return (const bf16_t*)WSP(unsigned char, WS_H8);
    if (KIND == G_DFT) return WSP(bf16_t, WS_DFTM);
    if (KIND == G_DFTC) return WSP(bf16_t, WS_DFTC);
    if (KIND == G_WOUT) return WSP(bf16_t, WS_YCAT);
    return WSP(bf16_t, WS_ACT);
}
template <int KIND> __device__ __forceinline__ const void* phase_B(const Params& p, int l) {
    if (KIND == G_WIN) return WSP(unsigned char, WS_WIN) + (size_t)l * NIN * 1024;
    if (KIND == G_DFT) return WSP(bf16_t, WS_XF);
    if (KIND == G_DFTC) return WSP(bf16_t, WS_XFC);
    if (KIND == G_WOUT) return WSP(bf16_t, WS_WOUT) + (size_t)l * 1024 * 1024;
    if (KIND == G_MOE1) return WSP(unsigned char, WS_W1) + (size_t)l * NE * 2048 * 1024;
    return WSP(unsigned char, WS_W2) + (size_t)l * NE * 1024 * 1024;
}
template <int KIND> __device__ __forceinline__ void get_unit(const Params& p, int l, int pm, int pn, const int* tinfo, UnitD& u) {
    u.gather = nullptr; u.nvalid = 256; u.e = 0; u.arow0 = pm * 256; u.orow0 = pm * 256; u.ocol0 = pn * 256;
    if (KIND == G_WIN) u.boff = (unsigned)pn * 256u * 1024u;
    else if (KIND == G_DFT) u.boff = (unsigned)pn * 256u * 2048u * 2u;
    else if (KIND == G_DFTC) u.boff = (unsigned)pn * 256u * 256u * 2u;
    else if (KIND == G_WOUT) u.boff = (unsigned)pn * 256u * 1024u * 2u;
    else {
        int e = 0; while (tinfo[e + 1] <= pm) ++e;
        e = __builtin_amdgcn_readfirstlane(e); u.e = e;
        if (KIND == G_MOE1) { u.gather = WSP(int, WS_LIST) + (size_t)e * NT; u.arow0 = __builtin_amdgcn_readfirstlane((pm - tinfo[e]) * 256); u.nvalid = __builtin_amdgcn_readfirstlane(tinfo[33 + e]) - u.arow0;
                              u.boff = (unsigned)(e * 2048 + pn * 256) * 1024u; }
        else u.boff = (unsigned)(e * 1024 + pn * 256) * 1024u;
    }
}
__device__ __forceinline__ bool static_order(int i, int G, int c, int nM, int nN, int& pm, int& pn) {
    const int nwg = nM * nN; const long L = (long)i * G + c; if (L >= nwg) return false;
    int wgid = (int)L; { const int q = nwg / g8::NXCD, r = nwg % g8::NXCD, xcd = wgid % g8::NXCD, off = wgid / g8::NXCD; wgid = (xcd < r ? xcd * (q + 1) : r * (q + 1) + (xcd - r) * q) + off; }
    const int nig = g8::WGM * nN, gid = wgid / nig, fm = gid * g8::WGM, gsz = (nM - fm) < g8::WGM ? (nM - fm) : g8::WGM;
    pm = fm + ((wgid % nig) % gsz); pn = (wgid % nig) / gsz; return true;
}
template <int KIND>
__device__ __forceinline__ void gemm_phase256(const Params& p, const int l, LAS unsigned char* lds, const int* tinfo) {
    using namespace g8;
    const int tid = hid_tid(), wid = __builtin_amdgcn_readfirstlane(tid >> 6), lane = tid & 63, wr = wid >> 2, wc = wid & 3, fr = lane & 15, fq = lane >> 4;
    int nM, nN, K; phase_geom<KIND>(l, tinfo, nM, nN, K);
    constexpr bool F8 = (KIND == G_MOE1 || KIND == G_MOE2 || KIND == G_WIN);
    constexpr int ES = F8 ? 1 : 2;
    constexpr int KREP = F8 ? REP_KL8 : REP_KL16;
    const int nt1 = K * ES / 128, nt = nt1 * KREP, G = gridDim.x, cwg = blockIdx.x;
    const __amdgpu_buffer_rsrc_t rsA = __builtin_amdgcn_make_buffer_rsrc((void*)phase_A<KIND>(p), 0, 0x7ffffff0, 0x00020000);
    const __amdgpu_buffer_rsrc_t rsB = __builtin_amdgcn_make_buffer_rsrc((void*)phase_B<KIND>(p, l), 0, 0x7ffffff0, 0x00020000);
    unsigned voffB[2];
#pragma unroll
    for (int i = 0; i < 2; ++i) { int R_, C_; stage_rc(tid * 16 + i * 8192, R_, C_);
        const int rho = R_ & 31, Rb = F8 ? 64 * (R_ >> 5) + 16 * ((rho & 15) >> 2) + 4 * (rho >> 4) + (rho & 3) : (R_ & ~31) + 8 * ((rho & 15) >> 2) + 4 * (rho >> 4) + (rho & 3);
        voffB[i] = (unsigned)(Rb * K * ES + C_ * 2); }
    const unsigned kstep = 128u, hstepB = (unsigned)((F8 ? 8 : HALF) * K * ES);
    const unsigned ldsw = (unsigned)wid * 1024u;
    int aoffL[2], boffL[2];
    { const int ra = wr * 64 + fr, rb = wc * 32 + fr;
      if (F8) { aoffL[0] = lds_byte(ra, 16 * fq); aoffL[1] = lds_byte(ra, 16 * fq + 8); boffL[0] = lds_byte(rb, 16 * fq); boffL[1] = lds_byte(rb, 16 * fq + 8); }
      else { aoffL[0] = lds_byte(ra, fq * 8); aoffL[1] = lds_byte(ra, fq * 8 + 32); boffL[0] = lds_byte(rb, fq * 8); boffL[1] = lds_byte(rb, fq * 8 + 32); } }
#define G8_SA(b, h) (((b) * 2 + (h)) * HTB)
#define G8_SB(b, h) ((4 + (b) * 2 + (h)) * HTB)
#define G8_STAGE_A(bufoff, ktb, h) do { _Pragma("unroll") for (int _i = 0; _i < 2; ++_i) \
        __builtin_amdgcn_raw_ptr_buffer_load_lds(rsA, (LAS void*)(lds + (bufoff) + ldsw + _i * 8192), 16, aoff[h][_i], (int)(ktb), 0, 0); } while (0)
#define G8_STAGE_B(bufoff, soff) do { _Pragma("unroll") for (int _i = 0; _i < 2; ++_i) \
        __builtin_amdgcn_raw_ptr_buffer_load_lds(rsB, (LAS void*)(lds + (bufoff) + ldsw + _i * 8192), 16, voffB[_i], (int)(soff), 0, 0); } while (0)
#define G8_LDA(dst, b, h) do { _Pragma("unroll") for (int m = 0; m < 4; ++m) _Pragma("unroll") for (int k = 0; k < 2; ++k) { const u32x4 _v = *(const LAS u32x4*)(lds + G8_SA(b, h) + aoffL[k] + m * 2048); dst[m][4 * k] = (int)_v.x; dst[m][4 * k + 1] = (int)_v.y; dst[m][4 * k + 2] = (int)_v.z; dst[m][4 * k + 3] = (int)_v.w; } } while (0)
#define G8_LDB(dst, b, h) do { _Pragma("unroll") for (int n = 0; n < 2; ++n) _Pragma("unroll") for (int k = 0; k < 2; ++k) { const u32x4 _v = *(const LAS u32x4*)(lds + G8_SB(b, h) + boffL[k] + n * 2048); dst[n][4 * k] = (int)_v.x; dst[n][4 * k + 1] = (int)_v.y; dst[n][4 * k + 2] = (int)_v.z; dst[n][4 * k + 3] = (int)_v.w; } } while (0)
#define G8_MMA(ai, bj, At, Bt) do { __builtin_amdgcn_s_setprio(1); _Pragma("unroll") for (int m = 0; m < 4; ++m) _Pragma("unroll") for (int n = 0; n < 2; ++n) { \
        if (F8) acc[ai][bj][m][n] = __builtin_amdgcn_mfma_scale_f32_16x16x128_f8f6f4(Bt[n], At[m], acc[ai][bj][m][n], 0, 0, 0, 0, 0, 0); \
        else { typedef int i32x4_ __attribute__((ext_vector_type(4))); \
               const i32x4_ _a0 = __builtin_shufflevector(At[m], At[m], 0, 1, 2, 3), _a1 = __builtin_shufflevector(At[m], At[m], 4, 5, 6, 7); \
               const i32x4_ _b0 = __builtin_shufflevector(Bt[n], Bt[n], 0, 1, 2, 3), _b1 = __builtin_shufflevector(Bt[n], Bt[n], 4, 5, 6, 7); \
               acc[ai][bj][m][n] = __builtin_amdgcn_mfma_f32_16x16x32_bf16(*(const bf16x8*)&_b0, *(const bf16x8*)&_a0, acc[ai][bj][m][n], 0, 0, 0); \
               acc[ai][bj][m][n] = __builtin_amdgcn_mfma_f32_16x16x32_bf16(*(const bf16x8*)&_b1, *(const bf16x8*)&_a1, acc[ai][bj][m][n], 0, 0, 0); } } \
        __builtin_amdgcn_s_setprio(0); } while (0)
#define G8_WAIT_V(n) asm volatile("s_waitcnt vmcnt(" #n ")" ::: "memory")
#define G8_WAIT_L(n) asm volatile("s_waitcnt lgkmcnt(" #n ")" ::: "memory")
#define G8_BAR __builtin_amdgcn_s_barrier()
#define G8_SCHED __builtin_amdgcn_sched_barrier(0)
#define G8_AOFF(dst, u) do { _Pragma("unroll") for (int _h = 0; _h < 2; ++_h) _Pragma("unroll") for (int _i = 0; _i < 2; ++_i) { int _R, _C; stage_rc(tid * 16 + _i * 8192, _R, _C); const int _rt = _h * 128 + _R; int _ar; \
        if (KIND == G_MOE1) _ar = (u).gather[(u).arow0 + (_rt < (u).nvalid ? _rt : -(u).arow0)]; else _ar = (u).arow0 + _rt; \
        dst[_h][_i] = (unsigned)(_ar * K * ES + _C * 2); } } while (0)
    UnitD cur, nxt; int ui = 0, pm, pn;
    if (!static_order(0, G, cwg, nM, nN, pm, pn)) return;
    get_unit<KIND>(p, l, pm, pn, tinfo, cur);
    unsigned aoff[2][2]; G8_AOFF(aoff, cur);
    f32x4 acc[2][2][4][2];
#pragma unroll
    for (int a = 0; a < 2; ++a)
#pragma unroll
        for (int b = 0; b < 2; ++b)
#pragma unroll
            for (int m = 0; m < 4; ++m)
#pragma unroll
                for (int n = 0; n < 2; ++n) acc[a][b][m][n] = (f32x4){0.f, 0.f, 0.f, 0.f};
    i32x8 At[4], B0[2], B1[2];
    unsigned cB = cur.boff;
    G8_STAGE_B(G8_SB(0, 0), cB); G8_STAGE_A(G8_SA(0, 0), 0, 0); G8_STAGE_B(G8_SB(0, 1), cB + hstepB); G8_STAGE_A(G8_SA(0, 1), 0, 1);
    if (wr == 1) G8_BAR;
    G8_WAIT_V(4); G8_BAR;
    G8_STAGE_B(G8_SB(1, 0), cB + kstep); G8_STAGE_A(G8_SA(1, 0), kstep, 0); G8_STAGE_B(G8_SB(1, 1), cB + hstepB + kstep);
    G8_WAIT_V(6); G8_BAR;
    G8_LDB(B0, 0, 0);
    for (;;) {
        const bool has_next = static_order(ui + 1, G, cwg, nM, nN, pm, pn);
        if (has_next) get_unit<KIND>(p, l, pm, pn, tinfo, nxt);
        const unsigned nB = has_next ? nxt.boff : cB;
        if ((KIND == G_MOE1 || KIND == G_MOE2) && wid == 0) {
            const float* bsrc = ((KIND == G_MOE1) ? p.b1 + (size_t)(l * NE + cur.e) * 2048 : p.b2 + (size_t)(l * NE + cur.e) * 1024) + cur.ocol0 + 4 * lane;
            __builtin_amdgcn_global_load_lds((const unsigned*)bsrc, (LAS unsigned*)(lds + STAGE_BYTES + (ui & 1) * 1024), 16, 0, 0);
            if (KIND == G_MOE1 && has_next)
                __builtin_amdgcn_global_load_lds((const unsigned*)(nxt.gather + nxt.arow0 + 4 * lane), (LAS unsigned*)(lds + STAGE_BYTES + 2048 + ((ui + 1) & 1) * 1024), 16, 0, 0);
        }
#pragma unroll 1
        for (int t = 0; t < nt; t += 2) {
            const bool last = (t == nt - 2);
            if (KREP > 1 && t == nt - nt1) {
#pragma unroll
                for (int a = 0; a < 2; ++a)
#pragma unroll
                    for (int b = 0; b < 2; ++b)
#pragma unroll
                        for (int m = 0; m < 4; ++m)
#pragma unroll
                            for (int n = 0; n < 2; ++n) acc[a][b][m][n] = (f32x4){0.f, 0.f, 0.f, 0.f};
            }
            unsigned naoff1[2];
            if (KIND == G_MOE1 && last && has_next) {
                const LAS int* itab = (const LAS int*)(lds + STAGE_BYTES + 2048 + ((ui + 1) & 1) * 1024);
#pragma unroll
                for (int _i = 0; _i < 2; ++_i) { int _R, _C; stage_rc(tid * 16 + _i * 8192, _R, _C);
                    const int _r0 = _R, _r1 = 128 + _R;
                    const int a0 = itab[_r0 < nxt.nvalid ? _r0 : 0], a1 = itab[_r1 < nxt.nvalid ? _r1 : 0];
                    aoff[0][_i] = (unsigned)(a0 * K * ES + _C * 2); naoff1[_i] = (unsigned)(a1 * K * ES + _C * 2); }
            }
            G8_LDA(At, 0, 0); G8_STAGE_A(G8_SA(1, 1), (unsigned)((t + 1) & (nt1 - 1)) * kstep, 1);
            G8_WAIT_L(8); G8_BAR; G8_WAIT_L(0); G8_MMA(0, 0, At, B0); G8_BAR; G8_SCHED;
            unsigned kt2 = (unsigned)((t + 2) & (nt1 - 1)) * kstep; unsigned b2 = cB + kt2;
            if (last) { kt2 = 0; b2 = nB; if (has_next) { if (KIND == G_MOE1) { aoff[1][0] = naoff1[0]; aoff[1][1] = naoff1[1]; } else G8_AOFF(aoff, nxt); } }
            G8_LDB(B1, 0, 1); G8_STAGE_B(G8_SB(0, 0), b2);
            G8_BAR; G8_WAIT_L(0); G8_MMA(0, 1, At, B1); G8_BAR;
            G8_LDA(At, 0, 1); G8_STAGE_A(G8_SA(0, 0), kt2, 0);
            G8_WAIT_V(10); G8_BAR; G8_WAIT_L(0); G8_MMA(1, 0, At, B0); G8_BAR; G8_SCHED;
            G8_LDB(B0, 1, 0); G8_STAGE_B(G8_SB(0, 1), b2 + hstepB);
            G8_WAIT_V(6); G8_BAR; G8_MMA(1, 1, At, B1); G8_BAR;
            G8_LDA(At, 1, 0); G8_STAGE_A(G8_SA(0, 1), kt2, 1);
            G8_WAIT_L(8); G8_BAR; G8_WAIT_L(0); G8_MMA(0, 0, At, B0); G8_BAR; G8_SCHED;
            G8_LDB(B1, 1, 1); G8_STAGE_B(G8_SB(1, 0), b2 + kstep);
            G8_BAR; G8_WAIT_L(0); G8_MMA(0, 1, At, B1); G8_BAR;
            G8_LDA(At, 1, 1); G8_STAGE_A(G8_SA(1, 0), kt2 + kstep, 0);
            G8_WAIT_V(10); G8_BAR; G8_WAIT_L(0); G8_MMA(1, 0, At, B0); G8_BAR; G8_SCHED;
            if (!last) G8_LDB(B0, 0, 0);
            G8_STAGE_B(G8_SB(1, 1), b2 + kstep + hstepB);
            G8_WAIT_V(6); G8_BAR; G8_MMA(1, 1, At, B1); G8_BAR;
        }
#if REP_EPI > 1
        int erep_n = F8 ? REP_EPI : 1; asm volatile("" : "+s"(erep_n));
#pragma unroll 1
        for (int erep_ = 0; erep_ < erep_n; ++erep_)
#endif
        {
            const int r0 = wr * 64 + fr, c0 = wc * 32 + 8 * fq;
            f32x4 cv[2][2];
            if (KIND == G_MOE1 || KIND == G_MOE2 || KIND == G_WOUT) {
                const float* cbase = WSP(float, WS_MOD) + (size_t)(l * 9 + mod_index(cur.orow0)) * 6144 + 2048;
#pragma unroll
                for (int bj = 0; bj < 2; ++bj)
#pragma unroll
                    for (int n = 0; n < 2; ++n) {
                        if (KIND == G_WOUT) cv[bj][n] = *(const f32x4*)(cbase + cur.ocol0 + bj * HALF + c0 + 4 * n);
                        else cv[bj][n] = *(const LAS f32x4*)(lds + STAGE_BYTES + (ui & 1) * 1024 + (wc * 64 + 16 * fq + 8 * bj + 4 * n) * 4);
                    }
                if (KIND == G_MOE1) {
                    constexpr float c = -2.45546696f, k4 = SA8 / c;
#pragma unroll
                    for (int bj = 0; bj < 2; ++bj)
#pragma unroll
                        for (int n = 0; n < 2; ++n) { cv[bj][n].x *= c; cv[bj][n].z *= c; cv[bj][n].y = cv[bj][n].y * k4 + k4; cv[bj][n].w = cv[bj][n].w * k4 + k4; }
                }
            }
#pragma unroll
            for (int ai = 0; ai < 2; ++ai) {
                if (KIND == G_WOUT) {
                    f32x4 xv[4][2][2];
#pragma unroll
                    for (int m = 0; m < 4; ++m) {
                        const int row = cur.orow0 + ai * HALF + r0 + m * 16;
                        if (l == 0) {
                            const float* xin = row < NX ? p.x + (size_t)row * DM : p.ctx + (size_t)(row - NX) * DM;
#pragma unroll
                            for (int bj = 0; bj < 2; ++bj)
#pragma unroll
                                for (int n = 0; n < 2; ++n) xv[m][bj][n] = *(const f32x4*)(xin + cur.ocol0 + bj * HALF + c0 + 4 * n);
                        } else {
#pragma unroll
                            for (int bj = 0; bj < 2; ++bj) { const u32x4 w = *(const u32x4*)(WSP(bf16_t, WS_X2) + (size_t)row * DM + cur.ocol0 + bj * HALF + c0);
                                xv[m][bj][0] = (f32x4){bflo(w.x), bfhi(w.x), bflo(w.y), bfhi(w.y)}; xv[m][bj][1] = (f32x4){bflo(w.z), bfhi(w.z), bflo(w.w), bfhi(w.w)}; }
                        }
                    }
#pragma unroll
                    for (int m = 0; m < 4; ++m) {
                        const int row = cur.orow0 + ai * HALF + r0 + m * 16;
#pragma unroll
                        for (int bj = 0; bj < 2; ++bj) {
                            const f32x4 v0 = acc[ai][bj][m][0], v1 = acc[ai][bj][m][1], g0 = cv[bj][0], g1 = cv[bj][1], x0 = xv[m][bj][0], x1 = xv[m][bj][1];
                            u32x4 o; o.x = pk2(x0.x + g0.x * v0.x, x0.y + g0.y * v0.y); o.y = pk2(x0.z + g0.z * v0.z, x0.w + g0.w * v0.w);
                            o.z = pk2(x1.x + g1.x * v1.x, x1.y + g1.y * v1.y); o.w = pk2(x1.z + g1.z * v1.z, x1.w + g1.w * v1.w);
                            *(u32x4*)(WSP(bf16_t, WS_X1) + (size_t)row * DM + cur.ocol0 + bj * HALF + c0) = o;
                        }
                    }
                } else {
#pragma unroll
                    for (int m = 0; m < 4; ++m) {
                        const int row = cur.orow0 + ai * HALF + r0 + m * 16;
                        if (F8) {
                            const int colw = cur.ocol0 + wc * 64 + 16 * fq;
                            unsigned ow[2][2] = {{0u, 0u}, {0u, 0u}};
#pragma unroll
                            for (int bj = 0; bj < 2; ++bj) {
                                const f32x4 v0 = acc[ai][bj][m][0], v1 = acc[ai][bj][m][1];
                                if (KIND == G_WIN) {
                                } else if (KIND == G_MOE1) {
                                    constexpr float c = -2.45546696f, k4 = SA8 / c, dqg = c / (SW8 * SH8), dql = k4 / (SW8 * SH8);
                                    const f32x4 b0 = cv[bj][0], b1 = cv[bj][1];
                                    const float ug[4] = {__builtin_fmaf(v0.x, dqg, b0.x), __builtin_fmaf(v0.z, dqg, b0.z), __builtin_fmaf(v1.x, dqg, b1.x), __builtin_fmaf(v1.z, dqg, b1.z)};
                                    const float ul[4] = {__builtin_fmaf(v0.y, dql, b0.y), __builtin_fmaf(v0.w, dql, b0.w), __builtin_fmaf(v1.y, dql, b1.y), __builtin_fmaf(v1.w, dql, b1.w)};
                                    float o[4];
#pragma unroll
                                    for (int q = 0; q < 4; ++q) { const float g2 = fmaxf(ug[q], 7.f * c), li = __builtin_amdgcn_fmed3f(ul[q], -6.f * k4, 8.f * k4);
                                        o[q] = g2 * __builtin_amdgcn_rcpf(1.f + __builtin_amdgcn_exp2f(g2)) * li; }
                                    ow[bj][0] = pk4_fp8(o[0], o[1], o[2], o[3]); ow[bj][1] = 0u;
                                } else {
                                    constexpr float dq = SY8 / (SW8 * SA8);
                                    const f32x4 b0 = cv[bj][0] * SY8, b1 = cv[bj][1] * SY8;
#define CL8(x) fminf(fmaxf((x), -448.f), 448.f)
                                    ow[bj][0] = pk4_fp8(CL8(v0.x * dq + b0.x), CL8(v0.y * dq + b0.y), CL8(v0.z * dq + b0.z), CL8(v0.w * dq + b0.w));
                                    ow[bj][1] = pk4_fp8(CL8(v1.x * dq + b1.x), CL8(v1.y * dq + b1.y), CL8(v1.z * dq + b1.z), CL8(v1.w * dq + b1.w));
#undef CL8
                                }
                            }
                            if (KIND == G_WIN) {
                                constexpr float dq = 1.f / (SW8 * SH8);
                                const f32x4 a0 = acc[ai][0][m][0] * dq, a1 = acc[ai][0][m][1] * dq, a2 = acc[ai][1][m][0] * dq, a3 = acc[ai][1][m][1] * dq;
                                u32x4 o0, o1; o0.x = pk2(a0.x, a0.y); o0.y = pk2(a0.z, a0.w); o0.z = pk2(a1.x, a1.y); o0.w = pk2(a1.z, a1.w);
                                o1.x = pk2(a2.x, a2.y); o1.y = pk2(a2.z, a2.w); o1.z = pk2(a3.x, a3.y); o1.w = pk2(a3.z, a3.w);
                                bf16_t* dst = WSP(bf16_t, WS_PX) + (size_t)row * NIN + colw;
                                *(u32x4*)dst = o0; *(u32x4*)(dst + 8) = o1;
                            } else
                            if (KIND == G_MOE1) { u32x2 o; o.x = ow[0][0]; o.y = ow[1][0]; *(u32x2*)(WSP(unsigned char, WS_ACT) + (size_t)row * FF + (colw >> 1)) = o; }
                            else { u32x4 o; o.x = ow[0][0]; o.y = ow[0][1]; o.z = ow[1][0]; o.w = ow[1][1]; *(u32x4*)(WSP(unsigned char, WS_Y2) + (size_t)row * DM + colw) = o; }
                        } else {
#pragma unroll
                            for (int bj = 0; bj < 2; ++bj) {
                                const f32x4 v0 = acc[ai][bj][m][0], v1 = acc[ai][bj][m][1]; const int col = cur.ocol0 + bj * HALF + c0;
                                u32x4 o; o.x = pk2(v0.x, v0.y); o.y = pk2(v0.z, v0.w); o.z = pk2(v1.x, v1.y); o.w = pk2(v1.z, v1.w);
                                bf16_t* dst;
                                if (KIND == G_WIN) dst = WSP(bf16_t, WS_PX) + (size_t)row * NIN + col;
                                else if (KIND == G_DFT) dst = WSP(bf16_t, WS_YCAT) + (size_t)((col >> 8) * SEQ + row) * DM + 768 + (col & 255);
                                else dst = WSP(bf16_t, WS_YCAT) + (size_t)(NX + (col >> 8) * LC + row) * DM + 768 + (col & 255);
                                *(u32x4*)dst = o;
                            }
                        }
                    }
                }
            }
        }
        if (!has_next) break;
#pragma unroll
        for (int a = 0; a < 2; ++a)
#pragma unroll
            for (int b = 0; b < 2; ++b)
#pragma unroll
                for (int m = 0; m < 4; ++m)
#pragma unroll
                    for (int n = 0; n < 2; ++n) acc[a][b][m][n] = (f32x4){0.f, 0.f, 0.f, 0.f};
        cur = nxt; cB = nB; ++ui;
        G8_LDB(B0, 0, 0);
    }
    G8_WAIT_V(0);
    if (wr == 0) G8_BAR;
    G8_BAR;
#undef G8_SA
#undef G8_SB
#undef G8_STAGE_A
#undef G8_STAGE_B
#undef G8_LDA
#undef G8_LDB
#undef G8_MMA
#undef G8_WAIT_V
#undef G8_WAIT_L
#undef G8_BAR
#undef G8_SCHED
#undef G8_AOFF
}

__device__ __forceinline__ void wave_transpose_store(bf16_t* sm  , const u32x4 (&v)[8], bf16_t* dst, size_t dstride, int lane, int cpos) {
#pragma unroll
    for (int i = 0; i < 8; ++i) {
        const unsigned w[4] = {v[i].x, v[i].y, v[i].z, v[i].w};
#pragma unroll
        for (int q = 0; q < 4; ++q) { sm[(8 * i + 2 * q) * 72 + cpos] = (bf16_t)(w[q] & 0xffffu); sm[(8 * i + 2 * q + 1) * 72 + cpos] = (bf16_t)(w[q] >> 16); }
    }
    __builtin_amdgcn_s_waitcnt(0xc07f); asm volatile("" ::: "memory");
#pragma unroll
    for (int i = 0; i < 8; ++i) { const u32x4 o = *(const u32x4*)(sm + lane * 72 + 8 * i); *(u32x4*)(dst + (size_t)lane * dstride + 8 * i) = o; }
    __builtin_amdgcn_s_waitcnt(0xc07f); asm volatile("" ::: "memory");
}

__device__ __forceinline__ void phase_prep(const Params& p, const int l, unsigned char* smem) {
    const int tid = hid_tid(), lane = tid & 63, wave = tid >> 6;
    const int gw = blockIdx.x * 8 + wave, ngw = gridDim.x * 8;
    const bf16_t* PX = WSP(bf16_t, WS_PX); const float* ROPE = WSP(float, WS_ROPE);
    bf16_t *QA = WSP(bf16_t, WS_QA), *KA = WSP(bf16_t, WS_KA), *QD = WSP(bf16_t, WS_QD), *KD = WSP(bf16_t, WS_KD), *YC = WSP(bf16_t, WS_YCAT);
    struct RowRaw { u32x2 q[4]; u32x2 wv[16]; u32x2 cu; };
    auto row_load = [&](int r, RowRaw& R) {
        const bool isctx = r >= NX; const int t = isctx ? ((r - NX) & 255) : (r & 2047);
        const bf16_t* px = PX + (size_t)r * NIN;
        R.q[0] = *(const u32x2*)(px + 4 * lane); R.q[1] = *(const u32x2*)(px + 256 + 4 * lane); R.q[2] = *(const u32x2*)(px + 768 + 4 * lane); R.q[3] = *(const u32x2*)(px + 1024 + 4 * lane);
        if (!(l == 1 && isctx)) {
            const int g = lane >> 4, win = 2 << g, Ls = isctx ? LC : SEQ;
            int lo = t - win / 2, hi = lo + win; lo = lo < 0 ? 0 : lo; hi = hi > Ls ? Ls : hi;
            const bf16_t* base = PX + (size_t)(r - t) * NIN + 1536 + 4 * lane;
#pragma unroll
            for (int j = 0; j < 16; ++j) { const int tt = lo + j < hi ? lo + j : hi - 1; R.wv[j] = *(const u32x2*)(base + (size_t)tt * NIN); }
            R.cu = *(const u32x2*)(base + (size_t)t * NIN);
        }
    };
    RowRaw cur, nxt;
    if (gw < NT) row_load(gw, nxt);
    for (int r = gw; r < NT; r += ngw) {
        cur = nxt;
        if (r + ngw < NT) row_load(r + ngw, nxt);
        const bool isctx = r >= NX; int b, t, kidx;
        if (!isctx) { b = r >> 11; t = r & 2047; kidx = 256 + t; } else { const int rr = r - NX; b = rr >> 8; t = rr & 255; kidx = t; }
        const int h = lane >> 4, d4 = (4 * lane) & 63;
        const size_t obase = ((size_t)(b * 4 + h) * KEYS + kidx) * 64 + d4;
        float v[4];
        { unpack4(cur.q[0], v); float ss = v[0] * v[0] + v[1] * v[1] + v[2] * v[2] + v[3] * v[3];
          ss = sum16_dpp(ss);
          const float rs = rsqrtf(ss * (1.f / 64.f) + EPS) * 0.18033688f; const f32x4 g = *(const f32x4*)(p.na_qg + l * 64 + d4);
          u32x2 o; o.x = pk2(v[0] * rs * g.x, v[1] * rs * g.y); o.y = pk2(v[2] * rs * g.z, v[3] * rs * g.w); *(u32x2*)(QA + obase) = o; }
        { unpack4(cur.q[1], v); float ss = v[0] * v[0] + v[1] * v[1] + v[2] * v[2] + v[3] * v[3];
          ss = sum16_dpp(ss);
          const float rs = rsqrtf(ss * (1.f / 64.f) + EPS); const f32x4 g = *(const f32x4*)(p.na_kg + l * 64 + d4);
          u32x2 o; o.x = pk2(v[0] * rs * g.x, v[1] * rs * g.y); o.y = pk2(v[2] * rs * g.z, v[3] * rs * g.w); *(u32x2*)(KA + obase) = o; }
        const int li = lane & 7, d32 = 4 * li;
        float cs[4], sn[4];
        if (!isctx) {
            const int pos = (li & 4) ? (t & 63) : (t >> 6);
            const f32x4* rt = (const f32x4*)(ROPE + (pos * 8 + 4 * (li & 1)) * 2);
            const f32x4 r0 = rt[0], r1 = rt[1];
            cs[0] = r0.x; sn[0] = r0.y; cs[1] = r0.z; sn[1] = r0.w; cs[2] = r1.x; sn[2] = r1.y; cs[3] = r1.z; sn[3] = r1.w;
        }
#pragma unroll
        for (int which = 0; which < 2; ++which) {
            unpack4(cur.q[2 + which], v);
            float ss = v[0] * v[0] + v[1] * v[1] + v[2] * v[2] + v[3] * v[3];
            ss = sum8_dpp(ss);
            const float rs = rsqrtf(ss * (1.f / 32.f) + EPS);
            const f32x4 g = *(const f32x4*)((which ? p.df_kg : p.df_qg) + l * 32 + d32);
            float y[4] = {v[0] * rs * g.x, v[1] * rs * g.y, v[2] * rs * g.z, v[3] * rs * g.w};
            if (!isctx) {
#pragma unroll
                for (int e = 0; e < 4; ++e) { const float o = DPP_F(y[e], 0x4E); y[e] = (li & 2) ? (y[e] * cs[e] + o * sn[e]) : (y[e] * cs[e] - o * sn[e]); }
            }
            const float sc = which ? 1.f : 0.25503486f;
            u32x2 o; o.x = pk2(y[0] * sc, y[1] * sc); o.y = pk2(y[2] * sc, y[3] * sc);
            *(u32x2*)((which ? KD : QD) + obase) = o;
        }
        if (!(l == 1 && isctx)) {
            const int g = lane >> 4, win = 2 << g, Ls = isctx ? LC : SEQ;
            int lo = t - win / 2, hi = lo + win; lo = lo < 0 ? 0 : lo; hi = hi > Ls ? Ls : hi;
            float s[4] = {0.f, 0.f, 0.f, 0.f};
#pragma unroll
            for (int j = 0; j < 16; ++j) { float q[4]; unpack4(cur.wv[j], q); const float m = lo + j < hi ? 1.f : 0.f; s[0] += m * q[0]; s[1] += m * q[1]; s[2] += m * q[2]; s[3] += m * q[3]; }
            float u[4]; unpack4(cur.cu, u);
            const float inv = 1.f / (float)(hi - lo);
            u32x2 o; o.x = pk2(s[0] * inv - u[0], s[1] * inv - u[1]); o.y = pk2(s[2] * inv - u[2], s[3] * inv - u[3]);
            *(u32x2*)(YC + (size_t)r * DM + 512 + 4 * lane) = o;
        }
    }
    bf16_t* sm = (bf16_t*)smem + wave * (64 * 72);
    for (int it = gw; it < 2 * 8 * 4 * 36; it += ngw) {
        const int ch = it % 36, h = (it / 36) & 3, b = (it / 144) & 7, which = it / 1152;
        const int kidx = 64 * ch + lane; const int row = kidx < 256 ? NX + b * LC + kidx : b * SEQ + kidx - 256;
        const u32x4* src = (const u32x4*)(PX + (size_t)row * NIN + (which ? 1280 : 512) + 64 * h);
        u32x4 v[8];
#pragma unroll
        for (int i = 0; i < 8; ++i) v[i] = src[i];
        bf16_t* dst = (which ? WSP(bf16_t, WS_VTD) : WSP(bf16_t, WS_VTA)) + (size_t)(b * 4 + h) * 64 * KEYS + 64 * ch;
        wave_transpose_store(sm, v, dst, KEYS, lane, (lane & 48) | (((lane >> 2) & 1) << 3) | (((lane >> 3) & 1) << 2) | (lane & 3));
    }
    const int nC = 8 * 4 * 32 + (l == 0 ? 8 * 4 * 4 : 0);
    for (int it = gw; it < nC; it += ngw) {
        const bool cx = it >= 1024; const int q = cx ? it - 1024 : it;
        const int N = cx ? 256 : 2048, njc = N / 64;
        const int jc = q % njc, cc = (q / njc) & 3, b = q / (njc * 4);
        const int j = 64 * jc + lane; const int rowb = cx ? NX + b * LC : b * SEQ;
        int t1, t2, col; float sgn;
        if (j <= N / 2) { t1 = j; t2 = (j == 0 || j == N / 2) ? -1 : N - j; col = 1792 + 64 * cc; sgn = 1.f; }
        else { t1 = j - N / 2; t2 = N - t1; col = 2048 + 64 * cc; sgn = -1.f; }
        const u32x4* s1 = (const u32x4*)(PX + (size_t)(rowb + t1) * NIN + col);
        const u32x4* s2 = (const u32x4*)(PX + (size_t)(rowb + (t2 < 0 ? t1 : t2)) * NIN + col);
        const float w2 = t2 < 0 ? 0.f : sgn;
        u32x4 v[8];
#pragma unroll
        for (int i = 0; i < 8; ++i) {
            const u32x4 a = s1[i], bq = s2[i]; u32x4 o;
            o.x = pk2(bflo(a.x) + w2 * bflo(bq.x), bfhi(a.x) + w2 * bfhi(bq.x)); o.y = pk2(bflo(a.y) + w2 * bflo(bq.y), bfhi(a.y) + w2 * bfhi(bq.y));
            o.z = pk2(bflo(a.z) + w2 * bflo(bq.z), bfhi(a.z) + w2 * bfhi(bq.z)); o.w = pk2(bflo(a.w) + w2 * bflo(bq.w), bfhi(a.w) + w2 * bfhi(bq.w));
            v[i] = o;
        }
        bf16_t* dst = (cx ? WSP(bf16_t, WS_XFC) : WSP(bf16_t, WS_XF)) + (size_t)(b * 256 + 64 * cc) * N + 64 * jc;
        wave_transpose_store(sm, v, dst, N, lane, lane);
    }
}


__device__ __forceinline__ unsigned cvt_pk_bf16(float lo, float hi) { return pk2(lo, hi); }
__device__ __forceinline__ void phase_df_mfma(const Params& p, const int l, LAS unsigned char* lds) {
    const int tid = hid_tid(), wave = __builtin_amdgcn_readfirstlane(tid >> 6), lane = tid & 63, qn = lane & 31, hh = lane >> 5;
    const float* SC = WSP(float, WS_SCAL) + l * 16;
    const float lam = SC[0], lam_init = SC[1], negmb = -SC[2];
    const int nunits = 256 + (l == 0 ? 32 : 0);
    const int srow = tid >> 3, scq = (tid & 7) ^ ((srow >> 1) & 7);
    const unsigned ldsw = (unsigned)tid * 16u;
    f32x16 negm;
#pragma unroll
    for (int i = 0; i < 16; ++i) negm[i] = negmb;
    const int rsw = (qn >> 1) & 7;
    for (int it_ = 0;; ++it_) {
        int u;
        if (gridDim.x == 256) { if (it_ == 0) u = blockIdx.x; else { if (it_ > 1 || nunits <= 256 || blockIdx.x < 224) break; u = 256 + (255 - (int)blockIdx.x); } }
        else { u = blockIdx.x + it_ * (int)gridDim.x; if (u >= nunits) break; }
        const bool cx = u >= 256; const int qt = (u >> 3) & 7, bh = cx ? u - 256 : (u & 7) * 4 + (u >> 6), b = bh >> 2, h = bh & 3;
        const int q0 = cx ? 0 : 256 + 256 * qt, nkt = cx ? 4 : 36;
        const int orow = (cx ? NX + b * LC : b * SEQ + 256 * qt) + 32 * wave + qn;
        const char* Kg = (const char*)(WSP(bf16_t, WS_KD) + (size_t)bh * KEYS * 64) + srow * 128 + scq * 16;
        const char* Vg = (const char*)(WSP(bf16_t, WS_VTD) + (size_t)bh * 64 * KEYS) + (size_t)srow * KEYS * 2 + scq * 16;
        bf16x8 qf[2][2];
        { const bf16_t* Q = WSP(bf16_t, WS_QD) + ((size_t)bh * KEYS + q0 + 32 * wave + qn) * 64;
#pragma unroll
          for (int sub = 0; sub < 2; ++sub)
#pragma unroll
              for (int ks = 0; ks < 2; ++ks) qf[sub][ks] = *(const bf16x8*)(Q + 32 * sub + 16 * ks + 8 * hh); }
        f32x16 O1[2], O2[2]; float l1 = 0.f, l2 = 0.f;
        for (int trep_ = 0; trep_ < REP_TILE; ++trep_) {
#pragma unroll
        for (int db = 0; db < 2; ++db)
#pragma unroll
            for (int i = 0; i < 16; ++i) { O1[db][i] = 0.f; O2[db][i] = 0.f; }
        l1 = 0.f; l2 = 0.f;
        __syncthreads();
        __builtin_amdgcn_global_load_lds((const unsigned*)Kg, (LAS unsigned*)(lds + ldsw), 16, 0, 0);
        __builtin_amdgcn_global_load_lds((const unsigned*)Vg, (LAS unsigned*)(lds + 8192 + ldsw), 16, 0, 0);
        __builtin_amdgcn_global_load_lds((const unsigned*)(Kg + (size_t)64 * 128), (LAS unsigned*)(lds + 16384 + ldsw), 16, 0, 0);
        __builtin_amdgcn_global_load_lds((const unsigned*)(Vg + (size_t)64 * 2), (LAS unsigned*)(lds + 16384 + 8192 + ldsw), 16, 0, 0);
        asm volatile("s_waitcnt vmcnt(2)" ::: "memory"); __builtin_amdgcn_s_barrier();
        unsigned bo = 0u;
#pragma unroll 1
        for (int t = 0; t < nkt; ++t) {
            if (t + 2 < nkt) {
                const unsigned bn = bo == 0u ? 32768u : bo - 16384u;
                __builtin_amdgcn_global_load_lds((const unsigned*)(Kg + (size_t)(t + 2) * 64 * 128), (LAS unsigned*)(lds + bn + ldsw), 16, 0, 0);
                __builtin_amdgcn_global_load_lds((const unsigned*)(Vg + (size_t)(t + 2) * 64 * 2), (LAS unsigned*)(lds + bn + 8192 + ldsw), 16, 0, 0);
            }
#pragma unroll
            for (int kb = 0; kb < 2; ++kb) {
                const LAS unsigned char* kt = lds + bo + (32 * kb + qn) * 128;
                bf16x8 kf[2][2];
#pragma unroll
                for (int sub = 0; sub < 2; ++sub)
#pragma unroll
                    for (int ks = 0; ks < 2; ++ks) kf[sub][ks] = *(const LAS bf16x8*)(kt + (((4 * sub + 2 * ks + hh) ^ rsw) << 4));
                f32x16 S1 = __builtin_amdgcn_mfma_f32_32x32x16_bf16(kf[0][0], qf[0][0], negm, 0, 0, 0);
                S1 = __builtin_amdgcn_mfma_f32_32x32x16_bf16(kf[0][1], qf[0][1], S1, 0, 0, 0);
                f32x16 S2 = __builtin_amdgcn_mfma_f32_32x32x16_bf16(kf[1][0], qf[1][0], negm, 0, 0, 0);
                S2 = __builtin_amdgcn_mfma_f32_32x32x16_bf16(kf[1][1], qf[1][1], S2, 0, 0, 0);
                bf16x8 vf[2][2];
#pragma unroll
                for (int db = 0; db < 2; ++db)
#pragma unroll
                    for (int s = 0; s < 2; ++s) vf[db][s] = *(const LAS bf16x8*)(lds + bo + 8192 + (32 * db + qn) * 128 + (((4 * kb + 2 * s + hh) ^ rsw) << 4));
                unsigned pa[8], pb[8];
#pragma unroll
                for (int i = 0; i < 8; ++i) {
                    const float a0 = __builtin_amdgcn_exp2f(S1[2 * i]), a1 = __builtin_amdgcn_exp2f(S1[2 * i + 1]);
                    const float b0 = __builtin_amdgcn_exp2f(S2[2 * i]), b1 = __builtin_amdgcn_exp2f(S2[2 * i + 1]);
                    l1 += a0 + a1; l2 += b0 + b1;
                    pa[i] = cvt_pk_bf16(a0, a1); pb[i] = cvt_pk_bf16(b0, b1);
                }
                bf16x8 P1[2], P2[2];
#pragma unroll
                for (int s = 0; s < 2; ++s) {
                    const u32x4 wa = {pa[4 * s], pa[4 * s + 1], pa[4 * s + 2], pa[4 * s + 3]}, wb = {pb[4 * s], pb[4 * s + 1], pb[4 * s + 2], pb[4 * s + 3]};
                    P1[s] = *(const bf16x8*)&wa; P2[s] = *(const bf16x8*)&wb;
                }
#pragma unroll
                for (int db = 0; db < 2; ++db)
#pragma unroll
                    for (int s = 0; s < 2; ++s) {
                        O1[db] = __builtin_amdgcn_mfma_f32_32x32x16_bf16(vf[db][s], P1[s], O1[db], 0, 0, 0);
                        O2[db] = __builtin_amdgcn_mfma_f32_32x32x16_bf16(vf[db][s], P2[s], O2[db], 0, 0, 0);
                    }
            }
            if (t + 2 < nkt) asm volatile("s_waitcnt vmcnt(2)" ::: "memory"); else asm volatile("s_waitcnt vmcnt(0)" ::: "memory");
            __builtin_amdgcn_s_barrier();
            bo = bo >= 32768u ? 0u : bo + 16384u;
        }
        }
        l1 += __shfl_xor(l1, 32); l2 += __shfl_xor(l2, 32);
        const float i1 = 1.f / l1, i2 = lam / l2; float ss = 0.f;
#pragma unroll
        for (int db = 0; db < 2; ++db)
#pragma unroll
            for (int i = 0; i < 16; ++i) { const float o = O1[db][i] * i1 - O2[db][i] * i2; O1[db][i] = o; ss += o * o; }
        ss += __shfl_xor(ss, 32);
        const float rs = rsqrtf(ss * (1.f / 64.f) + EPS) * (1.f - lam_init);
        bf16_t* op = WSP(bf16_t, WS_YCAT) + (size_t)orow * DM + 256 + 64 * h + 4 * hh;
        const float* sl = p.subln + l * 64 + 4 * hh;
#pragma unroll
        for (int db = 0; db < 2; ++db)
#pragma unroll
            for (int i = 0; i < 4; ++i) {
                const int d = 32 * db + 8 * i; const f32x4 g = *(const f32x4*)(sl + d);
                u32x2 o; o.x = pk2(O1[db][4 * i] * rs * g.x, O1[db][4 * i + 1] * rs * g.y); o.y = pk2(O1[db][4 * i + 2] * rs * g.z, O1[db][4 * i + 3] * rs * g.w);
                *(u32x2*)(op + d) = o;
            }
    }
    __syncthreads();
}


__device__ __forceinline__ void phase_na_mfma(const Params& p, const int l, LAS unsigned char* lds) {
    const int tid = hid_tid(), wave = __builtin_amdgcn_readfirstlane(tid >> 6), lane = tid & 63, qn = lane & 31, hh = lane >> 5;
    const float* SC = WSP(float, WS_SCAL) + l * 16;
    const int nunits = 256 + (l == 0 ? 32 : 0);
    const int srow = tid >> 3, scq = (tid & 7) ^ ((srow >> 1) & 7);
    const unsigned ldsw = (unsigned)tid * 16u;
    const int rsw = (qn >> 1) & 7;
    LAS float* btab = (LAS float*)(lds + 49152);
    for (int it_ = 0;; ++it_) {
        int u;
        if (gridDim.x == 256) { if (it_ == 0) u = blockIdx.x; else { if (it_ > 1 || nunits <= 256 || blockIdx.x < 224) break; u = 256 + (255 - (int)blockIdx.x); } }
        else { u = blockIdx.x + it_ * (int)gridDim.x; if (u >= nunits) break; }
        const bool cx = u >= 256; const int bh = cx ? u - 256 : (u & 7) * 4 + (u >> 6), rg = (u >> 3) & 7, b = bh >> 2, h = bh & 3;
        __syncthreads();
        for (int i = tid; i < 15 * 32; i += 512) { const int rr = i >> 5, cc = i & 31; btab[i] = cc < 31 ? p.na_rpb[((size_t)(l * 4 + h) * 15 + rr) * 31 + cc] * 1.44269504f : -__builtin_inff(); }
        const int r = 4 * rg + (wave >> 1), qc = 32 * (wave & 1) + qn;
        const int qidx = cx ? 32 * wave + qn : 256 + 64 * r + qc;
        const int orow = cx ? NX + b * LC + 32 * wave + qn : b * SEQ + 64 * r + qc;
        bf16x8 qf[4];
        { const bf16_t* Q = WSP(bf16_t, WS_QA) + ((size_t)bh * KEYS + qidx) * 64;
#pragma unroll
          for (int ks = 0; ks < 4; ++ks) qf[ks] = *(const bf16x8*)(Q + 16 * ks + 8 * hh); }
        int cs = qc - 8; cs = cs < 0 ? 0 : (cs > 48 ? 48 : cs);
        int boff[2][16];
#pragma unroll
        for (int kb = 0; kb < 2; ++kb)
#pragma unroll
            for (int rg2 = 0; rg2 < 16; ++rg2) {
                const int kc = 32 * kb + (rg2 & 3) + 8 * (rg2 >> 2) + 4 * hh;
                int dk = kc - qc; dk = dk < -15 ? -15 : (dk > 15 ? 15 : dk);
                boff[kb][rg2] = ((unsigned)(kc - cs) < 16u) ? 4 * (dk + 15) : 4 * 31;
            }
        int rs = r - 4; rs = rs < 0 ? 0 : (rs > 24 ? 24 : rs);
        int krlo = 4 * rg - 4; krlo = krlo < 0 ? 0 : (krlo > 24 ? 24 : krlo);
        int krhi = 4 * rg - 1; krhi = (krhi < 0 ? 0 : (krhi > 24 ? 24 : krhi)) + 7;
        const int ntile = cx ? 4 : 4 + (krhi - krlo + 1);
        const float negmb = -SC[4 + h];
        f32x16 negm;
#pragma unroll
        for (int i = 0; i < 16; ++i) negm[i] = negmb;
        const char* Kg = (const char*)(WSP(bf16_t, WS_KA) + (size_t)bh * KEYS * 64) + srow * 128 + scq * 16;
        const char* Vg = (const char*)(WSP(bf16_t, WS_VTA) + (size_t)bh * 64 * KEYS) + (size_t)srow * KEYS * 2 + scq * 16;
        f32x16 O[2]; float ls = 0.f;
        for (int trep_ = 0; trep_ < REP_TILE; ++trep_) {
        if (trep_) __syncthreads();
#pragma unroll
        for (int db = 0; db < 2; ++db)
#pragma unroll
            for (int i = 0; i < 16; ++i) O[db][i] = 0.f;
        ls = 0.f;
        __builtin_amdgcn_global_load_lds((const unsigned*)Kg, (LAS unsigned*)(lds + ldsw), 16, 0, 0);
        __builtin_amdgcn_global_load_lds((const unsigned*)Vg, (LAS unsigned*)(lds + 8192 + ldsw), 16, 0, 0);
        __builtin_amdgcn_global_load_lds((const unsigned*)(Kg + (size_t)64 * 128), (LAS unsigned*)(lds + 16384 + ldsw), 16, 0, 0);
        __builtin_amdgcn_global_load_lds((const unsigned*)(Vg + (size_t)64 * 2), (LAS unsigned*)(lds + 16384 + 8192 + ldsw), 16, 0, 0);
        asm volatile("s_waitcnt vmcnt(2)" ::: "memory"); __builtin_amdgcn_s_barrier();
        unsigned bo = 0u;
#pragma unroll 1
        for (int i = 0; i < ntile; ++i) {
            if (i + 2 < ntile) {
                const int tn = (i + 2 < 4) ? i + 2 : 4 + krlo + (i + 2 - 4);
                const unsigned bn = bo == 0u ? 32768u : bo - 16384u;
                __builtin_amdgcn_global_load_lds((const unsigned*)(Kg + (size_t)tn * 64 * 128), (LAS unsigned*)(lds + bn + ldsw), 16, 0, 0);
                __builtin_amdgcn_global_load_lds((const unsigned*)(Vg + (size_t)tn * 64 * 2), (LAS unsigned*)(lds + bn + 8192 + ldsw), 16, 0, 0);
            }
            const int kr = krlo + i - 4;
            const bool local = i >= 4;
            if (!local || (kr >= rs && kr < rs + 8)) {
                const int brow = local ? (kr - r + 7) * 128 : 0;
#pragma unroll
                for (int kb = 0; kb < 2; ++kb) {
                    const LAS unsigned char* kt = lds + bo + (32 * kb + qn) * 128;
                    bf16x8 kf[4];
#pragma unroll
                    for (int ks = 0; ks < 4; ++ks) kf[ks] = *(const LAS bf16x8*)(kt + (((2 * ks + hh) ^ rsw) << 4));
                    f32x16 S = __builtin_amdgcn_mfma_f32_32x32x16_bf16(kf[0], qf[0], negm, 0, 0, 0);
#pragma unroll
                    for (int ks = 1; ks < 4; ++ks) S = __builtin_amdgcn_mfma_f32_32x32x16_bf16(kf[ks], qf[ks], S, 0, 0, 0);
                    bf16x8 vf[2][2];
#pragma unroll
                    for (int db = 0; db < 2; ++db)
#pragma unroll
                        for (int s = 0; s < 2; ++s) vf[db][s] = *(const LAS bf16x8*)(lds + bo + 8192 + (32 * db + qn) * 128 + (((4 * kb + 2 * s + hh) ^ rsw) << 4));
                    if (local) {
#pragma unroll
                        for (int rg2 = 0; rg2 < 16; ++rg2) S[rg2] += *(const LAS float*)((const LAS unsigned char*)btab + brow + boff[kb][rg2]);
                    }
                    unsigned pa[8];
#pragma unroll
                    for (int j = 0; j < 8; ++j) {
                        const float a0 = __builtin_amdgcn_exp2f(S[2 * j]), a1 = __builtin_amdgcn_exp2f(S[2 * j + 1]);
                        ls += a0 + a1; pa[j] = pk2(a0, a1);
                    }
                    bf16x8 P[2];
#pragma unroll
                    for (int s = 0; s < 2; ++s) { const u32x4 wa = {pa[4 * s], pa[4 * s + 1], pa[4 * s + 2], pa[4 * s + 3]}; P[s] = *(const bf16x8*)&wa; }
#pragma unroll
                    for (int db = 0; db < 2; ++db)
#pragma unroll
                        for (int s = 0; s < 2; ++s) O[db] = __builtin_amdgcn_mfma_f32_32x32x16_bf16(vf[db][s], P[s], O[db], 0, 0, 0);
                }
            }
            if (i + 2 < ntile) asm volatile("s_waitcnt vmcnt(2)" ::: "memory"); else asm volatile("s_waitcnt vmcnt(0)" ::: "memory");
            __builtin_amdgcn_s_barrier();
            bo = bo >= 32768u ? 0u : bo + 16384u;
        }
        }
        ls += __shfl_xor(ls, 32);
        const float il = 1.f / ls;
        bf16_t* op = WSP(bf16_t, WS_YCAT) + (size_t)orow * DM + 64 * h + 4 * hh;
#pragma unroll
        for (int db = 0; db < 2; ++db)
#pragma unroll
            for (int i = 0; i < 4; ++i) {
                u32x2 o; o.x = pk2(O[db][4 * i] * il, O[db][4 * i + 1] * il); o.y = pk2(O[db][4 * i + 2] * il, O[db][4 * i + 3] * il);
                *(u32x2*)(op + 32 * db + 8 * i) = o;
            }
    }
    __syncthreads();
}

constexpr int RB = 72;
constexpr int HSTR = 2064;
__device__ __forceinline__ void phase_route(const Params& p, const int l, unsigned char* smem, const int cnt_off) {
    unsigned char* HN = smem;
    float* LOGIT = (float*)(smem + RB * HSTR);
    int* hist = (int*)(smem + RB * HSTR + RB * 32 * 4); int* base = hist + 32; int* s_e = base + 32; int* s_lp = s_e + RB * 4; float* s_g = (float*)(s_lp + RB * 4);
    const int tid = hid_tid(), lane = tid & 63, wave = tid >> 6, fr = lane & 15, fq = lane >> 4;
    const int nrows = (l == 0) ? NT : NX;
    const float* MOD = WSP(float, WS_MOD); unsigned char* H8 = WSP(unsigned char, WS_H8); const bf16_t* X1 = WSP(bf16_t, WS_X1);
    const bf16_t* RWT = WSP(bf16_t, WS_RWT) + (size_t)l * 32 * 1024;
    int* cnt = WSP(int, WS_CTL + CTL_CNT + cnt_off) + l * 32;
    int *RTE = WSP(int, WS_RTE), *RTP = WSP(int, WS_RTP), *LIST = WSP(int, WS_LIST); float* RTG = WSP(float, WS_RTG);
    const float rb0 = p.router_b[l * 32 + fr], rb1 = p.router_b[l * 32 + 16 + fr];
    for (int r0 = blockIdx.x * RB; r0 < nrows; r0 += gridDim.x * RB) {
        __syncthreads();
        if (tid < 32) hist[tid] = 0;
        const int nr = (nrows - r0) < RB ? (nrows - r0) : RB;
        u32x2 vn[4];
        if (wave < nr) {
#pragma unroll
            for (int j = 0; j < 4; ++j) vn[j] = ((const u32x2*)(X1 + (size_t)(r0 + wave) * DM))[lane + 64 * j];
        }
        int cmi = -1; f32x4 mA[4], mB[4];
        for (int i = wave; i < nr; i += 8) {
            const int r = r0 + i;
            if (mod_index(r) != cmi) {
                cmi = mod_index(r);
                const float* m = MOD + (size_t)(l * 9 + cmi) * 6144; const float* gw = p.g2w + l * 1024;
#pragma unroll
                for (int j = 0; j < 4; ++j) { const int c = 4 * lane + 256 * j; const f32x4 g = *(const f32x4*)(gw + c), s1 = *(const f32x4*)(m + 4 * 1024 + c);
                    mA[j].x = g.x * (1.f + s1.x); mA[j].y = g.y * (1.f + s1.y); mA[j].z = g.z * (1.f + s1.z); mA[j].w = g.w * (1.f + s1.w); mB[j] = *(const f32x4*)(m + 3 * 1024 + c); }
            }
            f32x4 v[4]; float ss = 0.f;
#pragma unroll
            for (int j = 0; j < 4; ++j) { v[j] = (f32x4){bflo(vn[j].x), bfhi(vn[j].x), bflo(vn[j].y), bfhi(vn[j].y)}; ss += v[j].x * v[j].x + v[j].y * v[j].y + v[j].z * v[j].z + v[j].w * v[j].w; }
            if (i + 8 < nr) {
#pragma unroll
                for (int j = 0; j < 4; ++j) vn[j] = ((const u32x2*)(X1 + (size_t)(r + 8) * DM))[lane + 64 * j];
            }
            ss = wave_sum_fast(ss);
            const float rs = rsqrtf(ss * (1.f / DM) + EPS);
#pragma unroll
            for (int j = 0; j < 4; ++j) {
                const int c = 4 * lane + 256 * j;
                f32x4 o;
                o.x = v[j].x * rs * mA[j].x + mB[j].x; o.y = v[j].y * rs * mA[j].y + mB[j].y;
                o.z = v[j].z * rs * mA[j].z + mB[j].z; o.w = v[j].w * rs * mA[j].w + mB[j].w;
                *(unsigned*)(H8 + (size_t)r * DM + c) = pk4_fp8(fminf(fmaxf(o.x * SH8, -448.f), 448.f), fminf(fmaxf(o.y * SH8, -448.f), 448.f), fminf(fmaxf(o.z * SH8, -448.f), 448.f), fminf(fmaxf(o.w * SH8, -448.f), 448.f));
                u32x2 hb; hb.x = pk2(o.x, o.y); hb.y = pk2(o.z, o.w);
                *(u32x2*)(HN + i * HSTR + c * 2) = hb;
            }
        }
        __syncthreads();
        if (wave < 5 && 16 * wave < nr) {
            f32x4 a0 = {0.f, 0.f, 0.f, 0.f}, a1 = {0.f, 0.f, 0.f, 0.f};
            const unsigned char* arow = HN + (16 * wave + fr) * HSTR + fq * 16;
            const bf16_t* b0p = RWT + (size_t)fr * 1024 + fq * 8; const bf16_t* b1p = b0p + 16 * 1024;
#pragma unroll 8
            for (int ks = 0; ks < 32; ++ks) {
                const bf16x8 a = *(const bf16x8*)(arow + ks * 64);
                const bf16x8 b0 = *(const bf16x8*)(b0p + ks * 32), b1 = *(const bf16x8*)(b1p + ks * 32);
                a0 = __builtin_amdgcn_mfma_f32_16x16x32_bf16(a, b0, a0, 0, 0, 0);
                a1 = __builtin_amdgcn_mfma_f32_16x16x32_bf16(a, b1, a1, 0, 0, 0);
            }
#pragma unroll
            for (int q = 0; q < 4; ++q) { const int row = 16 * wave + 4 * fq + q; if (row < nr) { LOGIT[row * 32 + fr] = a0[q] + rb0; LOGIT[row * 32 + 16 + fr] = a1[q] + rb1; } }
        }
        __syncthreads();
        for (int i = wave; i < nr; i += 8) {
            const float logit = LOGIT[i * 32 + (lane & 31)];
            float tv[4]; int ti[4];
            {
                const int me = lane & 31; int rank = 0;
#pragma unroll
                for (int e = 0; e < 32; ++e) { const float ov = __builtin_bit_cast(float, __builtin_amdgcn_readlane(__builtin_bit_cast(int, logit), e)); rank += ((ov > logit) || (ov == logit && e < me)) ? 1 : 0; }
#pragma unroll
                for (int k = 0; k < 4; ++k) {
                    const unsigned long long mk = __ballot(rank == k);
                    const int srcl = __builtin_amdgcn_readfirstlane((int)__builtin_ctzll(mk));
                    ti[k] = srcl & 31; tv[k] = __builtin_bit_cast(float, __builtin_amdgcn_readlane(__builtin_bit_cast(int, logit), srcl));
                }
            }
            const float e1 = __expf(tv[1] - tv[0]), e2 = __expf(tv[2] - tv[0]), e3 = __expf(tv[3] - tv[0]); const float inv = 1.f / (1.f + e1 + e2 + e3);
            if (lane < 4) {
                const int te = lane == 0 ? ti[0] : lane == 1 ? ti[1] : lane == 2 ? ti[2] : ti[3];
                const float tg = (lane == 0 ? 1.f : lane == 1 ? e1 : lane == 2 ? e2 : e3) * inv;
                s_e[i * 4 + lane] = te; s_g[i * 4 + lane] = tg; s_lp[i * 4 + lane] = atomicAdd(&hist[te], 1);
            }
        }
        __syncthreads();
        if (tid < 32) base[tid] = hist[tid] ? atomicAdd(&cnt[tid], hist[tid]) : 0;
        __syncthreads();
        for (int i = tid; i < nr * 4; i += 512) {
            const int r = r0 + (i >> 2), e = s_e[i], pos = base[e] + s_lp[i];
            RTE[(size_t)r * 4 + (i & 3)] = e; RTP[(size_t)r * 4 + (i & 3)] = pos; RTG[(size_t)r * 4 + (i & 3)] = s_g[i];
            LIST[(size_t)e * NT + pos] = r;
        }
    }
    __syncthreads();
}

__device__ __forceinline__ void phase_combine(const Params& p, const int l, const int* tinfo) {
    const int tid = hid_tid(), lane = tid & 63, wave = tid >> 6;
    const int gw = blockIdx.x * 8 + wave, ngw = gridDim.x * 8;
    const int nrows = (l == 0) ? NT : NX;
    const float* MOD = WSP(float, WS_MOD); const bf16_t* X1 = WSP(bf16_t, WS_X1); const unsigned char* Y2 = WSP(unsigned char, WS_Y2);
    const int *RTE = WSP(int, WS_RTE), *RTP = WSP(int, WS_RTP); const float* RTG = WSP(float, WS_RTG);
    int ne[4], np_[4]; float ng[4];
    if (gw < nrows) {
#pragma unroll
        for (int k = 0; k < 4; ++k) { ne[k] = RTE[(size_t)gw * 4 + k]; np_[k] = RTP[(size_t)gw * 4 + k]; ng[k] = RTG[(size_t)gw * 4 + k]; }
    }
    int cmi = -1; f32x4 g2v[4], nA[4], nB[4];
    for (int r = gw; r < nrows; r += ngw) {
        if (mod_index(r) != cmi) {
            cmi = mod_index(r);
            const float* g2 = MOD + (size_t)(l * 9 + cmi) * 6144 + 5 * 1024; const float* m = MOD + (size_t)(1 * 9 + cmi) * 6144;
#pragma unroll
            for (int j = 0; j < 4; ++j) { const int c = 4 * lane + 256 * j; g2v[j] = *(const f32x4*)(g2 + c);
                if (l == 0) { const f32x4 g = *(const f32x4*)(p.g1w + 1024 + c), s1 = *(const f32x4*)(m + 1024 + c);
                    nA[j].x = g.x * (1.f + s1.x); nA[j].y = g.y * (1.f + s1.y); nA[j].z = g.z * (1.f + s1.z); nA[j].w = g.w * (1.f + s1.w); nB[j] = *(const f32x4*)(m + c); } }
        }
        const unsigned char* yr[4]; float gk[4];
#pragma unroll
        for (int k = 0; k < 4; ++k) { yr[k] = Y2 + ((size_t)tinfo[ne[k]] * 256 + np_[k]) * DM; gk[k] = ng[k] * (1.f / SY8); }
        unsigned yv[4][4]; u32x2 x1v[4]; f32x4 gv[4];
#pragma unroll
        for (int j = 0; j < 4; ++j) {
            const int c = 4 * lane + 256 * j;
#pragma unroll
            for (int k = 0; k < 4; ++k) yv[j][k] = *(const unsigned*)(yr[k] + c);
            x1v[j] = *(const u32x2*)(X1 + (size_t)r * DM + c); gv[j] = g2v[j];
        }
        if (r + ngw < nrows) {
#pragma unroll
            for (int k = 0; k < 4; ++k) { ne[k] = RTE[(size_t)(r + ngw) * 4 + k]; np_[k] = RTP[(size_t)(r + ngw) * 4 + k]; ng[k] = RTG[(size_t)(r + ngw) * 4 + k]; }
        }
        f32x4 xv[4];
#pragma unroll
        for (int j = 0; j < 4; ++j) {
            const int c = 4 * lane + 256 * j;
            float s[4] = {0.f, 0.f, 0.f, 0.f};
#pragma unroll
            for (int k = 0; k < 4; ++k) { const f32x2 ya = __builtin_amdgcn_cvt_pk_f32_fp8((int)yv[j][k], false), yb = __builtin_amdgcn_cvt_pk_f32_fp8((int)yv[j][k], true); s[0] += gk[k] * ya.x; s[1] += gk[k] * ya.y; s[2] += gk[k] * yb.x; s[3] += gk[k] * yb.y; }
            const f32x4 x1 = {bflo(x1v[j].x), bfhi(x1v[j].x), bflo(x1v[j].y), bfhi(x1v[j].y)}, g = gv[j];
            f32x4 o; o.x = x1.x + g.x * s[0]; o.y = x1.y + g.y * s[1]; o.z = x1.z + g.z * s[2]; o.w = x1.w + g.w * s[3];
            if (l == 0) { u32x2 ob; ob.x = pk2(o.x, o.y); ob.y = pk2(o.z, o.w); *(u32x2*)(WSP(bf16_t, WS_X2) + (size_t)r * DM + c) = ob; }
            else *(f32x4*)(p.out + (size_t)r * DM + c) = o;
            xv[j] = o;
        }
        if (l == 0) {
            float ss = 0.f;
#pragma unroll
            for (int j = 0; j < 4; ++j) ss += xv[j].x * xv[j].x + xv[j].y * xv[j].y + xv[j].z * xv[j].z + xv[j].w * xv[j].w;
            ss = wave_sum_fast(ss); const float rs = rsqrtf(ss * (1.f / DM) + EPS);
            unsigned char* hrow = WSP(unsigned char, WS_H) + (size_t)r * DM;
#pragma unroll
            for (int j = 0; j < 4; ++j) {
                const int c = 4 * lane + 256 * j;
                *(unsigned*)(hrow + c) = pk4_fp8(cl8((xv[j].x * rs * nA[j].x + nB[j].x) * SH8), cl8((xv[j].y * rs * nA[j].y + nB[j].y) * SH8),
                                                 cl8((xv[j].z * rs * nA[j].z + nB[j].z) * SH8), cl8((xv[j].w * rs * nA[j].w + nB[j].w) * SH8));
            }
        }
    }
}

#define XB_TMO      128
#define XB_XCNT(j)  (256  + 64 * (j))
#define XB_XSUB(j)  (1280 + 64 * (j))
#define XB_XGEN(j)  (2304 + 64 * (j))
#define XB_TOP      3328
#define XB_TOPGEN   3392
#define XCD_BAR_WORDS 3456
#define XB_SPIN_CAP (1u << 18)
__device__ __forceinline__ unsigned xb_ld(unsigned* p)              { return __hip_atomic_load(p, __ATOMIC_RELAXED, __HIP_MEMORY_SCOPE_AGENT); }
__device__ __forceinline__ unsigned xb_add(unsigned* p, unsigned v) { return __hip_atomic_fetch_add(p, v, __ATOMIC_RELAXED, __HIP_MEMORY_SCOPE_AGENT); }
__device__ __forceinline__ unsigned xb_xcc_id() { return (unsigned)__builtin_amdgcn_s_getreg((3 << 11) | 20) & 0xFu; }
#define XB_SPIN(cond, bar) do { unsigned _sp = 0; while (cond) { __builtin_amdgcn_s_sleep(1); \
    if ((++_sp & 255u) == 0u) { if (xb_ld(&(bar)[XB_TMO])) break; if (_sp > XB_SPIN_CAP) { atomicAdd(&(bar)[XB_TMO], 1u); break; } } } } while (0)
struct XcdBarrier { unsigned* bar; unsigned x; volatile LAS unsigned* st; };
__device__ __forceinline__ XcdBarrier xcd_barrier_post(unsigned* bar, volatile LAS unsigned* st) {
    XcdBarrier b; b.bar = bar; b.x = xb_xcc_id(); b.st = st;
    if (threadIdx.x == 0) (void)xb_add(&bar[XB_XCNT(b.x)], 1u);
    return b;
}
__device__ __forceinline__ void xcd_barrier_complete(unsigned* bar, unsigned x, unsigned& nloc, unsigned& nx) {
    const unsigned G = gridDim.x * gridDim.y * gridDim.z;
    unsigned sum, cnt, mine, sp = 0u;
    for (;;) {
        sum = 0u; cnt = 0u; mine = 0u;
#pragma unroll
        for (unsigned j = 0; j < 16; ++j) { const unsigned c = xb_ld(&bar[XB_XCNT(j)]); sum += c; cnt += (c > 0u) ? 1u : 0u; mine = (j == x) ? c : mine; }
        if (sum == G) break;
        __builtin_amdgcn_s_sleep(1);
        if ((++sp & 255u) == 0u) { if (xb_ld(&bar[XB_TMO])) break; if (sp > XB_SPIN_CAP) { atomicAdd(&bar[XB_TMO], 1u); break; } }
    }
    nloc = mine > 0u ? mine : 1u; nx = cnt > 0u ? cnt : 1u;
}
__device__ __forceinline__ void xcd_barrier(const XcdBarrier& b) {
    asm volatile("s_waitcnt vmcnt(0)" ::: "memory");
    __syncthreads();
    if (threadIdx.x == 0) {
        unsigned* bar = b.bar;
        __builtin_amdgcn_s_waitcnt(0);
        unsigned nloc = b.st[0], nx = b.st[1];
        if (nloc == 0u) { xcd_barrier_complete(bar, b.x, nloc, nx); b.st[0] = nloc; b.st[1] = nx; }
        const unsigned old = xb_add(&bar[XB_XSUB(b.x)], 1u);
        const unsigned gen = old / nloc;
        if (old + 1u == (gen + 1u) * nloc) {
            __builtin_amdgcn_fence(__ATOMIC_RELEASE, "agent");
            asm volatile("s_waitcnt vmcnt(0)" ::: "memory");
            const unsigned og = xb_add(&bar[XB_TOP], 1u);
            const unsigned tg = og / nx;
            if (og + 1u == (tg + 1u) * nx) xb_add(&bar[XB_TOPGEN], 1u);
            else XB_SPIN(xb_ld(&bar[XB_TOPGEN]) == tg, bar);
            __builtin_amdgcn_fence(__ATOMIC_ACQUIRE, "agent");
            xb_add(&bar[XB_XGEN(b.x)], 1u);
            asm volatile("s_waitcnt vmcnt(0)" ::: "memory");
        } else {
            XB_SPIN(xb_ld(&bar[XB_XGEN(b.x)]) == gen, bar);
            __builtin_amdgcn_fence(__ATOMIC_ACQUIRE, "agent");
            asm volatile("s_waitcnt vmcnt(0)" ::: "memory");
        }
    }
    __syncthreads();
}

constexpr int LDS_BYTES = 163840;
constexpr int MISC_OFF = LDS_BYTES - 2048;
constexpr int NCH_L = 3072;
constexpr size_t CTL_CHUNK = 40960, CTL_DONE = 41472;
__device__ __forceinline__ void conv_item(const Params& p, unsigned char* smem, int l, int q, int wave, int lane) {
    unsigned char* tsm = smem + wave * (64 * 144);
    if (q < 16384) { const int m = l * 32 + (q >> 9), r = q & 511; transpose_item8(p.w1 + (size_t)m * 1024 * 2048, 2048, 1024, WSP(unsigned char, WS_W1) + (size_t)m * 2048 * 1024, tsm, r & 15, r >> 4, lane); }
    else { const int q2 = q - 16384, m = l * 32 + (q2 >> 8), r = q2 & 255; transpose_item8(p.w2 + (size_t)m * 1024 * 1024, 1024, 1024, WSP(unsigned char, WS_W2) + (size_t)m * 1024 * 1024, tsm, r & 15, r >> 4, lane); }
}
__device__ __forceinline__ void idle_fill(const Params& p, unsigned char* smem, const int phase, const int l) {
    const int tid = hid_tid(), lane = tid & 63, wave = tid >> 6;
    volatile int* cslot = (volatile int*)(smem + MISC_OFF + 512);
    unsigned* chunk = WSP(unsigned, WS_CTL + CTL_CHUNK + 256 * l); unsigned* done = WSP(unsigned, WS_CTL + CTL_DONE + 256 * phase);
    __syncthreads();
    if (tid == 0) {
        __hip_atomic_fetch_add(done, 1u, __ATOMIC_RELAXED, __HIP_MEMORY_SCOPE_AGENT);
        int c = -1;
        if (__hip_atomic_load(done, __ATOMIC_RELAXED, __HIP_MEMORY_SCOPE_AGENT) < gridDim.x) { const unsigned g = __hip_atomic_fetch_add(chunk, 1u, __ATOMIC_RELAXED, __HIP_MEMORY_SCOPE_AGENT); if (g < (unsigned)NCH_L) c = (int)g; }
        cslot[0] = c;
    }
    __syncthreads();
    int c = cslot[0];
    while (c >= 0) {
        __syncthreads();
        unsigned gnext = 0xffffffffu; bool more = false;
        if (tid == 0) { more = __hip_atomic_load(done, __ATOMIC_RELAXED, __HIP_MEMORY_SCOPE_AGENT) < gridDim.x; if (more) gnext = __hip_atomic_fetch_add(chunk, 1u, __ATOMIC_RELAXED, __HIP_MEMORY_SCOPE_AGENT); }
        conv_item(p, smem, l, c * 8 + wave, wave, lane);
        if (tid == 0) cslot[0] = (more && gnext < (unsigned)NCH_L) ? (int)gnext : -1;
        __syncthreads();
        c = cslot[0];
    }
}
__device__ __forceinline__ void conv_drain(const Params& p, unsigned char* smem, const int l) {
    const int tid = hid_tid(), lane = tid & 63, wave = tid >> 6;
    const int gw = blockIdx.x * 8 + wave, ngw = gridDim.x * 8;
    unsigned cst = __hip_atomic_load(WSP(unsigned, WS_CTL + CTL_CHUNK + 256 * l), __ATOMIC_RELAXED, __HIP_MEMORY_SCOPE_AGENT);
    cst = cst > (unsigned)NCH_L ? (unsigned)NCH_L : cst;
    __syncthreads();
    for (int q = (int)cst * 8 + gw; q < NCH_L * 8; q += ngw) conv_item(p, smem, l, q, wave, lane);
    __syncthreads();
}

__global__ void __launch_bounds__(512, 2) k_fwd(Params p) {
    extern __shared__ __attribute__((aligned(16))) unsigned char smem[];
    int* tinfo = (int*)(smem + MISC_OFF + 64);
    if (threadIdx.x < 4) ((unsigned*)(smem + MISC_OFF))[threadIdx.x] = 0u;
    __syncthreads();
    XcdBarrier bar = xcd_barrier_post(WSP(unsigned, WS_CTL), (volatile LAS unsigned*)(smem + MISC_OFF));
    phase_pro0(p, smem);
    __syncthreads();
    REPEAT(REP_PRO1, phase_pro1(p, smem); __syncthreads());
    xcd_barrier(bar);
#define LAYER(l) do { \
        REPEAT(REP_WIN, gemm_phase256<G_WIN>(p, l, (LAS unsigned char*)smem, tinfo)); \
        REPEAT(REP_BAR, xcd_barrier(bar)); \
        REPEAT(REP_PREP, phase_prep(p, l, smem); __syncthreads()); \
        REPEAT(REP_BAR, xcd_barrier(bar)); \
          \
        REPEAT(REP_DFT, gemm_phase256<G_DFT>(p, l, (LAS unsigned char*)smem, tinfo)); \
        if (l == 0) gemm_phase256<G_DFTC>(p, l, (LAS unsigned char*)smem, tinfo); \
        __syncthreads(); \
        REPEAT(REP_DF, phase_df_mfma(p, l, (LAS unsigned char*)smem)); \
        REPEAT(REP_NA, phase_na_mfma(p, l, (LAS unsigned char*)smem)); \
        idle_fill(p, smem, 3 + 8 * l, l); \
        REPEAT(REP_BAR, xcd_barrier(bar)); \
        REPEAT(REP_WOUT, gemm_phase256<G_WOUT>(p, l, (LAS unsigned char*)smem, tinfo)); \
        if (l == 0) idle_fill(p, smem, 4 + 8 * l, l); \
        REPEAT(REP_BAR, xcd_barrier(bar)); \
        if (REP_ROUTE > 1) { phase_route(p, l, smem, 1024); __syncthreads(); } \
        phase_route(p, l, smem, 0); \
        conv_drain(p, smem, l); \
        REPEAT(REP_BAR, xcd_barrier(bar)); \
        moe_tinfo(p, l, tinfo); \
        REPEAT(REP_MOE1, gemm_phase256<G_MOE1>(p, l, (LAS unsigned char*)smem, tinfo)); \
        if (l == 0) idle_fill(p, smem, 5, 1);         \
        REPEAT(REP_BAR, xcd_barrier(bar)); \
        REPEAT(REP_MOE2, gemm_phase256<G_MOE2>(p, l, (LAS unsigned char*)smem, tinfo)); \
        if (l == 0) idle_fill(p, smem, 6, 1); \
        REPEAT(REP_BAR, xcd_barrier(bar)); \
        REPEAT(REP_COMB, phase_combine(p, l, tinfo)); \
        if (l == 0) xcd_barrier(bar); \
    } while (0)
    LAYER(0);
    LAYER(1);
#undef LAYER
}

extern "C" void kernel_launch(void* const* d_in, const int* in_sizes, int n_in, void* d_out, int out_size, void* d_ws, size_t ws_size, hipStream_t stream) {
    static int grid = 0;
    if (n_in != 29 || ws_size < WS_END) { fprintf(stderr, "kernel_launch: need 29 inputs and %zu bytes of workspace (got %d, %zu)\n", (size_t)WS_END, n_in, ws_size); return; }
    if (!grid) {
        int dev = 0, cus = 0, per_cu = 0;
        (void)hipGetDevice(&dev);
        (void)hipDeviceGetAttribute(&cus, hipDeviceAttributeMultiprocessorCount, dev);
        (void)hipFuncSetAttribute((const void*)k_fwd, hipFuncAttributeMaxDynamicSharedMemorySize, LDS_BYTES);
        (void)hipOccupancyMaxActiveBlocksPerMultiprocessor(&per_cu, (const void*)k_fwd, 512, LDS_BYTES);
        if (per_cu < 1) fprintf(stderr, "kernel_launch: occupancy query reports %d workgroups per CU\n", per_cu);
        grid = cus > 0 ? cus : 256;
    }
    Params p;
    const float** pp = (const float**)&p;
    for (int i = 0; i < 29; ++i) pp[i] = (const float*)d_in[i];
    p.out = (float*)d_out; p.ws = (unsigned char*)d_ws;
    (void)hipMemsetAsync((char*)d_ws + WS_CTL, 0, CTL_BYTES, stream);
    hipLaunchKernelGGL(k_fwd, dim3(grid), dim3(512), LDS_BYTES, stream, p);
}
```
